# Optimizing an MI355X kernel written in HIP

```python
import math
import jax, jax.numpy as jnp
from jax import lax
import numpy as np

D_MODEL = 1024
BATCH = 4
SEQ = 8192
DEPTH = 1

PLE_DIM = 256
EPS = 1e-6
BLOCK = 128
NEG = -1e30

A_HEADS = 16
A_KV_HEADS = 2
A_HEAD_DIM = 64
A_WIDTH = A_HEADS * A_HEAD_DIM
A_KV_WIDTH = A_KV_HEADS * A_HEAD_DIM
WINDOW = 128
N_BUCKETS = 32
MAX_DISTANCE = 128

B_HEADS = 16
B_Q_RANK = 256
B_KV_RANK = 128
B_NOPE = 64
B_ROPE = 32
B_QK_DIM = B_NOPE + B_ROPE
B_VDIM = 64
B_WIDTH = B_HEADS * B_VDIM
ROPE_THETA = 10000.0

SPLIT_SIZES = (A_WIDTH, A_KV_WIDTH, A_KV_WIDTH, A_WIDTH,
               B_Q_RANK, B_KV_RANK, B_ROPE, B_WIDTH,
               D_MODEL, D_MODEL)
D_IN = 2 * A_WIDTH + 2 * A_KV_WIDTH + B_Q_RANK + B_KV_RANK + B_ROPE + B_WIDTH + 2 * D_MODEL

kernel_name = "hybrid_swa_sink_mla_gated_block"


def _rms(x, g):
    x32 = x.astype(jnp.float32)
    y = x32 * lax.rsqrt(jnp.mean(x32 * x32, axis=-1, keepdims=True) + EPS)
    return (y * g.astype(jnp.float32)).astype(x.dtype)


def _split(z):
    offsets = [int(o) for o in np.cumsum(SPLIT_SIZES)[:-1]]
    return jnp.split(z, offsets, axis=-1)


def _t5_bucket(dist):
    max_exact = N_BUCKETS // 2
    d = jnp.maximum(dist, 1).astype(jnp.float32)
    large = max_exact + (jnp.log(d / max_exact) / math.log(MAX_DISTANCE / max_exact)
                         * (N_BUCKETS - max_exact)).astype(jnp.int32)
    large = jnp.minimum(large, N_BUCKETS - 1)
    return jnp.where(dist < max_exact, dist, large)


def _rope_tables(positions, dim):
    inv_freq = ROPE_THETA ** (-jnp.arange(0, dim, 2, dtype=jnp.float32) / dim)
    ang = positions.astype(jnp.float32)[..., None] * inv_freq
    return jnp.cos(ang), jnp.sin(ang)


def _rope(x, cos, sin):
    cos = cos.astype(x.dtype)
    sin = sin.astype(x.dtype)
    x1, x2 = jnp.split(x, 2, axis=-1)
    return jnp.concatenate([x1 * cos - x2 * sin, x2 * cos + x1 * sin], axis=-1)


def _swa_branch(q, k, v, rel_bias, sinks, qn_g, kn_g):
    b, s_len, _ = q.shape
    nb = s_len // BLOCK
    grp = A_HEADS // A_KV_HEADS
    q = _rms(q.reshape(b, nb, BLOCK, A_KV_HEADS, grp, A_HEAD_DIM), qn_g)
    k = _rms(k.reshape(b, nb, BLOCK, A_KV_HEADS, A_HEAD_DIM), kn_g)
    v = v.reshape(b, nb, BLOCK, A_KV_HEADS, A_HEAD_DIM)
    pad = jnp.zeros_like(k[:, :1])
    k_band = jnp.concatenate([jnp.concatenate([pad, k[:, :-1]], axis=1), k], axis=2)
    v_band = jnp.concatenate([jnp.concatenate([pad, v[:, :-1]], axis=1), v], axis=2)
    scale = A_HEAD_DIM ** -0.5
    s = jnp.einsum('bnqkgd,bnckd->bnkgqc', q, k_band).astype(jnp.float32) * scale
    dist = (jnp.arange(BLOCK)[:, None] + BLOCK) - jnp.arange(2 * BLOCK)[None, :]
    valid = (dist >= 0) & (dist < WINDOW)
    bias = rel_bias.astype(jnp.float32)[_t5_bucket(jnp.maximum(dist, 0))]
    bias = jnp.transpose(bias, (2, 0, 1)).reshape(A_KV_HEADS, grp, BLOCK, 2 * BLOCK)
    first_pad = (jnp.arange(nb)[:, None, None] == 0) & (jnp.arange(2 * BLOCK)[None, None, :] < BLOCK)
    mask = valid[None] & ~first_pad
    s = jnp.where(mask[None, :, None, None], s + bias, NEG)
    sink = sinks.astype(jnp.float32).reshape(1, 1, A_KV_HEADS, grp, 1, 1)
    m = jnp.maximum(jnp.max(s, axis=-1, keepdims=True), sink)
    e = jnp.exp(s - m)
    probs = e / (jnp.sum(e, axis=-1, keepdims=True) + jnp.exp(sink - m))
    o = jnp.einsum('bnkgqc,bnckd->bnqkgd', probs.astype(v.dtype), v_band)
    return o.reshape(b, s_len, A_WIDTH)


def _mla_branch(c_q, c_kv, k_r, positions, cq_g, w_uq, ckv_g, w_uk, w_uv, qn_g, kn_g, krn_g):
    b, s_len, _ = c_q.shape
    nb = s_len // BLOCK
    cos, sin = _rope_tables(positions, B_ROPE)
    q = (_rms(c_q, cq_g) @ w_uq).reshape(b, s_len, B_HEADS, B_QK_DIM)
    q = _rms(q, qn_g)
    q = jnp.concatenate([q[..., :B_NOPE], _rope(q[..., B_NOPE:], cos[:, :, None], sin[:, :, None])], axis=-1)
    ckv = _rms(c_kv, ckv_g)
    k_nope = _rms((ckv @ w_uk).reshape(b, s_len, B_HEADS, B_NOPE), kn_g)
    v = (ckv @ w_uv).reshape(b, s_len, B_HEADS, B_VDIM)
    k_rope = _rope(_rms(k_r, krn_g), cos, sin)
    scale = B_QK_DIM ** -0.5
    q_blocks = jnp.transpose(q.reshape(b, nb, BLOCK, B_HEADS, B_QK_DIM), (1, 0, 2, 3, 4))
    k_pos = jnp.arange(s_len)

    def one_block(args):
        q_blk, idx = args
        s = (jnp.einsum('bqhd,bkhd->bhqk', q_blk[..., :B_NOPE], k_nope)
             + jnp.einsum('bqhr,bkr->bhqk', q_blk[..., B_NOPE:], k_rope)).astype(jnp.float32) * scale
        q_pos = idx * BLOCK + jnp.arange(BLOCK)
        s = jnp.where(k_pos[None, :] <= q_pos[:, None], s, NEG)
        probs = jax.nn.softmax(s, axis=-1)
        return jnp.einsum('bhqk,bkhd->bqhd', probs.astype(v.dtype), v)

    o = lax.map(one_block, (q_blocks, jnp.arange(nb)))
    return jnp.transpose(o, (1, 0, 2, 3, 4)).reshape(b, s_len, B_WIDTH)


def setup_inputs(seed: int = 0) -> dict:
    key = jax.random.key(seed)
    ks = jax.random.split(key, 24)
    f32 = jnp.float32

    def w(k, shape, fan_in):
        return jax.random.normal(k, shape, f32) * fan_in ** -0.5

    def gain(k, shape):
        return 1.0 + 0.1 * jax.random.normal(k, shape, f32)

    return {
        "x": jax.random.normal(ks[0], (BATCH, SEQ, D_MODEL), f32),
        "p": jax.random.normal(ks[1], (DEPTH, BATCH, SEQ, PLE_DIM), f32),
        "positions": jnp.broadcast_to(jnp.arange(SEQ, dtype=jnp.int32)[None], (BATCH, SEQ)),
        "norm_g": gain(ks[2], (DEPTH, D_MODEL)),
        "w_in": w(ks[3], (DEPTH, D_MODEL, D_IN), D_MODEL),
        "a_q_norm": gain(ks[4], (DEPTH, A_HEAD_DIM)),
        "a_k_norm": gain(ks[5], (DEPTH, A_HEAD_DIM)),
        "a_sinks": 0.5 * jax.random.normal(ks[6], (DEPTH, A_HEADS), f32),
        "rel_bias": 0.5 * jax.random.normal(ks[7], (N_BUCKETS, A_HEADS), f32),
        "w_o_a": w(ks[8], (DEPTH, A_WIDTH, D_MODEL), A_WIDTH),
        "b_cq_norm": gain(ks[9], (DEPTH, B_Q_RANK)),
        "w_uq": w(ks[10], (DEPTH, B_Q_RANK, B_HEADS * B_QK_DIM), B_Q_RANK),
        "b_ckv_norm": gain(ks[11], (DEPTH, B_KV_RANK)),
        "w_uk": w(ks[12], (DEPTH, B_KV_RANK, B_HEADS * B_NOPE), B_KV_RANK),
        "w_uv": w(ks[13], (DEPTH, B_KV_RANK, B_HEADS * B_VDIM), B_KV_RANK),
        "b_q_norm": gain(ks[14], (DEPTH, B_QK_DIM)),
        "b_k_norm": gain(ks[15], (DEPTH, B_NOPE)),
        "b_kr_norm": gain(ks[16], (DEPTH, B_ROPE)),
        "w_o_b": w(ks[17], (DEPTH, B_WIDTH, D_MODEL), B_WIDTH),
        "w_out": w(ks[18], (DEPTH, D_MODEL, D_MODEL), D_MODEL),
        "ple_norm_g": gain(ks[19], (DEPTH, D_MODEL)),
        "w_ple_gate": w(ks[20], (DEPTH, D_MODEL, D_MODEL), D_MODEL),
        "w_ple_proj": w(ks[21], (DEPTH, PLE_DIM, D_MODEL), PLE_DIM),
        "ple_post_g": gain(ks[22], (DEPTH, D_MODEL)),
    }


def reference(x, p, positions, norm_g, w_in, a_q_norm, a_k_norm, a_sinks, rel_bias, w_o_a,
              b_cq_norm, w_uq, b_ckv_norm, w_uk, w_uv, b_q_norm, b_k_norm, b_kr_norm, w_o_b,
              w_out, ple_norm_g, w_ple_gate, w_ple_proj, ple_post_g):
    for i in range(DEPTH):
        h = _rms(x, norm_g[i])
        z = h @ w_in[i]
        q_a, k_a, v_a, z_a, c_q, c_kv, k_r, z_b, g_a, g_b = _split(z)
        y_a = _swa_branch(q_a, k_a, v_a, rel_bias, a_sinks[i], a_q_norm[i], a_k_norm[i])
        y_a = (y_a * jax.nn.silu(z_a)) @ w_o_a[i]
        y_b = _mla_branch(c_q, c_kv, k_r, positions, b_cq_norm[i], w_uq[i], b_ckv_norm[i],
                          w_uk[i], w_uv[i], b_q_norm[i], b_k_norm[i], b_kr_norm[i])
        y_b = (y_b * jax.nn.silu(z_b)) @ w_o_b[i]
        merged = jax.nn.sigmoid(g_a) * y_a + jax.nn.sigmoid(g_b) * y_b
        x = x + merged @ w_out[i]
        gate = jax.nn.sigmoid(_rms(x, ple_norm_g[i]) @ w_ple_gate[i])
        emb = _rms(p[i] @ w_ple_proj[i], ple_post_g[i])
        x = x + gate * emb
    return x
```

```cpp
#include <hip/hip_runtime.h>
#include <hip/hip_cooperative_groups.h>
#include <cstdio>
#include <cstdint>
namespace cg = cooperative_groups;
namespace pg8 {
#define PG8_LAS __attribute__((address_space(3)))
typedef unsigned short bf16_t;
typedef short bf16x8 __attribute__((ext_vector_type(8)));
typedef float f32x4 __attribute__((ext_vector_type(4)));
typedef unsigned u32x4 __attribute__((ext_vector_type(4)));
constexpr int BM = 256, BK = 64, HALF = 128, HTB = HALF * BK * 2  , STAGE_BYTES = 8 * HTB, NXCD = 8, WGM = 8;

__host__ __device__ __forceinline__ int lds_byte(int r, int c) { const int st = (r >> 4) * 2 + (c >> 5), rr = r & 15, cc = c & 31, ob = rr * 64 + cc * 2; return st * 1024 + (ob ^ (((ob >> 9) & 1) << 5)); }
__host__ __device__ __forceinline__ void stage_rc(int b, int& R, int& C) { const int st = b / 1024, sb = b % 1024, swz = sb ^ (((sb >> 9) & 1) << 5); R = (st >> 1) * 16 + swz / 64; C = (st & 1) * 32 + (swz % 64) / 2; }
__host__ __device__ __forceinline__ int perm32(int rho) { const int n = rho >> 4, i = rho & 15; return 8 * (i >> 2) + 4 * n + (i & 3); }

struct Unit { int pm, pn; };
struct Gemm { const bf16_t* A; const bf16_t* Bt; int M, N, K; };

struct StaticOrder {
    int nM, nN, nwg, G, c;
    __host__ __device__ void init(int M, int N, int G_, int c_) { nM = M / BM; nN = N / BM; nwg = nM * nN; G = G_; c = c_; }
    __host__ __device__ bool next(int i, Unit& u) const {
        const long L = (long)i * G + c; if (L >= nwg) return false;
        int wgid = (int)L; { const int q = nwg / NXCD, r = nwg % NXCD, xcd = wgid % NXCD, off = wgid / NXCD; wgid = (xcd < r ? xcd * (q + 1) : r * (q + 1) + (xcd - r) * q) + off; }
        const int nig = WGM * nN, gid = wgid / nig, fm = gid * WGM, gsz = (nM - fm) < WGM ? (nM - fm) : WGM;
        u.pm = fm + ((wgid % nig) % gsz); u.pn = (wgid % nig) / gsz; return true;
    }
    __device__ __forceinline__ void a_ready(const Unit&) const {}
    __device__ __forceinline__ void done(const Unit&) const {}
};

__device__ __forceinline__ unsigned cvt_pk_bf16(float lo, float hi) { unsigned r; asm volatile("v_cvt_pk_bf16_f32 %0, %1, %2" : "=v"(r) : "v"(lo), "v"(hi)); return r; }
typedef float f32x2 __attribute__((ext_vector_type(2)));
template <class Epi, class Sched, bool ALIGN_EPI = false, bool SP2 = false>
__device__ __forceinline__ void gemm_phase(PG8_LAS unsigned char* lds, const Gemm g, const Sched& S, const Epi& E) {
    const int tid = threadIdx.x, wid = __builtin_amdgcn_readfirstlane(tid >> 6), lane = tid & 63, wr = wid >> 2, wc = wid & 3, fr = lane & 15, fq = lane >> 4;
    const int K = g.K, nt = K / BK;
    unsigned voffA[2], voffB[2];
#pragma unroll
    for (int i = 0; i < 2; ++i) { int R, C; stage_rc(tid * 16 + i * 8192, R, C); const int Rb = Epi::PERM ? ((R & ~31) + perm32(R & 31)) : R;
        voffA[i] = (unsigned)(R * K + C) * 2u; voffB[i] = (unsigned)(Rb * K + C) * 2u; }
    const size_t kstep = (size_t)(BK * 2);
    const size_t hstep = (size_t)HALF * K * 2;
    const size_t tstep = 2 * hstep;
    const unsigned ldsw = (unsigned)wid * 1024u;
    const int aoff = lds_byte(wr * 64 + fr, fq * 8), boff = lds_byte(wc * 32 + fr, fq * 8);
#define PG8_SA(b, h) (((b) * 2 + (h)) * HTB)
#define PG8_SB(b, h) ((4 + (b) * 2 + (h)) * HTB)
#define PG8_STAGE(bufoff, gbase, voff) do { _Pragma("unroll") for (int _i = 0; _i < 2; ++_i) \
        __builtin_amdgcn_global_load_lds((const unsigned*)((const char*)(gbase) + (voff)[_i]), (PG8_LAS unsigned*)(lds + (bufoff) + ldsw + _i * 8192), 16, 0, 0); } while (0)
#define PG8_LDA(dst, b, h) do { _Pragma("unroll") for (int m = 0; m < 4; ++m) _Pragma("unroll") for (int k = 0; k < 2; ++k) dst[m][k] = *(const PG8_LAS bf16x8*)(lds + PG8_SA(b, h) + aoff + m * 2048 + k * 1024); } while (0)
#define PG8_LDB(dst, b, h) do { _Pragma("unroll") for (int n = 0; n < 2; ++n) _Pragma("unroll") for (int k = 0; k < 2; ++k) dst[n][k] = *(const PG8_LAS bf16x8*)(lds + PG8_SB(b, h) + boff + n * 2048 + k * 1024); } while (0)
#define PG8_MMA(ai, bj, At, Bt) do { __builtin_amdgcn_s_setprio(1); _Pragma("unroll") for (int m = 0; m < 4; ++m) _Pragma("unroll") for (int n = 0; n < 2; ++n) _Pragma("unroll") for (int k = 0; k < 2; ++k) \
        acc[ai][bj][m][n] = __builtin_amdgcn_mfma_f32_16x16x32_bf16(Bt[n][k], At[m][k], acc[ai][bj][m][n], 0, 0, 0); __builtin_amdgcn_s_setprio(0); } while (0)
#define PG8_WAIT_V(n) asm volatile("s_waitcnt vmcnt(" #n ")" ::: "memory")
#define PG8_WAIT_L(n) asm volatile("s_waitcnt lgkmcnt(" #n ")" ::: "memory")
#define PG8_BAR __builtin_amdgcn_s_barrier()
#define PG8_SCHED __builtin_amdgcn_sched_barrier(0)
    Unit cur, nxt; int ui = 0;
    if (!S.next(0, cur)) return;
    f32x4 acc[2][2][4][2];
#pragma unroll
    for (int a = 0; a < 2; ++a)
#pragma unroll
        for (int b = 0; b < 2; ++b)
#pragma unroll
            for (int m = 0; m < 4; ++m)
#pragma unroll
                for (int n = 0; n < 2; ++n) acc[a][b][m][n] = (f32x4){0.f, 0.f, 0.f, 0.f};
    bf16x8 At[4][2], B0[2][2], B1[2][2];
    const char* cA = (const char*)g.A + (size_t)cur.pm * tstep; const char* cB = (const char*)g.Bt + (size_t)cur.pn * tstep;
    S.a_ready(cur);
    if constexpr (SP2) {
        PG8_STAGE(PG8_SB(0, 0), cB, voffB); PG8_STAGE(PG8_SB(0, 1), cB + hstep, voffB); PG8_STAGE(PG8_SA(0, 0), cA, voffA); PG8_STAGE(PG8_SA(0, 1), cA + hstep, voffA);
        if (wr == 1) PG8_BAR;
        PG8_WAIT_V(2); PG8_BAR;
        PG8_STAGE(PG8_SB(1, 0), cB + kstep, voffB); PG8_STAGE(PG8_SA(1, 0), cA + kstep, voffA); PG8_STAGE(PG8_SB(1, 1), cB + hstep + kstep, voffB);
        PG8_WAIT_V(6); PG8_BAR;
    } else {
        PG8_STAGE(PG8_SB(0, 0), cB, voffB); PG8_STAGE(PG8_SA(0, 0), cA, voffA); PG8_STAGE(PG8_SB(0, 1), cB + hstep, voffB); PG8_STAGE(PG8_SA(0, 1), cA + hstep, voffA);
        if (wr == 1) PG8_BAR;
        PG8_WAIT_V(4); PG8_BAR;
        PG8_STAGE(PG8_SB(1, 0), cB + kstep, voffB); PG8_STAGE(PG8_SA(1, 0), cA + kstep, voffA); PG8_STAGE(PG8_SB(1, 1), cB + hstep + kstep, voffB);
        PG8_WAIT_V(6); PG8_BAR;
    }
    for (;;) {
        const bool has_next = S.next(ui + 1, nxt);
        const char* nA = has_next ? (const char*)g.A + (size_t)nxt.pm * tstep : cA; const char* nB = has_next ? (const char*)g.Bt + (size_t)nxt.pn * tstep : cB;
        for (int t = 0; t < nt; t += 2) {
            const bool last = (t == nt - 2);
            const char* a1 = cA + (size_t)(t + 1) * kstep;
            const char* a2 = last ? nA : cA + (size_t)(t + 2) * kstep; const char* b2 = last ? nB : cB + (size_t)(t + 2) * kstep;
            const char* a3 = a2 + kstep; const char* b3 = b2 + kstep;
            if (last && has_next) S.a_ready(nxt);
            if constexpr (SP2) {
            PG8_LDB(B0, 0, 0); PG8_LDB(B1, 0, 1); PG8_SCHED; PG8_LDA(At, 0, 0); PG8_STAGE(PG8_SA(1, 1), a1 + hstep, voffA);
            PG8_WAIT_V(8); PG8_WAIT_L(0); PG8_BAR; PG8_MMA(0, 0, At, B0); PG8_MMA(0, 1, At, B1); PG8_BAR; PG8_SCHED;
            PG8_LDA(At, 0, 1); PG8_STAGE(PG8_SB(0, 0), b2, voffB); PG8_STAGE(PG8_SB(0, 1), b2 + hstep, voffB); PG8_STAGE(PG8_SA(0, 0), a2, voffA);
            PG8_WAIT_V(8); PG8_WAIT_L(0); PG8_BAR; PG8_MMA(1, 0, At, B0); PG8_MMA(1, 1, At, B1); PG8_BAR; PG8_SCHED;
            PG8_LDB(B0, 1, 0); PG8_LDB(B1, 1, 1); PG8_SCHED; PG8_LDA(At, 1, 0); PG8_STAGE(PG8_SA(0, 1), a2 + hstep, voffA);
            PG8_WAIT_V(8); PG8_WAIT_L(0); PG8_BAR; PG8_MMA(0, 0, At, B0); PG8_MMA(0, 1, At, B1); PG8_BAR; PG8_SCHED;
            PG8_LDA(At, 1, 1); PG8_STAGE(PG8_SB(1, 0), b3, voffB); PG8_STAGE(PG8_SB(1, 1), b3 + hstep, voffB); PG8_STAGE(PG8_SA(1, 0), a3, voffA);
            PG8_WAIT_V(8); PG8_WAIT_L(0); PG8_BAR; PG8_MMA(1, 0, At, B0); PG8_MMA(1, 1, At, B1); PG8_BAR; PG8_SCHED;
            } else {
            PG8_LDB(B0, 0, 0); PG8_SCHED; PG8_LDA(At, 0, 0); PG8_STAGE(PG8_SA(1, 1), a1 + hstep, voffA);
            PG8_WAIT_L(8); PG8_BAR; PG8_WAIT_L(0); PG8_MMA(0, 0, At, B0); PG8_BAR; PG8_SCHED;
            PG8_LDB(B1, 0, 1); PG8_STAGE(PG8_SB(0, 0), b2, voffB);
            PG8_BAR; PG8_WAIT_L(0); PG8_MMA(0, 1, At, B1); PG8_BAR;
            PG8_LDA(At, 0, 1); PG8_STAGE(PG8_SA(0, 0), a2, voffA);
            PG8_BAR; PG8_WAIT_L(0); PG8_MMA(1, 0, At, B0); PG8_BAR; PG8_SCHED;
            PG8_STAGE(PG8_SB(0, 1), b2 + hstep, voffB);
            PG8_WAIT_V(6); PG8_BAR; PG8_MMA(1, 1, At, B1); PG8_BAR;
            PG8_LDB(B0, 1, 0); PG8_SCHED; PG8_LDA(At, 1, 0); PG8_STAGE(PG8_SA(0, 1), a2 + hstep, voffA);
            PG8_WAIT_L(8); PG8_BAR; PG8_WAIT_L(0); PG8_MMA(0, 0, At, B0); PG8_BAR; PG8_SCHED;
            PG8_LDB(B1, 1, 1); PG8_STAGE(PG8_SB(1, 0), b3, voffB);
            PG8_BAR; PG8_WAIT_L(0); PG8_MMA(0, 1, At, B1); PG8_BAR;
            PG8_LDA(At, 1, 1); PG8_STAGE(PG8_SA(1, 0), a3, voffA);
            PG8_BAR; PG8_WAIT_L(0); PG8_MMA(1, 0, At, B0); PG8_BAR; PG8_SCHED;
            PG8_STAGE(PG8_SB(1, 1), b3 + hstep, voffB);
            PG8_WAIT_V(6); PG8_BAR; PG8_MMA(1, 1, At, B1); PG8_BAR;
            }
        }
        if constexpr (ALIGN_EPI) { if (wr == 0) PG8_BAR; }
        if constexpr (!Epi::AFTER_DRAIN) { E(acc, cur, wr, wc, fr, fq); S.done(cur); }
        if (!has_next) break;
#pragma unroll
        for (int a = 0; a < 2; ++a)
#pragma unroll
            for (int b = 0; b < 2; ++b)
#pragma unroll
                for (int m = 0; m < 4; ++m)
#pragma unroll
                    for (int n = 0; n < 2; ++n) acc[a][b][m][n] = (f32x4){0.f, 0.f, 0.f, 0.f};
        cur = nxt; cA = nA; cB = nB; ++ui;
        if constexpr (ALIGN_EPI) { if (wr == 1) PG8_BAR; }
    }
    PG8_WAIT_V(0);
    if constexpr (!ALIGN_EPI) { if (wr == 0) PG8_BAR; }
    PG8_BAR;
    if constexpr (Epi::AFTER_DRAIN) { E.fused(acc, cur, wr, wc, fr, fq, lds, wid, lane); S.done(cur); }
#undef PG8_SA
#undef PG8_SB
#undef PG8_STAGE
#undef PG8_LDA
#undef PG8_LDB
#undef PG8_MMA
#undef PG8_WAIT_V
#undef PG8_WAIT_L
#undef PG8_BAR
#undef PG8_SCHED
}
}

#define GAS __attribute__((address_space(1)))
#define LAS __attribute__((address_space(3)))
typedef unsigned short bf16;
typedef unsigned u32x4 __attribute__((ext_vector_type(4)));
typedef unsigned u32x2 __attribute__((ext_vector_type(2)));
typedef float f32x4 __attribute__((ext_vector_type(4)));
using pg8::cvt_pk_bf16;

constexpr int NWAVES = 8, NTHR = 512;
constexpr int T = 32768, SEQ = 8192, NB = 4, DM = 1024;
constexpr int DIN = 5792, N1 = 5888;
constexpr float EPS = 1e-6f, LOG2E = 1.4426950408889634f;
constexpr float QA_SCALE = 0.125f * LOG2E;
constexpr float QB_SCALE = 0.10206207261596575f * LOG2E;

constexpr size_t MiB = 1u << 20;
constexpr size_t WS_CTL = 0, WS_BT = 64 * 1024;
constexpr size_t WS_SSCQ = 1 * MiB, WS_SSCKV = 1 * MiB + 512 * 1024;
constexpr size_t WS_KR = 2 * MiB, WS_ROPE = 4 * MiB;
constexpr size_t WS_BT1 = 8 * MiB, WS_BT3 = 20 * MiB, WS_WOUT = 24 * MiB, WS_WG = 26 * MiB, WS_BT2 = 28 * MiB, WS_WPP = 30 * MiB;
constexpr size_t WS_XN = 32 * MiB;
constexpr size_t WS_QA = 96 * MiB;
constexpr size_t WS_KVA = 160 * MiB;
constexpr size_t WS_CQKV = 176 * MiB;
constexpr size_t WS_SGA = 208 * MiB, WS_SGB = 272 * MiB;
constexpr size_t WS_QBN = 336 * MiB;
constexpr size_t WS_QBR = 400 * MiB;
constexpr size_t WS_KN = 432 * MiB;
constexpr size_t WS_END = 496 * MiB;
constexpr size_t WS_VB = WS_XN, WS_X1B = WS_XN, WS_ER = WS_QA, WS_PB = WS_KVA, WS_SSX1 = WS_CQKV, WS_SSE = WS_CQKV + 2 * MiB, WS_MG = WS_KN;

constexpr int RING_BYTES = 131072, LDS_BYTES = 147456;

#define LDS_WAIT() asm volatile("s_waitcnt lgkmcnt(0)" ::: "memory")
__device__ __forceinline__ unsigned f2bf(float f) { unsigned u = __builtin_bit_cast(unsigned, f); return (u + 0x7fffu + ((u >> 16) & 1u)) >> 16; }
__device__ __forceinline__ unsigned pk2(float lo, float hi) { return f2bf(lo) | (f2bf(hi) << 16); }
__device__ __forceinline__ float bf2f(unsigned short b) { return __builtin_bit_cast(float, (unsigned)b << 16); }
__device__ __forceinline__ float bflo(unsigned w) { return __builtin_bit_cast(float, w << 16); }
__device__ __forceinline__ float bfhi(unsigned w) { return __builtin_bit_cast(float, w & 0xffff0000u); }
__device__ __forceinline__ float sigmoidf_(float v) { return __builtin_amdgcn_rcpf(1.0f + __builtin_amdgcn_exp2f(-v * LOG2E)); }
__device__ __forceinline__ void st8(bf16* p, f32x4 a, f32x4 b) { u32x4 w; w.x = cvt_pk_bf16(a[0], a[1]); w.y = cvt_pk_bf16(a[2], a[3]); w.z = cvt_pk_bf16(b[0], b[1]); w.w = cvt_pk_bf16(b[2], b[3]); *(u32x4*)p = w; }
__device__ __forceinline__ float sumsq4(f32x4 a) { return (a[0] * a[0] + a[1] * a[1]) + (a[2] * a[2] + a[3] * a[3]); }
__device__ __forceinline__ float red_fq(float s) { s += __shfl_xor(s, 16); s += __shfl_xor(s, 32); return s; }

struct Args { const float* in[24]; float* out; unsigned char* ws; int ph_lo, ph_hi; };

struct Frame {
    LAS unsigned char* lds;
    int tid, lane, wave, vcu, G;
};

struct Order2 {
    pg8::StaticOrder so;
    __device__ bool next(int i, pg8::Unit& u) const { if (!so.next(i, u)) return false; if (u.pn >= 6) u.pm += 128; return true; }
    __device__ __forceinline__ void a_ready(const pg8::Unit&) const {}
    __device__ __forceinline__ void done(const pg8::Unit&) const {}
};
struct Order3 {
    pg8::StaticOrder so; int pm_off;
    __device__ bool next(int i, pg8::Unit& u) const { if (!so.next(i >> 1, u)) return false; if (i & 1) { u.pm += pm_off; u.pn += 4; } return true; }
    __device__ __forceinline__ void a_ready(const pg8::Unit&) const {}
    __device__ __forceinline__ void done(const pg8::Unit&) const {}
};

typedef const pg8::f32x4 (&AccRef)[2][2][4][2];


__device__ __forceinline__ float acc_ss(AccRef acc, int ai, int m) { return (sumsq4(acc[ai][0][m][0]) + sumsq4(acc[ai][0][m][1])) + (sumsq4(acc[ai][1][m][0]) + sumsq4(acc[ai][1][m][1])); }
__device__ __forceinline__ void epi_raw(AccRef acc, bf16* base, int ld, int row0, int lc0) {
#pragma unroll
    for (int ai = 0; ai < 2; ++ai)
#pragma unroll
        for (int m = 0; m < 4; ++m) { bf16* dst = base + (size_t)(row0 + ai * 128 + m * 16) * ld + lc0;
#pragma unroll
            for (int bj = 0; bj < 2; ++bj) st8(dst + 32 * bj, acc[ai][bj][m][0], acc[ai][bj][m][1]); }
}
__device__ __forceinline__ void epi_raw_ss(AccRef acc, bf16* base, int ld, int row0, int lc0, float* ssp, int nss, int idx, int fq) {
#pragma unroll
    for (int ai = 0; ai < 2; ++ai)
#pragma unroll
        for (int m = 0; m < 4; ++m) { const int row = row0 + ai * 128 + m * 16; const float ss = red_fq(acc_ss(acc, ai, m));
            if (fq == 0) ssp[(size_t)row * nss + idx] = ss;
            bf16* dst = base + (size_t)row * ld + lc0;
#pragma unroll
            for (int bj = 0; bj < 2; ++bj) st8(dst + 32 * bj, acc[ai][bj][m][0], acc[ai][bj][m][1]); }
}
__device__ __forceinline__ void epi_headnorm(AccRef acc, bf16* base, int ld, int row0, int lc0, const float* g, float sc, int fq) {
    f32x4 gv[2][2];
#pragma unroll
    for (int bj = 0; bj < 2; ++bj)
#pragma unroll
        for (int n = 0; n < 2; ++n) gv[bj][n] = *(const f32x4*)(g + 32 * bj + 8 * fq + 4 * n) * sc;
#pragma unroll
    for (int ai = 0; ai < 2; ++ai)
#pragma unroll
        for (int m = 0; m < 4; ++m) { const int row = row0 + ai * 128 + m * 16; const float r = rsqrtf(red_fq(acc_ss(acc, ai, m)) * (1.0f / 64.0f) + EPS);
            bf16* dst = base + (size_t)row * ld + lc0;
#pragma unroll
            for (int bj = 0; bj < 2; ++bj) st8(dst + 32 * bj, acc[ai][bj][m][0] * gv[bj][0] * r, acc[ai][bj][m][1] * gv[bj][1] * r); }
}
template <bool SILU> __device__ __forceinline__ void epi_act(AccRef acc, bf16* base, int row0, int lc0) {
#pragma unroll
    for (int ai = 0; ai < 2; ++ai)
#pragma unroll
        for (int m = 0; m < 4; ++m) { bf16* dst = base + (size_t)(row0 + ai * 128 + m * 16) * 1024 + lc0;
#pragma unroll
            for (int bj = 0; bj < 2; ++bj) { f32x4 v0 = acc[ai][bj][m][0], v1 = acc[ai][bj][m][1], o0, o1;
#pragma unroll
                for (int e = 0; e < 4; ++e) { const float s0 = sigmoidf_(v0[e]), s1 = sigmoidf_(v1[e]); o0[e] = SILU ? v0[e] * s0 : s0; o1[e] = SILU ? v1[e] * s1 : s1; }
                st8(dst + 32 * bj, o0, o1); } }
}

struct Epi1 {
    static constexpr bool PERM = true, AFTER_DRAIN = false;
    float* out; unsigned char* ws; const float *gq, *gk, *gkr;
    __device__ __forceinline__ void operator()(AccRef acc, const pg8::Unit& u, int wr, int wc, int, int) const {
        int ln_ = threadIdx.x & 63; asm volatile("" : "+v"(ln_)); const int fr = ln_ & 15, fq = ln_ >> 4;
        const int row0 = u.pm * 256 + wr * 64 + fr, pn = u.pn, lc0 = 64 * wc + 8 * fq;
        if (pn < 4) {
            epi_headnorm(acc, (bf16*)(ws + WS_QA) + pn * 256, 1024, row0, lc0, gq, QA_SCALE, fq);
        } else if (pn == 4) {
            if (wc < 2) epi_headnorm(acc, (bf16*)(ws + WS_KVA), 256, row0, lc0, gk, 1.0f, fq);
            else epi_raw(acc, (bf16*)(ws + WS_KVA), 256, row0, lc0);
        } else if (pn <= 8) {
            epi_act<true>(acc, (bf16*)out + (pn - 5) * 256, row0, lc0);
        } else if (pn == 9) {
            epi_raw_ss(acc, (bf16*)(ws + WS_CQKV), 256, row0, lc0, (float*)(ws + WS_SSCQ), 4, wc, fq);
        } else if (pn == 10) {
            bf16* base = (bf16*)(ws + WS_CQKV) + (size_t)T * 256;
            if (wc < 2) epi_raw_ss(acc, base, 256, row0, lc0, (float*)(ws + WS_SSCKV), 2, wc, fq);
            else {
                const f32x4 z4 = (f32x4){0.f, 0.f, 0.f, 0.f};
                f32x4 gv[2];
#pragma unroll
                for (int n = 0; n < 2; ++n) gv[n] = *(const f32x4*)(gkr + 8 * fq + 4 * n);
                const float* rope = (const float*)(ws + WS_ROPE); bf16* KR = (bf16*)(ws + WS_KR);
#pragma unroll
                for (int ai = 0; ai < 2; ++ai)
#pragma unroll
                    for (int m = 0; m < 4; ++m) {
                        const int row = row0 + ai * 128 + m * 16;
                        bf16* dst = base + (size_t)row * 256 + lc0;
                        st8(dst, z4, z4); st8(dst + 32, z4, z4);
                        if (wc == 2) {
                            const float ss = red_fq(sumsq4(acc[ai][0][m][0]) + sumsq4(acc[ai][0][m][1]));
                            const float r = rsqrtf(ss * (1.0f / 32.0f) + EPS);
                            const f32x4 a0 = acc[ai][0][m][0] * gv[0] * r, a1 = acc[ai][0][m][1] * gv[1] * r;
                            f32x4 p0, p1;
#pragma unroll
                            for (int e = 0; e < 4; ++e) { p0[e] = __shfl_xor(a0[e], 32); p1[e] = __shfl_xor(a1[e], 32); }
                            const float* rp = rope + (size_t)row * 32 + 8 * (fq & 1);
                            const f32x4 c0 = *(const f32x4*)(rp), c1 = *(const f32x4*)(rp + 4), s0 = *(const f32x4*)(rp + 16), s1 = *(const f32x4*)(rp + 20);
                            const float sg = fq < 2 ? -1.0f : 1.0f;
                            st8(KR + (size_t)row * 32 + 8 * fq, a0 * c0 + p0 * s0 * sg, a1 * c1 + p1 * s1 * sg);
                        }
                        asm volatile("" ::: "memory");
                    }
            }
        } else if (pn <= 14) {
            epi_act<true>(acc, (bf16*)out + (size_t)T * 1024 + (pn - 11) * 256, row0, lc0);
        } else {
            epi_act<false>(acc, (bf16*)(ws + WS_SGA) + (size_t)(pn >= 19 ? 1 : 0) * ((size_t)T * 1024) + ((pn - 15) & 3) * 256, row0, lc0);
        }
    }
};
static_assert(WS_SGB == WS_SGA + (size_t)T * 1024 * 2, "SGA and SGB adjacent");

struct Epi2 {
    static constexpr bool PERM = true, AFTER_DRAIN = false;
    unsigned char* ws; const float* gkn;
    __device__ __forceinline__ void operator()(AccRef acc, const pg8::Unit& u, int wr, int wc, int, int) const {
        int ln_ = threadIdx.x & 63; asm volatile("" : "+v"(ln_)); const int fr = ln_ & 15, fq = ln_ >> 4;
        const int row0 = (u.pm & 127) * 256 + wr * 64 + fr, pn = u.pn, lc0 = 64 * wc + 8 * fq;
        if (pn < 4) epi_raw(acc, (bf16*)(ws + WS_QBN) + pn * 256, 1024, row0, lc0);
        else if (pn < 6) epi_raw(acc, (bf16*)(ws + WS_QBR) + (pn - 4) * 256, 512, row0, lc0);
        else {
            const float* SSCKV = (const float*)(ws + WS_SSCKV);
            if (pn < 10) {
                bf16* base = (bf16*)(ws + WS_KN) + (pn - 6) * 256;
                f32x4 gv[2][2];
#pragma unroll
                for (int bj = 0; bj < 2; ++bj)
#pragma unroll
                    for (int n = 0; n < 2; ++n) gv[bj][n] = *(const f32x4*)(gkn + 32 * bj + 8 * fq + 4 * n);
#pragma unroll
                for (int ai = 0; ai < 2; ++ai)
#pragma unroll
                    for (int m = 0; m < 4; ++m) { const int row = row0 + ai * 128 + m * 16;
                        const float msl = (SSCKV[(size_t)row * 2] + SSCKV[(size_t)row * 2 + 1]) * (1.0f / 128.0f) + EPS;
                        const float r = rsqrtf(red_fq(acc_ss(acc, ai, m)) * (1.0f / 64.0f) + EPS * msl);
                        bf16* dst = base + (size_t)row * 1024 + lc0;
#pragma unroll
                        for (int bj = 0; bj < 2; ++bj) st8(dst + 32 * bj, acc[ai][bj][m][0] * gv[bj][0] * r, acc[ai][bj][m][1] * gv[bj][1] * r);
                        asm volatile("" ::: "memory"); }
            } else {
                bf16* base = (bf16*)(ws + WS_VB) + (pn - 10) * 256;
#pragma unroll
                for (int ai = 0; ai < 2; ++ai)
#pragma unroll
                    for (int m = 0; m < 4; ++m) { const int row = row0 + ai * 128 + m * 16;
                        const float r = rsqrtf((SSCKV[(size_t)row * 2] + SSCKV[(size_t)row * 2 + 1]) * (1.0f / 128.0f) + EPS);
                        bf16* dst = base + (size_t)row * 1024 + lc0;
#pragma unroll
                        for (int bj = 0; bj < 2; ++bj) st8(dst + 32 * bj, acc[ai][bj][m][0] * r, acc[ai][bj][m][1] * r);
                        asm volatile("" ::: "memory"); }
            }
        }
    }
};

struct Epi3 {
    static constexpr bool PERM = true, AFTER_DRAIN = false;
    bf16* MG; const bf16 *SGA, *SGB; int pm_off;
    __device__ __forceinline__ void operator()(AccRef acc, const pg8::Unit& u, int wr, int wc, int, int) const {
        int ln_ = threadIdx.x & 63; asm volatile("" : "+v"(ln_)); const int fr = ln_ & 15, fq = ln_ >> 4;
        const bool sub = u.pn >= 4; const int pn = u.pn & 3, pm = sub ? u.pm - pm_off : u.pm;
        const int row0 = pm * 256 + wr * 64 + fr, lc0 = pn * 256 + 64 * wc + 8 * fq;
        const bf16* SG = SGA + (size_t)(sub ? 1 : 0) * ((size_t)T * 1024);
#pragma unroll
        for (int ai = 0; ai < 2; ++ai)
#pragma unroll
            for (int m = 0; m < 4; ++m) {
                const size_t off = (size_t)(row0 + ai * 128 + m * 16) * 1024 + lc0;
#pragma unroll
                for (int bj = 0; bj < 2; ++bj) {
                    const u32x4 g = *(const u32x4*)(SG + off + 32 * bj);
                    f32x4 v0 = acc[ai][bj][m][0], v1 = acc[ai][bj][m][1];
                    v0[0] *= bflo(g.x); v0[1] *= bfhi(g.x); v0[2] *= bflo(g.y); v0[3] *= bfhi(g.y);
                    v1[0] *= bflo(g.z); v1[1] *= bfhi(g.z); v1[2] *= bflo(g.w); v1[3] *= bfhi(g.w);
                    if (sub) { const u32x4 p = *(const u32x4*)(MG + off + 32 * bj);
                        v0[0] += bflo(p.x); v0[1] += bfhi(p.x); v0[2] += bflo(p.y); v0[3] += bfhi(p.y);
                        v1[0] += bflo(p.z); v1[1] += bfhi(p.z); v1[2] += bflo(p.w); v1[3] += bfhi(p.w); }
                    st8(MG + off + 32 * bj, v0, v1);
                }
            }
    }
};

struct Epi4 {
    static constexpr bool PERM = false, AFTER_DRAIN = false;
    const float* x; float* out; bf16* X1B; float* SSX1;
    __device__ __forceinline__ void operator()(AccRef acc, const pg8::Unit& u, int wr, int wc, int, int) const {
        int ln_ = threadIdx.x & 63; asm volatile("" : "+v"(ln_)); const int fr = ln_ & 15, fq = ln_ >> 4;
        const int row0 = u.pm * 256 + wr * 64 + fr, c0 = u.pn * 256 + 32 * wc + 4 * fq;
#pragma unroll
        for (int ai = 0; ai < 2; ++ai)
#pragma unroll
            for (int m = 0; m < 4; ++m) {
                const int row = row0 + ai * 128 + m * 16; float ss = 0.f;
#pragma unroll
                for (int bj = 0; bj < 2; ++bj)
#pragma unroll
                    for (int n = 0; n < 2; ++n) {
                        const size_t off = (size_t)row * 1024 + c0 + 128 * bj + 16 * n;
                        const f32x4 v = *(const f32x4*)(x + off) + acc[ai][bj][m][n];
                        *(f32x4*)(out + off) = v; ss += sumsq4(v);
                        u32x2 w; w.x = cvt_pk_bf16(v[0], v[1]); w.y = cvt_pk_bf16(v[2], v[3]); *(u32x2*)(X1B + off) = w;
                    }
                ss = red_fq(ss);
                if (fq == 0) SSX1[(size_t)row * 16 + u.pn * 4 + wc] = ss;
            }
    }
};

struct EpiE {
    static constexpr bool PERM = true, AFTER_DRAIN = false;
    bf16* ER; float* SSE;
    __device__ __forceinline__ void operator()(AccRef acc, const pg8::Unit& u, int wr, int wc, int, int) const {
        int ln_ = threadIdx.x & 63; asm volatile("" : "+v"(ln_)); const int fr = ln_ & 15, fq = ln_ >> 4;
        const int row0 = u.pm * 256 + wr * 64 + fr, lc0 = u.pn * 256 + 64 * wc + 8 * fq;
#pragma unroll
        for (int ai = 0; ai < 2; ++ai)
#pragma unroll
            for (int m = 0; m < 4; ++m) {
                const int row = row0 + ai * 128 + m * 16;
                float ss = (sumsq4(acc[ai][0][m][0]) + sumsq4(acc[ai][0][m][1])) + (sumsq4(acc[ai][1][m][0]) + sumsq4(acc[ai][1][m][1]));
                ss = red_fq(ss);
                if (fq == 0) SSE[(size_t)row * 16 + u.pn * 4 + wc] = ss;
                bf16* dst = ER + (size_t)row * 1024 + lc0;
#pragma unroll
                for (int bj = 0; bj < 2; ++bj) st8(dst + 32 * bj, acc[ai][bj][m][0], acc[ai][bj][m][1]);
            }
    }
};

struct Epi5 {
    static constexpr bool PERM = false, AFTER_DRAIN = false;
    float* out; const bf16* ER; const float *SSX1, *SSE, *gpost;
    __device__ __forceinline__ void operator()(AccRef acc, const pg8::Unit& u, int wr, int wc, int, int) const {
        int ln_ = threadIdx.x & 63; asm volatile("" : "+v"(ln_)); const int fr = ln_ & 15, fq = ln_ >> 4;
        const int row0 = u.pm * 256 + wr * 64 + fr, c0 = u.pn * 256 + 32 * wc + 4 * fq;
        f32x4 gp[2][2];
#pragma unroll
        for (int bj = 0; bj < 2; ++bj)
#pragma unroll
            for (int n = 0; n < 2; ++n) gp[bj][n] = *(const f32x4*)(gpost + c0 + 128 * bj + 16 * n);
#pragma unroll
        for (int ai = 0; ai < 2; ++ai)
#pragma unroll
            for (int m = 0; m < 4; ++m) {
                const int row = row0 + ai * 128 + m * 16;
                float s1 = 0.f, se = 0.f;
#pragma unroll
                for (int j = 0; j < 4; ++j) { const f32x4 a = *(const f32x4*)(SSX1 + (size_t)row * 16 + 4 * j), b = *(const f32x4*)(SSE + (size_t)row * 16 + 4 * j);
                    s1 += (a[0] + a[1]) + (a[2] + a[3]); se += (b[0] + b[1]) + (b[2] + b[3]); }
                const float r1 = rsqrtf(s1 * (1.0f / 1024.0f) + EPS), re = rsqrtf(se * (1.0f / 1024.0f) + EPS);
#pragma unroll
                for (int bj = 0; bj < 2; ++bj)
#pragma unroll
                    for (int n = 0; n < 2; ++n) {
                        const size_t off = (size_t)row * 1024 + c0 + 128 * bj + 16 * n;
                        const f32x4 x1 = *(const f32x4*)(out + off); const u32x2 e = *(const u32x2*)(ER + off);
                        const f32x4 a = acc[ai][bj][m][n] * r1; f32x4 em = (f32x4){bflo(e.x), bfhi(e.x), bflo(e.y), bfhi(e.y)}; em = em * gp[bj][n] * re;
                        f32x4 o;
#pragma unroll
                        for (int q = 0; q < 4; ++q) o[q] = x1[q] + sigmoidf_(a[q]) * em[q];
                        *(f32x4*)(out + off) = o;
                    }
            }
    }
};

__device__ __forceinline__ float wave_sum(float v) {
#pragma unroll
    for (int o = 1; o < 64; o <<= 1) v += __shfl_xor(v, o);
    return v;
}
__device__ __forceinline__ void tr_item(const float* W, int ldw, int srcc0, int krows, const float* kg, bf16* WT, int K, int drow0, int k0, LAS float* scr, int lane) {
#pragma unroll 8
    for (int i = 0; i < 32; ++i) { const int kk = 2 * i + (lane >> 5), k = k0 + kk; float v = 0.f;
        if (srcc0 >= 0 && k < krows) { v = W[(size_t)k * ldw + srcc0 + (lane & 31)]; if (kg) v *= kg[k]; }
        scr[kk * 33 + (lane & 31)] = v; }
    LDS_WAIT(); asm volatile("" ::: "memory");
    const int c = lane & 7;
#pragma unroll
    for (int j = 0; j < 4; ++j) { const int n = (lane >> 3) + 8 * j; const LAS float* s = scr + (8 * c) * 33 + n;
        u32x4 o; o.x = pk2(s[0 * 33], s[1 * 33]); o.y = pk2(s[2 * 33], s[3 * 33]); o.z = pk2(s[4 * 33], s[5 * 33]); o.w = pk2(s[6 * 33], s[7 * 33]);
        *(u32x4*)(WT + (size_t)(drow0 + n) * K + k0 + 8 * c) = o; }
    LDS_WAIT(); asm volatile("" ::: "memory");
}
__device__ __forceinline__ void sincos_red(double a, double& s, double& c) {
    const double k = rint(a * 0.63661977236758134308); const double r = fma(-k, 6.123233995736766e-17, fma(-k, 1.5707963267948966, a)); const double r2 = r * r;
    double sp = -1.0 / 1307674368000.0; sp = fma(sp, r2, 1.0 / 6227020800.0); sp = fma(sp, r2, -1.0 / 39916800.0); sp = fma(sp, r2, 1.0 / 362880.0); sp = fma(sp, r2, -1.0 / 5040.0); sp = fma(sp, r2, 1.0 / 120.0); sp = fma(sp, r2, -1.0 / 6.0); sp = fma(sp * r2, r, r);
    double cp = 1.0 / 20922789888000.0; cp = fma(cp, r2, -1.0 / 87178291200.0); cp = fma(cp, r2, 1.0 / 479001600.0); cp = fma(cp, r2, -1.0 / 3628800.0); cp = fma(cp, r2, 1.0 / 40320.0); cp = fma(cp, r2, -1.0 / 720.0); cp = fma(cp, r2, 1.0 / 24.0); cp = fma(cp, r2, -0.5); cp = fma(cp, r2, 1.0);
    const int q = (int)k & 3;
    s = (q == 0) ? sp : (q == 1) ? cp : (q == 2) ? -sp : -cp; c = (q == 0) ? cp : (q == 1) ? -sp : (q == 2) ? -cp : sp;
}
__device__ __forceinline__ int hp_row(int L0) { const int lc = L0 & 255; return (L0 & ~255) + 128 * ((lc >> 5) & 1) + 32 * (lc >> 6); }

__device__ __forceinline__ void p0_prologue(Frame& F, const Args& a) {
    unsigned char* ws = a.ws;
    LAS float* scr = (LAS float*)(F.lds + F.wave * 16384);
    const int gw = F.vcu * NWAVES + F.wave, NGW = F.G * NWAVES, lane = F.lane;
    constexpr int I1 = (N1 / 32) * 16, I2 = 32 * 16, I5 = 48 * 4, I6 = 32 * 4;
    constexpr int NITEMS = I1 + 4 * I2 + I5 + 3 * I6;
    for (int it = gw; it < NITEMS; it += NGW) {
        int r = it;
        if (r < I1) { const int nb = r / 16, kb = r % 16, L0 = nb * 32; const int src = L0 < 2720 ? L0 : (L0 < 2816 ? -1 : L0 - 96);
            tr_item(a.in[4], DIN, src, 1024, nullptr, (bf16*)(ws + WS_BT1), 1024, hp_row(L0), kb * 64, scr, lane); continue; } r -= I1;
        if (r < I2) { const int nb = r / 16, kb = r % 16; tr_item(a.in[9], 1024, nb * 32, 1024, nullptr, (bf16*)(ws + WS_BT3), 1024, hp_row(nb * 32), kb * 64, scr, lane); continue; } r -= I2;
        if (r < I2) { const int nb = r / 16, kb = r % 16; tr_item(a.in[18], 1024, nb * 32, 1024, nullptr, (bf16*)(ws + WS_BT3) + (size_t)1024 * 1024, 1024, hp_row(nb * 32), kb * 64, scr, lane); continue; } r -= I2;
        if (r < I2) { const int nb = r / 16, kb = r % 16; tr_item(a.in[19], 1024, nb * 32, 1024, nullptr, (bf16*)(ws + WS_WOUT), 1024, nb * 32, kb * 64, scr, lane); continue; } r -= I2;
        if (r < I2) { const int nb = r / 16, kb = r % 16; tr_item(a.in[21], 1024, nb * 32, 1024, a.in[20], (bf16*)(ws + WS_WG), 1024, nb * 32, kb * 64, scr, lane); continue; } r -= I2;
        if (r < I5) { const int nb = r / 4, kb = r % 4, L0 = nb * 32; const int src = L0 < 1024 ? (L0 >> 6) * 96 + (L0 & 63) : ((L0 - 1024) >> 5) * 96 + 64;
            tr_item(a.in[11], 1536, src, 256, a.in[10], (bf16*)(ws + WS_BT2), 256, hp_row(L0), kb * 64, scr, lane); continue; } r -= I5;
        if (r < I6) { const int nb = r / 4, kb = r % 4; tr_item(a.in[13], 1024, nb * 32, 128, a.in[12], (bf16*)(ws + WS_BT2) + (size_t)1536 * 256, 256, hp_row(nb * 32), kb * 64, scr, lane); continue; } r -= I6;
        if (r < I6) { const int nb = r / 4, kb = r % 4; tr_item(a.in[14], 1024, nb * 32, 128, a.in[12], (bf16*)(ws + WS_BT2) + (size_t)2560 * 256, 256, hp_row(nb * 32), kb * 64, scr, lane); continue; } r -= I6;
        { const int nb = r / 4, kb = r % 4; tr_item(a.in[22], 1024, nb * 32, 256, nullptr, (bf16*)(ws + WS_WPP), 256, hp_row(nb * 32), kb * 64, scr, lane); }
    }
    {
        const float* x = a.in[0]; const float* g = a.in[3]; bf16* XN = (bf16*)(ws + WS_XN);
        f32x4 gv[4];
#pragma unroll
        for (int j = 0; j < 4; ++j) gv[j] = *(const f32x4*)(g + 4 * lane + 256 * j);
        for (int m = gw; m < T; m += NGW) {
            const f32x4* xr = (const f32x4*)(x + (size_t)m * DM) + lane; f32x4 v[4]; float s = 0.f;
#pragma unroll
            for (int j = 0; j < 4; ++j) { v[j] = xr[64 * j]; s += sumsq4(v[j]); }
            const float r = rsqrtf(wave_sum(s) * (1.0f / DM) + EPS);
            unsigned long long* o8 = (unsigned long long*)(XN + (size_t)m * DM) + lane;
#pragma unroll
            for (int j = 0; j < 4; ++j) { const f32x4 w = v[j] * gv[j] * r; o8[64 * j] = (unsigned long long)cvt_pk_bf16(w[0], w[1]) | ((unsigned long long)cvt_pk_bf16(w[2], w[3]) << 32); }
        }
    }
    {
        const int gt = F.vcu * NTHR + F.tid, NGT = F.G * NTHR; const int* pos = (const int*)a.in[2]; float* rope = (float*)(ws + WS_ROPE);
        for (int e = gt; e < T * 16; e += NGT) { const int row = e >> 4, i = e & 15;
            const float invf = (float)pow(10000.0, -(double)i / 16.0); const float ang = (float)pos[row] * invf;
            double sv, cv; sincos_red((double)ang, sv, cv); rope[(size_t)row * 32 + i] = (float)cv; rope[(size_t)row * 32 + 16 + i] = (float)sv; }
        float* bt = (float*)(ws + WS_BT); const float* rb = a.in[8];
        for (int e = gt; e < 16 * 128; e += NGT) { const int h = e >> 7, d = e & 127;
            int b = d; if (d >= 16) { b = 16 + (int)(logf((float)d * (1.0f / 16.0f)) / logf(8.0f) * 16.0f); b = b < 31 ? b : 31; }
            bt[e] = rb[b * 16 + h] * LOG2E; }
    }
}
__device__ __forceinline__ void p_to_bf16(Frame& F, const Args& a) {
    const int gt = F.vcu * NTHR + F.tid, NGT = F.G * NTHR; const f32x4* p = (const f32x4*)a.in[1]; u32x2* o = (u32x2*)(a.ws + WS_PB);
    for (int e = gt; e < T * 256 / 4; e += NGT) { const f32x4 v = p[e]; u32x2 w; w.x = cvt_pk_bf16(v[0], v[1]); w.y = cvt_pk_bf16(v[2], v[3]); o[e] = w; }
}

__device__ __forceinline__ void cvt8(u32x4 w, LAS float* d) {
    *(LAS f32x4*)d = (f32x4){bflo(w.x), bfhi(w.x), bflo(w.y), bfhi(w.y)}; *(LAS f32x4*)(d + 4) = (f32x4){bflo(w.z), bfhi(w.z), bflo(w.w), bfhi(w.w)};
}
__device__ __forceinline__ void mla_simple(Frame& F, const Args& a) {
    unsigned char* ws = a.ws;
    const bf16 *QBN = (const bf16*)(ws + WS_QBN), *QBR = (const bf16*)(ws + WS_QBR), *KN = (const bf16*)(ws + WS_KN), *KR = (const bf16*)(ws + WS_KR), *VB = (const bf16*)(ws + WS_VB);
    const bf16* SZB = (const bf16*)a.out + (size_t)T * 1024; bf16* AB = (bf16*)(ws + WS_QBN);
    const float *SSCQ = (const float*)(ws + WS_SSCQ), *rope = (const float*)(ws + WS_ROPE), *gq = a.in[15];
    LAS float* Kf = (LAS float*)F.lds; LAS float* Vf = Kf + 64 * 96;
    const int tid = F.tid;
    for (int ui = F.vcu; ui < 1024; ui += F.G) {
        const int bh = ui & 63, s = ui >> 6; const int qb = ((s >> 2) & 1) ? 4 * (s >> 2) + 3 - (s & 3) : 4 * (s >> 2) + (s & 3);
        const int b = bh >> 4, h = bh & 15; const int qpos = qb * 512 + tid; const size_t row = (size_t)b * SEQ + qpos;
        f32x4 q[24];
        {
            const u32x4* qn = (const u32x4*)(QBN + row * 1024 + h * 64); const u32x4* qr = (const u32x4*)(QBR + row * 512 + h * 32);
            float ss = 0.f;
#pragma unroll
            for (int c = 0; c < 12; ++c) { const u32x4 w = c < 8 ? qn[c] : qr[c - 8];
                q[2 * c] = (f32x4){bflo(w.x), bfhi(w.x), bflo(w.y), bfhi(w.y)}; q[2 * c + 1] = (f32x4){bflo(w.z), bfhi(w.z), bflo(w.w), bfhi(w.w)};
                ss += sumsq4(q[2 * c]) + sumsq4(q[2 * c + 1]); }
            const f32x4 sc = *(const f32x4*)(SSCQ + row * 4);
            const float msl = ((sc[0] + sc[1]) + (sc[2] + sc[3])) * (1.0f / 256.0f) + EPS;
            const float r = rsqrtf(ss * (1.0f / 96.0f) + EPS * msl);
#pragma unroll
            for (int c = 0; c < 24; ++c) q[c] = q[c] * *(const f32x4*)(gq + 4 * c) * r;
#pragma unroll
            for (int c = 0; c < 4; ++c) { const f32x4 cs = *(const f32x4*)(rope + row * 32 + 4 * c), sn = *(const f32x4*)(rope + row * 32 + 16 + 4 * c);
                const f32x4 x1 = q[16 + c], x2 = q[20 + c]; q[16 + c] = x1 * cs - x2 * sn; q[20 + c] = x2 * cs + x1 * sn; }
#pragma unroll
            for (int c = 0; c < 24; ++c) q[c] = q[c] * QB_SCALE;
        }
        f32x4 o[16];
#pragma unroll
        for (int c = 0; c < 16; ++c) o[c] = (f32x4){0.f, 0.f, 0.f, 0.f};
        float mrun = -INFINITY, l = 0.f;
        const int nkt = (qb + 1) * 8;
        for (int kt = 0; kt < nkt; ++kt) {
            __syncthreads();
            { const int key = tid >> 3, ch = tid & 7; const size_t kr = (size_t)b * SEQ + kt * 64 + key;
              cvt8(*(const u32x4*)(KN + kr * 1024 + h * 64 + ch * 8), Kf + key * 96 + ch * 8);
              cvt8(*(const u32x4*)(VB + kr * 1024 + h * 64 + ch * 8), Vf + key * 64 + ch * 8);
              if (tid < 256) { const int k2 = tid >> 2, c2 = tid & 3; cvt8(*(const u32x4*)(KR + ((size_t)b * SEQ + kt * 64 + k2) * 32 + c2 * 8), Kf + k2 * 96 + 64 + c2 * 8); } }
            __syncthreads();
            for (int c8 = 0; c8 < 8; ++c8) {
                float sv[8]; float cm = -INFINITY;
#pragma unroll
                for (int j = 0; j < 8; ++j) { const LAS f32x4* kp = (const LAS f32x4*)(Kf + (c8 * 8 + j) * 96); f32x4 acc = q[0] * kp[0];
#pragma unroll
                    for (int c = 1; c < 24; ++c) acc += q[c] * kp[c];
                    float sj = (acc[0] + acc[1]) + (acc[2] + acc[3]);
                    if (kt * 64 + c8 * 8 + j > qpos) sj = -INFINITY;
                    sv[j] = sj; cm = fmaxf(cm, sj); }
                const float mn = fmaxf(mrun, cm), f = __builtin_amdgcn_exp2f(mrun - mn); mrun = mn; l *= f;
#pragma unroll
                for (int c = 0; c < 16; ++c) o[c] = o[c] * f;
#pragma unroll
                for (int j = 0; j < 8; ++j) { const float p = __builtin_amdgcn_exp2f(sv[j] - mn); l += p; const LAS f32x4* vp = (const LAS f32x4*)(Vf + (c8 * 8 + j) * 64);
#pragma unroll
                    for (int c = 0; c < 16; ++c) o[c] += vp[c] * p; }
            }
        }
        const float rl = 1.0f / l;
        const u32x4* sz = (const u32x4*)(SZB + row * 1024 + h * 64); u32x4* dst = (u32x4*)(AB + row * 1024 + h * 64);
#pragma unroll
        for (int c = 0; c < 8; ++c) { const u32x4 g = sz[c]; f32x4 v0 = o[2 * c] * rl, v1 = o[2 * c + 1] * rl;
            v0[0] *= bflo(g.x); v0[1] *= bfhi(g.x); v0[2] *= bflo(g.y); v0[3] *= bfhi(g.y); v1[0] *= bflo(g.z); v1[1] *= bfhi(g.z); v1[2] *= bflo(g.w); v1[3] *= bfhi(g.w);
            u32x4 w; w.x = cvt_pk_bf16(v0[0], v0[1]); w.y = cvt_pk_bf16(v0[2], v0[3]); w.z = cvt_pk_bf16(v1[0], v1[1]); w.w = cvt_pk_bf16(v1[2], v1[3]); dst[c] = w; }
    }
    __syncthreads();
}
__device__ __forceinline__ void swa_simple(Frame& F, const Args& a) {
    unsigned char* ws = a.ws;
    const bf16 *QA = (const bf16*)(ws + WS_QA), *KVA = (const bf16*)(ws + WS_KVA); const bf16* SZA = (const bf16*)a.out; bf16* AA = (bf16*)(ws + WS_QA);
    const float *bt = (const float*)(ws + WS_BT), *sinks = a.in[7];
    LAS float* Kf = (LAS float*)F.lds; LAS float* Vf = Kf + 256 * 64;
    const int tid = F.tid;
    for (int ui = F.vcu; ui < 256; ui += F.G) {
        const int b = ui >> 6, nblk = ui & 63;
        for (int g = 0; g < 2; ++g) {
            __syncthreads();
            for (int e = tid; e < 256 * 8; e += NTHR) { const int c = e >> 3, ch = e & 7; const int tok = (nblk - 1) * 128 + c;
                if (tok >= 0) { const size_t kr = (size_t)b * SEQ + tok;
                    cvt8(*(const u32x4*)(KVA + kr * 256 + g * 64 + ch * 8), Kf + c * 64 + ch * 8);
                    cvt8(*(const u32x4*)(KVA + kr * 256 + 128 + g * 64 + ch * 8), Vf + c * 64 + ch * 8); }
                else { const u32x4 z = (u32x4){0u, 0u, 0u, 0u}; cvt8(z, Kf + c * 64 + ch * 8); cvt8(z, Vf + c * 64 + ch * 8); } }
            __syncthreads();
            for (int itr = 0; itr < 2; ++itr) {
                const int p = tid + NTHR * itr, ql = p & 127, head = g * 8 + (p >> 7); const int ql0 = ql & ~63;
                const size_t row = (size_t)b * SEQ + nblk * 128 + ql;
                f32x4 q[16];
                { const u32x4* qp = (const u32x4*)(QA + row * 1024 + head * 64);
#pragma unroll
                  for (int c = 0; c < 8; ++c) { const u32x4 w = qp[c]; q[2 * c] = (f32x4){bflo(w.x), bfhi(w.x), bflo(w.y), bfhi(w.y)}; q[2 * c + 1] = (f32x4){bflo(w.z), bfhi(w.z), bflo(w.w), bfhi(w.w)}; } }
                f32x4 o[16];
#pragma unroll
                for (int c = 0; c < 16; ++c) o[c] = (f32x4){0.f, 0.f, 0.f, 0.f};
                float mrun = sinks[head] * LOG2E, l = 1.0f;
                const float* bth = bt + head * 128;
                for (int c0 = ql0 + 1; c0 < ql0 + 192; c0 += 8) {
                    float sv[8]; float cm = -INFINITY;
#pragma unroll
                    for (int j = 0; j < 8; ++j) { const int c = c0 + j; const int cc = c < 256 ? c : 255; const LAS f32x4* kp = (const LAS f32x4*)(Kf + cc * 64); f32x4 acc = q[0] * kp[0];
#pragma unroll
                        for (int d = 1; d < 16; ++d) acc += q[d] * kp[d];
                        const int dist = ql + 128 - c; const bool valid = dist >= 0 && dist < 128 && c < 256 && !(nblk == 0 && c < 128);
                        float sj = (acc[0] + acc[1]) + (acc[2] + acc[3]) + bth[dist & 127];
                        sj = valid ? sj : -INFINITY; sv[j] = sj; cm = fmaxf(cm, sj); }
                    const float mn = fmaxf(mrun, cm), f = __builtin_amdgcn_exp2f(mrun - mn); mrun = mn; l *= f;
#pragma unroll
                    for (int d = 0; d < 16; ++d) o[d] = o[d] * f;
#pragma unroll
                    for (int j = 0; j < 8; ++j) { const int c = c0 + j; const int cc = c < 256 ? c : 255; const float pj = __builtin_amdgcn_exp2f(sv[j] - mn); l += pj; const LAS f32x4* vp = (const LAS f32x4*)(Vf + cc * 64);
#pragma unroll
                        for (int d = 0; d < 16; ++d) o[d] += vp[d] * pj; }
                }
                const float rl = 1.0f / l;
                const u32x4* sz = (const u32x4*)(SZA + row * 1024 + head * 64); u32x4* dst = (u32x4*)(AA + row * 1024 + head * 64);
#pragma unroll
                for (int c = 0; c < 8; ++c) { const u32x4 gz = sz[c]; f32x4 v0 = o[2 * c] * rl, v1 = o[2 * c + 1] * rl;
                    v0[0] *= bflo(gz.x); v0[1] *= bfhi(gz.x); v0[2] *= bflo(gz.y); v0[3] *= bfhi(gz.y); v1[0] *= bflo(gz.z); v1[1] *= bfhi(gz.z); v1[2] *= bflo(gz.w); v1[3] *= bfhi(gz.w);
                    u32x4 w; w.x = cvt_pk_bf16(v0[0], v0[1]); w.y = cvt_pk_bf16(v0[2], v0[3]); w.z = cvt_pk_bf16(v1[0], v1[1]); w.w = cvt_pk_bf16(v1[2], v1[3]); dst[c] = w; }
            }
        }
    }
    __syncthreads();
}

constexpr int NPHASE = 7;
__global__ void __launch_bounds__(NTHR, 2) mk_fwd(Args a) {
    extern __shared__ __attribute__((aligned(16))) unsigned char lds[];
    cg::grid_group grid = cg::this_grid();
    Frame F; F.lds = (LAS unsigned char*)lds; F.tid = threadIdx.x; F.lane = F.tid & 63; F.wave = __builtin_amdgcn_readfirstlane(F.tid >> 6);
    F.G = gridDim.x; { const int bx = blockIdx.x; F.vcu = (F.G % 8 == 0) ? (bx % 8) * (F.G / 8) + bx / 8 : bx; }
    unsigned char* ws = a.ws;
    const int lo = a.ph_lo, hi = a.ph_hi;
#define IN(k) (lo <= (k) && (k) < hi)
#define SEAM(k) do { if (IN(k) && IN((k) + 1)) grid.sync(); } while (0)
    bf16* SZA = (bf16*)a.out; bf16* SZB = SZA + (size_t)T * 1024;

#ifndef SKIP_P0
    if (IN(0)) { p0_prologue(F, a); }
#endif
    SEAM(0);

    int K1024 = 1024, K256 = 256; asm volatile("" : "+s"(K1024), "+s"(K256));
    if (IN(1)) {
        pg8::Gemm g{(const bf16*)(ws + WS_XN), (const bf16*)(ws + WS_BT1), T, N1, K1024}; pg8::StaticOrder S; S.init(T, N1, F.G, (int)blockIdx.x);
        Epi1 E{a.out, ws, a.in[5], a.in[6], a.in[17]};
#ifndef SKIP_G1
        pg8::gemm_phase<Epi1, pg8::StaticOrder, true, true>(F.lds, g, S, E);
#endif
    } SEAM(1);

    if (IN(2)) {
        pg8::Gemm g{(const bf16*)(ws + WS_CQKV), (const bf16*)(ws + WS_BT2), 2 * T, 3584, K256}; Order2 S; S.so.init(T, 3584, F.G, (int)blockIdx.x);
        Epi2 E{ws, a.in[16]};
#ifndef SKIP_G2
        pg8::gemm_phase<Epi2, Order2, true, true>(F.lds, g, S, E);
#endif
    } SEAM(2);

    if (IN(3)) {
#ifndef SKIP_SWA
        swa_simple(F, a);
#endif
#ifndef SKIP_MLA
        mla_simple(F, a);
#endif
    } SEAM(3);

    if (IN(4)) {
        p_to_bf16(F, a);
        constexpr int PM_OFF = (int)((WS_QBN - WS_QA) / (256 * 1024 * 2));
        pg8::Gemm g{(const bf16*)(ws + WS_QA), (const bf16*)(ws + WS_BT3), T, 2048, K1024}; Order3 S; S.so.init(T, 1024, F.G, (int)blockIdx.x); S.pm_off = PM_OFF;
        Epi3 E{(bf16*)(ws + WS_MG), (const bf16*)(ws + WS_SGA), (const bf16*)(ws + WS_SGB), PM_OFF};
#ifndef SKIP_G3
        pg8::gemm_phase<Epi3, Order3, true, true>(F.lds, g, S, E);
#endif
    } SEAM(4);

    if (IN(5)) {
        { pg8::Gemm g{(const bf16*)(ws + WS_MG), (const bf16*)(ws + WS_WOUT), T, 1024, K1024}; pg8::StaticOrder S; S.init(T, 1024, F.G, (int)blockIdx.x);
          Epi4 E{a.in[0], a.out, (bf16*)(ws + WS_X1B), (float*)(ws + WS_SSX1)};

#ifndef SKIP_G4
          pg8::gemm_phase<Epi4, pg8::StaticOrder, true, true>(F.lds, g, S, E);
#endif
 }
        { pg8::Gemm g{(const bf16*)(ws + WS_PB), (const bf16*)(ws + WS_WPP), T, 1024, K256}; pg8::StaticOrder S; S.init(T, 1024, F.G, (int)blockIdx.x);
          EpiE E{(bf16*)(ws + WS_ER), (float*)(ws + WS_SSE)};

#ifndef SKIP_GE
          pg8::gemm_phase<EpiE, pg8::StaticOrder, true, true>(F.lds, g, S, E);
#endif
 }
    } SEAM(5);

    if (IN(6)) {
        pg8::Gemm g{(const bf16*)(ws + WS_X1B), (const bf16*)(ws + WS_WG), T, 1024, K1024}; pg8::StaticOrder S; S.init(T, 1024, F.G, (int)blockIdx.x);
        Epi5 E{a.out, (const bf16*)(ws + WS_ER), (const float*)(ws + WS_SSX1), (const float*)(ws + WS_SSE), a.in[23]};
#ifndef SKIP_G5
        pg8::gemm_phase<Epi5, pg8::StaticOrder, true, true>(F.lds, g, S, E);
#endif
    }
#undef IN
#undef SEAM
}

#ifndef MK_N_LAUNCHES
#define MK_N_LAUNCHES 1
#endif
extern "C" void kernel_launch(void* const* d_in, const int* in_sizes, int n_in, void* d_out, int out_size, void* d_ws, size_t ws_size, hipStream_t stream) {
    static int grid = 0;
    if (grid == 0) {
        if (n_in != 24 || in_sizes[0] != T * DM || out_size != T * DM || ws_size < WS_END) { fprintf(stderr, "kernel_launch: unexpected shapes / workspace (n_in %d, ws %zu)\n", n_in, ws_size); grid = -1; return; }
        int dev = 0, cus = 0, per_cu = 0;
        if (hipGetDevice(&dev) != hipSuccess || hipDeviceGetAttribute(&cus, hipDeviceAttributeMultiprocessorCount, dev) != hipSuccess) { grid = -1; return; }
        if (hipFuncSetAttribute((const void*)mk_fwd, hipFuncAttributeMaxDynamicSharedMemorySize, LDS_BYTES) != hipSuccess) { fprintf(stderr, "kernel_launch: hipFuncSetAttribute failed\n"); grid = -1; return; }
        if (hipOccupancyMaxActiveBlocksPerMultiprocessor(&per_cu, (const void*)mk_fwd, NTHR, LDS_BYTES) != hipSuccess || per_cu < 1) { fprintf(stderr, "kernel_launch: occupancy query says %d\n", per_cu); per_cu = 1; }
        (void)hipGetLastError();
        grid = cus;
    }
    if (grid < 0) return;
    Args a{};
    for (int i = 0; i < 24; ++i) a.in[i] = (const float*)d_in[i];
    a.out = (float*)d_out; a.ws = (unsigned char*)d_ws;
#if MK_N_LAUNCHES == 1
    a.ph_lo = 0; a.ph_hi = NPHASE;
    void* args[] = {&a};
    hipError_t e = hipLaunchCooperativeKernel((const void*)mk_fwd, dim3(grid), dim3(NTHR), args, LDS_BYTES, stream);
    if (e != hipSuccess) fprintf(stderr, "kernel_launch: cooperative launch failed: %s (grid %d)\n", hipGetErrorString(e), grid);
#else
    for (int ph = 0; ph < NPHASE; ++ph) { a.ph_lo = ph; a.ph_hi = ph + 1; hipLaunchKernelGGL(mk_fwd, dim3(grid), dim3(NTHR), LDS_BYTES, stream, a); }
#endif
}
```

```cpp
#include <hip/hip_runtime.h>
#include <hip/hip_cooperative_groups.h>
#include <cstdio>
#include <cstdint>
namespace cg = cooperative_groups;
namespace pg8 {
#define PG8_LAS __attribute__((address_space(3)))
typedef unsigned short bf16_t;
typedef short bf16x8 __attribute__((ext_vector_type(8)));
typedef float f32x4 __attribute__((ext_vector_type(4)));
typedef unsigned u32x4 __attribute__((ext_vector_type(4)));
constexpr int BM = 256, BK = 64, HALF = 128, HTB = HALF * BK * 2  , STAGE_BYTES = 8 * HTB, NXCD = 8, WGM = 8;

__host__ __device__ __forceinline__ int lds_byte(int r, int c) { const int st = (r >> 4) * 2 + (c >> 5), rr = r & 15, cc = c & 31, ob = rr * 64 + cc * 2; return st * 1024 + (ob ^ (((ob >> 9) & 1) << 5)); }
__host__ __device__ __forceinline__ void stage_rc(int b, int& R, int& C) { const int st = b / 1024, sb = b % 1024, swz = sb ^ (((sb >> 9) & 1) << 5); R = (st >> 1) * 16 + swz / 64; C = (st & 1) * 32 + (swz % 64) / 2; }
__host__ __device__ __forceinline__ int perm32(int rho) { const int n = rho >> 4, i = rho & 15; return 8 * (i >> 2) + 4 * n + (i & 3); }

struct Unit { int pm, pn; };
struct Gemm { const bf16_t* A; const bf16_t* Bt; int M, N, K; };

struct StaticOrder {
    int nM, nN, nwg, G, c;
    __host__ __device__ void init(int M, int N, int G_, int c_) { nM = M / BM; nN = N / BM; nwg = nM * nN; G = G_; c = c_; }
    __host__ __device__ bool next(int i, Unit& u) const {
        const long L = (long)i * G + c; if (L >= nwg) return false;
        int wgid = (int)L; { const int q = nwg / NXCD, r = nwg % NXCD, xcd = wgid % NXCD, off = wgid / NXCD; wgid = (xcd < r ? xcd * (q + 1) : r * (q + 1) + (xcd - r) * q) + off; }
        const int nig = WGM * nN, gid = wgid / nig, fm = gid * WGM, gsz = (nM - fm) < WGM ? (nM - fm) : WGM;
        u.pm = fm + ((wgid % nig) % gsz); u.pn = (wgid % nig) / gsz; return true;
    }
    __device__ __forceinline__ void a_ready(const Unit&) const {}
    __device__ __forceinline__ void done(const Unit&) const {}
};

__device__ __forceinline__ unsigned cvt_pk_bf16(float lo, float hi) { unsigned r; asm volatile("v_cvt_pk_bf16_f32 %0, %1, %2" : "=v"(r) : "v"(lo), "v"(hi)); return r; }
typedef float f32x2 __attribute__((ext_vector_type(2)));
template <class Epi, class Sched, bool ALIGN_EPI = false, bool SP2 = false>
__device__ __forceinline__ void gemm_phase(PG8_LAS unsigned char* lds, const Gemm g, const Sched& S, const Epi& E, const int tid_in) {
    const int tid = tid_in, wid = __builtin_amdgcn_readfirstlane(tid >> 6), lane = tid & 63, wr = wid >> 2, wc = wid & 3, fr = lane & 15, fq = lane >> 4;
    const int K = g.K, nt = K / BK;
    unsigned voffA[2], voffB[2];
#pragma unroll
    for (int i = 0; i < 2; ++i) { int R, C; stage_rc(tid * 16 + i * 8192, R, C); const int Rb = Epi::PERM ? ((R & ~31) + perm32(R & 31)) : R;
        voffA[i] = (unsigned)(R * K + C) * 2u; voffB[i] = (unsigned)(Rb * K + C) * 2u; }
    const size_t kstep = (size_t)(BK * 2);
    const size_t hstep = (size_t)HALF * K * 2;
    const size_t tstep = 2 * hstep;
    const unsigned ldsw = (unsigned)wid * 1024u;
    const int aoff = lds_byte(wr * 64 + fr, fq * 8), boff = lds_byte(wc * 32 + fr, fq * 8);
#define PG8_SA(b, h) (((b) * 2 + (h)) * HTB)
#define PG8_SB(b, h) ((4 + (b) * 2 + (h)) * HTB)
#define PG8_STAGE(bufoff, gbase, voff) do { _Pragma("unroll") for (int _i = 0; _i < 2; ++_i) \
        __builtin_amdgcn_global_load_lds((const unsigned*)((const char*)(gbase) + (voff)[_i]), (PG8_LAS unsigned*)(lds + (bufoff) + ldsw + _i * 8192), 16, 0, 0); } while (0)
#define PG8_LDA(dst, b, h) do { _Pragma("unroll") for (int m = 0; m < 4; ++m) _Pragma("unroll") for (int k = 0; k < 2; ++k) dst[m][k] = *(const PG8_LAS bf16x8*)(lds + PG8_SA(b, h) + aoff + m * 2048 + k * 1024); } while (0)
#define PG8_LDB(dst, b, h) do { _Pragma("unroll") for (int n = 0; n < 2; ++n) _Pragma("unroll") for (int k = 0; k < 2; ++k) dst[n][k] = *(const PG8_LAS bf16x8*)(lds + PG8_SB(b, h) + boff + n * 2048 + k * 1024); } while (0)
#define PG8_MMA(ai, bj, At, Bt) do { __builtin_amdgcn_s_setprio(1); _Pragma("unroll") for (int m = 0; m < 4; ++m) _Pragma("unroll") for (int n = 0; n < 2; ++n) _Pragma("unroll") for (int k = 0; k < 2; ++k) \
        acc[ai][bj][m][n] = __builtin_amdgcn_mfma_f32_16x16x32_bf16(Bt[n][k], At[m][k], acc[ai][bj][m][n], 0, 0, 0); __builtin_amdgcn_s_setprio(0); } while (0)
#define PG8_WAIT_V(n) asm volatile("s_waitcnt vmcnt(" #n ")" ::: "memory")
#define PG8_WAIT_L(n) asm volatile("s_waitcnt lgkmcnt(" #n ")" ::: "memory")
#define PG8_BAR __builtin_amdgcn_s_barrier()
#define PG8_SCHED __builtin_amdgcn_sched_barrier(0)
    Unit cur, nxt; int ui = 0;
    if (!S.next(0, cur)) return;
    f32x4 acc[2][2][4][2];
#pragma unroll
    for (int a = 0; a < 2; ++a)
#pragma unroll
        for (int b = 0; b < 2; ++b)
#pragma unroll
            for (int m = 0; m < 4; ++m)
#pragma unroll
                for (int n = 0; n < 2; ++n) acc[a][b][m][n] = (f32x4){0.f, 0.f, 0.f, 0.f};
    bf16x8 At[4][2], B0[2][2], B1[2][2];
    const char* cA = (const char*)g.A + (size_t)cur.pm * tstep; const char* cB = (const char*)g.Bt + (size_t)cur.pn * tstep;
    S.a_ready(cur); E.pre(cur, tid);
    if constexpr (SP2) {
        PG8_STAGE(PG8_SB(0, 0), cB, voffB); PG8_STAGE(PG8_SB(0, 1), cB + hstep, voffB); PG8_STAGE(PG8_SA(0, 0), cA, voffA); PG8_STAGE(PG8_SA(0, 1), cA + hstep, voffA);
        if (wr == 1) PG8_BAR;
        PG8_WAIT_V(2); PG8_BAR;
        PG8_STAGE(PG8_SB(1, 0), cB + kstep, voffB); PG8_STAGE(PG8_SA(1, 0), cA + kstep, voffA); PG8_STAGE(PG8_SB(1, 1), cB + hstep + kstep, voffB);
        PG8_WAIT_V(6); PG8_BAR;
    } else {
        PG8_STAGE(PG8_SB(0, 0), cB, voffB); PG8_STAGE(PG8_SA(0, 0), cA, voffA); PG8_STAGE(PG8_SB(0, 1), cB + hstep, voffB); PG8_STAGE(PG8_SA(0, 1), cA + hstep, voffA);
        if (wr == 1) PG8_BAR;
        PG8_WAIT_V(4); PG8_BAR;
        PG8_STAGE(PG8_SB(1, 0), cB + kstep, voffB); PG8_STAGE(PG8_SA(1, 0), cA + kstep, voffA); PG8_STAGE(PG8_SB(1, 1), cB + hstep + kstep, voffB);
        PG8_WAIT_V(6); PG8_BAR;
    }
    for (;;) {
        const bool has_next = S.next(ui + 1, nxt);
        const char* nA = has_next ? (const char*)g.A + (size_t)nxt.pm * tstep : cA; const char* nB = has_next ? (const char*)g.Bt + (size_t)nxt.pn * tstep : cB;
        for (int t = 0; t < nt; t += 2) {
            const bool last = (t == nt - 2);
            const char* a1 = cA + (size_t)(t + 1) * kstep;
            const char* a2 = last ? nA : cA + (size_t)(t + 2) * kstep; const char* b2 = last ? nB : cB + (size_t)(t + 2) * kstep;
            const char* a3 = a2 + kstep; const char* b3 = b2 + kstep;
            if (last && has_next) S.a_ready(nxt);
            if constexpr (SP2) {
            PG8_LDB(B0, 0, 0); PG8_LDB(B1, 0, 1); PG8_SCHED; PG8_LDA(At, 0, 0); PG8_STAGE(PG8_SA(1, 1), a1 + hstep, voffA);
            PG8_WAIT_V(8); PG8_WAIT_L(0); PG8_BAR; PG8_MMA(0, 0, At, B0); PG8_MMA(0, 1, At, B1); PG8_BAR; PG8_SCHED;
            PG8_LDA(At, 0, 1); PG8_STAGE(PG8_SB(0, 0), b2, voffB); PG8_STAGE(PG8_SB(0, 1), b2 + hstep, voffB); PG8_STAGE(PG8_SA(0, 0), a2, voffA);
            PG8_WAIT_V(8); PG8_WAIT_L(0); PG8_BAR; PG8_MMA(1, 0, At, B0); PG8_MMA(1, 1, At, B1); PG8_BAR; PG8_SCHED;
            PG8_LDB(B0, 1, 0); PG8_LDB(B1, 1, 1); PG8_SCHED; PG8_LDA(At, 1, 0); PG8_STAGE(PG8_SA(0, 1), a2 + hstep, voffA);
            PG8_WAIT_V(8); PG8_WAIT_L(0); PG8_BAR; PG8_MMA(0, 0, At, B0); PG8_MMA(0, 1, At, B1); PG8_BAR; PG8_SCHED;
            PG8_LDA(At, 1, 1); PG8_STAGE(PG8_SB(1, 0), b3, voffB); PG8_STAGE(PG8_SB(1, 1), b3 + hstep, voffB); PG8_STAGE(PG8_SA(1, 0), a3, voffA);
            PG8_WAIT_V(8); PG8_WAIT_L(0); PG8_BAR; PG8_MMA(1, 0, At, B0); PG8_MMA(1, 1, At, B1); PG8_BAR; PG8_SCHED;
            } else {
            PG8_LDB(B0, 0, 0); PG8_SCHED; PG8_LDA(At, 0, 0); PG8_STAGE(PG8_SA(1, 1), a1 + hstep, voffA);
            PG8_WAIT_L(8); PG8_BAR; PG8_WAIT_L(0); PG8_MMA(0, 0, At, B0); PG8_BAR; PG8_SCHED;
            PG8_LDB(B1, 0, 1); PG8_STAGE(PG8_SB(0, 0), b2, voffB);
            PG8_BAR; PG8_WAIT_L(0); PG8_MMA(0, 1, At, B1); PG8_BAR;
            PG8_LDA(At, 0, 1); PG8_STAGE(PG8_SA(0, 0), a2, voffA);
            PG8_BAR; PG8_WAIT_L(0); PG8_MMA(1, 0, At, B0); PG8_BAR; PG8_SCHED;
            PG8_STAGE(PG8_SB(0, 1), b2 + hstep, voffB);
            PG8_WAIT_V(6); PG8_BAR; PG8_MMA(1, 1, At, B1); PG8_BAR;
            PG8_LDB(B0, 1, 0); PG8_SCHED; PG8_LDA(At, 1, 0); PG8_STAGE(PG8_SA(0, 1), a2 + hstep, voffA);
            PG8_WAIT_L(8); PG8_BAR; PG8_WAIT_L(0); PG8_MMA(0, 0, At, B0); PG8_BAR; PG8_SCHED;
            PG8_LDB(B1, 1, 1); PG8_STAGE(PG8_SB(1, 0), b3, voffB);
            PG8_BAR; PG8_WAIT_L(0); PG8_MMA(0, 1, At, B1); PG8_BAR;
            PG8_LDA(At, 1, 1); PG8_STAGE(PG8_SA(1, 0), a3, voffA);
            PG8_BAR; PG8_WAIT_L(0); PG8_MMA(1, 0, At, B0); PG8_BAR; PG8_SCHED;
            PG8_STAGE(PG8_SB(1, 1), b3 + hstep, voffB);
            PG8_WAIT_V(6); PG8_BAR; PG8_MMA(1, 1, At, B1); PG8_BAR;
            }
        }
        if constexpr (ALIGN_EPI) { if (wr == 0) PG8_BAR; }
        if constexpr (!Epi::AFTER_DRAIN) { E(acc, cur, wr, wc, fr, fq); S.done(cur); }
        if (!has_next) break;
#pragma unroll
        for (int a = 0; a < 2; ++a)
#pragma unroll
            for (int b = 0; b < 2; ++b)
#pragma unroll
                for (int m = 0; m < 4; ++m)
#pragma unroll
                    for (int n = 0; n < 2; ++n) acc[a][b][m][n] = (f32x4){0.f, 0.f, 0.f, 0.f};
        cur = nxt; cA = nA; cB = nB; ++ui; E.pre(cur, tid);
        if constexpr (ALIGN_EPI) { if (wr == 1) PG8_BAR; }
    }
    PG8_WAIT_V(0);
    if constexpr (!ALIGN_EPI) { if (wr == 0) PG8_BAR; }
    PG8_BAR;
    if constexpr (Epi::AFTER_DRAIN) { E.fused(acc, cur, wr, wc, fr, fq, lds, wid, lane); S.done(cur); }
#undef PG8_SA
#undef PG8_SB
#undef PG8_STAGE
#undef PG8_LDA
#undef PG8_LDB
#undef PG8_MMA
#undef PG8_WAIT_V
#undef PG8_WAIT_L
#undef PG8_BAR
#undef PG8_SCHED
}
}
namespace pg8 {
template <class Epi, class Sched, bool ALIGN_EPI = false, bool SP2 = false>
__device__ __forceinline__ void gemm_phase_cat(PG8_LAS unsigned char* lds, const Gemm g, const Sched& S, const Epi& E, const int tid_in, const int lda, const int KH, const long dA) {
    const int tid = tid_in, wid = __builtin_amdgcn_readfirstlane(tid >> 6), lane = tid & 63, wr = wid >> 2, wc = wid & 3, fr = lane & 15, fq = lane >> 4;
    const int K = g.K, nt = K / BK;
    unsigned voffA[2], voffB[2];
#pragma unroll
    for (int i = 0; i < 2; ++i) { int R, C; stage_rc(tid * 16 + i * 8192, R, C); const int Rb = Epi::PERM ? ((R & ~31) + perm32(R & 31)) : R;
        voffA[i] = (unsigned)(R * lda + C) * 2u; voffB[i] = (unsigned)(Rb * K + C) * 2u; }
    const size_t kstep = (size_t)(BK * 2);
    const size_t hstep = (size_t)HALF * K * 2, tstep = 2 * hstep;
    const size_t hstepA = (size_t)HALF * lda * 2, tstepA = 2 * hstepA;
    const size_t dsplit = (size_t)dA - (size_t)KH * kstep;
#define PG8_APT(base, kt) ((base) + (size_t)(kt) * kstep + ((kt) >= KH ? dsplit : (size_t)0))
    const unsigned ldsw = (unsigned)wid * 1024u;
    const int aoff = lds_byte(wr * 64 + fr, fq * 8), boff = lds_byte(wc * 32 + fr, fq * 8);
#define PG8_SA(b, h) (((b) * 2 + (h)) * HTB)
#define PG8_SB(b, h) ((4 + (b) * 2 + (h)) * HTB)
#define PG8_STAGE(bufoff, gbase, voff) do { _Pragma("unroll") for (int _i = 0; _i < 2; ++_i) \
        __builtin_amdgcn_global_load_lds((const unsigned*)((const char*)(gbase) + (voff)[_i]), (PG8_LAS unsigned*)(lds + (bufoff) + ldsw + _i * 8192), 16, 0, 0); } while (0)
#define PG8_LDA(dst, b, h) do { _Pragma("unroll") for (int m = 0; m < 4; ++m) _Pragma("unroll") for (int k = 0; k < 2; ++k) dst[m][k] = *(const PG8_LAS bf16x8*)(lds + PG8_SA(b, h) + aoff + m * 2048 + k * 1024); } while (0)
#define PG8_LDB(dst, b, h) do { _Pragma("unroll") for (int n = 0; n < 2; ++n) _Pragma("unroll") for (int k = 0; k < 2; ++k) dst[n][k] = *(const PG8_LAS bf16x8*)(lds + PG8_SB(b, h) + boff + n * 2048 + k * 1024); } while (0)
#define PG8_MMA(ai, bj, At, Bt) do { __builtin_amdgcn_s_setprio(1); _Pragma("unroll") for (int m = 0; m < 4; ++m) _Pragma("unroll") for (int n = 0; n < 2; ++n) _Pragma("unroll") for (int k = 0; k < 2; ++k) \
        acc[ai][bj][m][n] = __builtin_amdgcn_mfma_f32_16x16x32_bf16(Bt[n][k], At[m][k], acc[ai][bj][m][n], 0, 0, 0); __builtin_amdgcn_s_setprio(0); } while (0)
#define PG8_WAIT_V(n) asm volatile("s_waitcnt vmcnt(" #n ")" ::: "memory")
#define PG8_WAIT_L(n) asm volatile("s_waitcnt lgkmcnt(" #n ")" ::: "memory")
#define PG8_BAR __builtin_amdgcn_s_barrier()
#define PG8_SCHED __builtin_amdgcn_sched_barrier(0)
    Unit cur, nxt; int ui = 0;
    if (!S.next(0, cur)) return;
    f32x4 acc[2][2][4][2];
#pragma unroll
    for (int a = 0; a < 2; ++a)
#pragma unroll
        for (int b = 0; b < 2; ++b)
#pragma unroll
            for (int m = 0; m < 4; ++m)
#pragma unroll
                for (int n = 0; n < 2; ++n) acc[a][b][m][n] = (f32x4){0.f, 0.f, 0.f, 0.f};
    bf16x8 At[4][2], B0[2][2], B1[2][2];
    const char* cA = (const char*)g.A + (size_t)cur.pm * tstepA; const char* cB = (const char*)g.Bt + (size_t)cur.pn * tstep;
    S.a_ready(cur); E.pre(cur, tid);
    if constexpr (SP2) {
        PG8_STAGE(PG8_SB(0, 0), cB, voffB); PG8_STAGE(PG8_SB(0, 1), cB + hstep, voffB); PG8_STAGE(PG8_SA(0, 0), cA, voffA); PG8_STAGE(PG8_SA(0, 1), cA + hstepA, voffA);
        if (wr == 1) PG8_BAR;
        PG8_WAIT_V(2); PG8_BAR;
        PG8_STAGE(PG8_SB(1, 0), cB + kstep, voffB); PG8_STAGE(PG8_SA(1, 0), cA + kstep, voffA); PG8_STAGE(PG8_SB(1, 1), cB + hstep + kstep, voffB);
        PG8_WAIT_V(6); PG8_BAR;
    } else {
        PG8_STAGE(PG8_SB(0, 0), cB, voffB); PG8_STAGE(PG8_SA(0, 0), cA, voffA); PG8_STAGE(PG8_SB(0, 1), cB + hstep, voffB); PG8_STAGE(PG8_SA(0, 1), cA + hstepA, voffA);
        if (wr == 1) PG8_BAR;
        PG8_WAIT_V(4); PG8_BAR;
        PG8_STAGE(PG8_SB(1, 0), cB + kstep, voffB); PG8_STAGE(PG8_SA(1, 0), cA + kstep, voffA); PG8_STAGE(PG8_SB(1, 1), cB + hstep + kstep, voffB);
        PG8_WAIT_V(6); PG8_BAR;
    }
    for (;;) {
        const bool has_next = S.next(ui + 1, nxt);
        const char* nA = has_next ? (const char*)g.A + (size_t)nxt.pm * tstepA : cA; const char* nB = has_next ? (const char*)g.Bt + (size_t)nxt.pn * tstep : cB;
        for (int t = 0; t < nt; t += 2) {
            const bool last = (t == nt - 2);
            if (t == KH) E.mid(acc, cur, wr, wc);
            const char* a1 = PG8_APT(cA, t + 1);
            const char* a2 = last ? nA : PG8_APT(cA, t + 2); const char* b2 = last ? nB : cB + (size_t)(t + 2) * kstep;
            const char* a3 = last ? nA + kstep : PG8_APT(cA, t + 3); const char* b3 = b2 + kstep;
            if (last && has_next) S.a_ready(nxt);
            if constexpr (SP2) {
            PG8_LDB(B0, 0, 0); PG8_LDB(B1, 0, 1); PG8_SCHED; PG8_LDA(At, 0, 0); PG8_STAGE(PG8_SA(1, 1), a1 + hstepA, voffA);
            PG8_WAIT_V(8); PG8_WAIT_L(0); PG8_BAR; PG8_MMA(0, 0, At, B0); PG8_MMA(0, 1, At, B1); PG8_BAR; PG8_SCHED;
            PG8_LDA(At, 0, 1); PG8_STAGE(PG8_SB(0, 0), b2, voffB); PG8_STAGE(PG8_SB(0, 1), b2 + hstep, voffB); PG8_STAGE(PG8_SA(0, 0), a2, voffA);
            PG8_WAIT_V(8); PG8_WAIT_L(0); PG8_BAR; PG8_MMA(1, 0, At, B0); PG8_MMA(1, 1, At, B1); PG8_BAR; PG8_SCHED;
            PG8_LDB(B0, 1, 0); PG8_LDB(B1, 1, 1); PG8_SCHED; PG8_LDA(At, 1, 0); PG8_STAGE(PG8_SA(0, 1), a2 + hstepA, voffA);
            PG8_WAIT_V(8); PG8_WAIT_L(0); PG8_BAR; PG8_MMA(0, 0, At, B0); PG8_MMA(0, 1, At, B1); PG8_BAR; PG8_SCHED;
            PG8_LDA(At, 1, 1); PG8_STAGE(PG8_SB(1, 0), b3, voffB); PG8_STAGE(PG8_SB(1, 1), b3 + hstep, voffB); PG8_STAGE(PG8_SA(1, 0), a3, voffA);
            PG8_WAIT_V(8); PG8_WAIT_L(0); PG8_BAR; PG8_MMA(1, 0, At, B0); PG8_MMA(1, 1, At, B1); PG8_BAR; PG8_SCHED;
            } else {
            PG8_LDB(B0, 0, 0); PG8_SCHED; PG8_LDA(At, 0, 0); PG8_STAGE(PG8_SA(1, 1), a1 + hstepA, voffA);
            PG8_WAIT_L(8); PG8_BAR; PG8_WAIT_L(0); PG8_MMA(0, 0, At, B0); PG8_BAR; PG8_SCHED;
            PG8_LDB(B1, 0, 1); PG8_STAGE(PG8_SB(0, 0), b2, voffB);
            PG8_BAR; PG8_WAIT_L(0); PG8_MMA(0, 1, At, B1); PG8_BAR;
            PG8_LDA(At, 0, 1); PG8_STAGE(PG8_SA(0, 0), a2, voffA);
            PG8_BAR; PG8_WAIT_L(0); PG8_MMA(1, 0, At, B0); PG8_BAR; PG8_SCHED;
            PG8_STAGE(PG8_SB(0, 1), b2 + hstep, voffB);
            PG8_WAIT_V(6); PG8_BAR; PG8_MMA(1, 1, At, B1); PG8_BAR;
            PG8_LDB(B0, 1, 0); PG8_SCHED; PG8_LDA(At, 1, 0); PG8_STAGE(PG8_SA(0, 1), a2 + hstepA, voffA);
            PG8_WAIT_L(8); PG8_BAR; PG8_WAIT_L(0); PG8_MMA(0, 0, At, B0); PG8_BAR; PG8_SCHED;
            PG8_LDB(B1, 1, 1); PG8_STAGE(PG8_SB(1, 0), b3, voffB);
            PG8_BAR; PG8_WAIT_L(0); PG8_MMA(0, 1, At, B1); PG8_BAR;
            PG8_LDA(At, 1, 1); PG8_STAGE(PG8_SA(1, 0), a3, voffA);
            PG8_BAR; PG8_WAIT_L(0); PG8_MMA(1, 0, At, B0); PG8_BAR; PG8_SCHED;
            PG8_STAGE(PG8_SB(1, 1), b3 + hstep, voffB);
            PG8_WAIT_V(6); PG8_BAR; PG8_MMA(1, 1, At, B1); PG8_BAR;
            }
        }
        if constexpr (ALIGN_EPI) { if (wr == 0) PG8_BAR; }
        if constexpr (!Epi::AFTER_DRAIN) { E(acc, cur, wr, wc, fr, fq); S.done(cur); }
        if (!has_next) break;
#pragma unroll
        for (int a = 0; a < 2; ++a)
#pragma unroll
            for (int b = 0; b < 2; ++b)
#pragma unroll
                for (int m = 0; m < 4; ++m)
#pragma unroll
                    for (int n = 0; n < 2; ++n) acc[a][b][m][n] = (f32x4){0.f, 0.f, 0.f, 0.f};
        cur = nxt; cA = nA; cB = nB; ++ui; E.pre(cur, tid);
        if constexpr (ALIGN_EPI) { if (wr == 1) PG8_BAR; }
    }
    PG8_WAIT_V(0);
    if constexpr (!ALIGN_EPI) { if (wr == 0) PG8_BAR; }
    PG8_BAR;
    if constexpr (Epi::AFTER_DRAIN) { E.fused(acc, cur, wr, wc, fr, fq, lds, wid, lane); S.done(cur); }
#undef PG8_APT
#undef PG8_SA
#undef PG8_SB
#undef PG8_STAGE
#undef PG8_LDA
#undef PG8_LDB
#undef PG8_MMA
#undef PG8_WAIT_V
#undef PG8_WAIT_L
#undef PG8_BAR
#undef PG8_SCHED
}
}

#define GAS __attribute__((address_space(1)))
#define LAS __attribute__((address_space(3)))
typedef unsigned short bf16;
typedef unsigned u32x4 __attribute__((ext_vector_type(4)));
typedef unsigned u32x2 __attribute__((ext_vector_type(2)));
typedef float f32x4 __attribute__((ext_vector_type(4)));
typedef float f32x2 __attribute__((ext_vector_type(2)));
using pg8::cvt_pk_bf16;

constexpr int NWAVES = 8, NTHR = 512;
constexpr int T = 32768, SEQ = 8192, NB = 4, DM = 1024;
constexpr int DIN = 5792, N1 = 5888;
constexpr float EPS = 1e-6f, LOG2E = 1.4426950408889634f;
constexpr float QA_SCALE = 0.125f * LOG2E;
constexpr float QB_SCALE = 0.10206207261596575f * LOG2E;

constexpr size_t MiB = 1u << 20;
constexpr size_t WS_CTL = 0, WS_BT = 64 * 1024;
constexpr size_t WS_SSCQ = 1 * MiB, WS_SSCKV = 1 * MiB + 512 * 1024;
constexpr size_t WS_KR = 2 * MiB, WS_ROPE = 4 * MiB;
constexpr size_t WS_BT1 = 8 * MiB, WS_BT3 = 20 * MiB, WS_WOUT = 24 * MiB, WS_WG = 26 * MiB, WS_BT2 = 28 * MiB, WS_WPP = 30 * MiB;
constexpr size_t WS_XN = 32 * MiB;
constexpr size_t WS_QA = 96 * MiB;
constexpr size_t WS_KVA = 160 * MiB;
constexpr size_t WS_CQKV = 176 * MiB;
constexpr size_t WS_SGA = 208 * MiB, WS_SGB = 272 * MiB;
constexpr size_t WS_QBN = 336 * MiB;
constexpr size_t WS_QBR = 400 * MiB;
constexpr size_t WS_KN = 432 * MiB;
constexpr size_t WS_SSQ = 200 * MiB;
constexpr size_t WS_RS = 204 * MiB;
constexpr size_t WS_PBX = 496 * MiB;
constexpr size_t WS_END = 512 * MiB;
constexpr size_t WS_VB = WS_XN, WS_X1B = WS_XN, WS_ER = WS_QA, WS_PB = WS_PBX, WS_SSX1 = WS_CQKV, WS_SSE = WS_CQKV + 2 * MiB, WS_MG = WS_KN, WS_X1F = WS_SGA  ;

constexpr int RING_BYTES = 131072, LDS_BYTES = 147456;

#ifndef NT_ST8
#define NT_ST8 0
#endif
#ifndef NT_SG
#define NT_SG 0
#endif
#ifndef NT_X1ER
#define NT_X1ER 0
#endif
#ifndef NT_X1B
#define NT_X1B 0
#endif
#ifndef NT_PLD
#define NT_PLD 1
#endif
#ifndef NT_PST
#define NT_PST 0
#endif
#ifndef NT_ATTZ
#define NT_ATTZ 1
#endif
#ifndef NT_ATTO
#define NT_ATTO 1
#endif
#ifndef NT_WLD
#define NT_WLD 1
#endif
template <bool NT, class V> __device__ __forceinline__ V ld_hint(const V* p) { if constexpr (NT) return __builtin_nontemporal_load(p); else return *p; }
template <bool NT, class V> __device__ __forceinline__ void st_hint(V v, V* p) { if constexpr (NT) __builtin_nontemporal_store(v, p); else *p = v; }
#define LDS_WAIT() asm volatile("s_waitcnt lgkmcnt(0)" ::: "memory")
__device__ __forceinline__ unsigned f2bf(float f) { unsigned u = __builtin_bit_cast(unsigned, f); return (u + 0x7fffu + ((u >> 16) & 1u)) >> 16; }
__device__ __forceinline__ unsigned pk2(float lo, float hi) { return f2bf(lo) | (f2bf(hi) << 16); }
__device__ __forceinline__ float bf2f(unsigned short b) { return __builtin_bit_cast(float, (unsigned)b << 16); }
__device__ __forceinline__ float bflo(unsigned w) { return __builtin_bit_cast(float, w << 16); }
__device__ __forceinline__ float bfhi(unsigned w) { return __builtin_bit_cast(float, w & 0xffff0000u); }
__device__ __forceinline__ float sigmoidf_(float v) { return __builtin_amdgcn_rcpf(1.0f + __builtin_amdgcn_exp2f(-v * LOG2E)); }
__device__ __forceinline__ void st8(bf16* p, f32x4 a, f32x4 b) { u32x4 w; w.x = cvt_pk_bf16(a[0], a[1]); w.y = cvt_pk_bf16(a[2], a[3]); w.z = cvt_pk_bf16(b[0], b[1]); w.w = cvt_pk_bf16(b[2], b[3]);
#if defined(ST8_SC1) && ST8_SC1
    asm volatile("global_store_dwordx4 %0, %1, off sc1\n\ts_nop 1" :: "v"(p), "v"(w) : "memory");
#else
    st_hint<NT_ST8 != 0>(w, (u32x4*)p);
#endif
}
__device__ __forceinline__ float sumsq4(f32x4 a) { return (a[0] * a[0] + a[1] * a[1]) + (a[2] * a[2] + a[3] * a[3]); }
__device__ __forceinline__ float red_fq(float s) { s += __shfl_xor(s, 16); s += __shfl_xor(s, 32); return s; }

__device__ __forceinline__ int lane_id() { int l; asm volatile("v_mbcnt_lo_u32_b32 %0, -1, 0\n\tv_mbcnt_hi_u32_b32 %0, -1, %0" : "=v"(l)); return l; }

struct Args { const float* in[24]; float* out; unsigned char* ws; int ph_lo, ph_hi; };

struct Frame {
    LAS unsigned char* lds;
    int tid, lane, wave, vcu, G;
#ifdef PROBE
    unsigned long long* pts;
#endif
};
#ifdef PROBE
#define FSTAMP(F, k) do { if (blockIdx.x == 0 && (F).wave == 0 && lane_id() == 0) (F).pts[k] = __builtin_amdgcn_s_memrealtime(); } while (0)
#else
#define FSTAMP(F, k) do { } while (0)
#endif

struct Order2 {
    pg8::StaticOrder so;
    __device__ bool next(int i, pg8::Unit& u) const { if (!so.next(i, u)) return false; if (u.pn >= 6) u.pm += 128; return true; }
    __device__ __forceinline__ void a_ready(const pg8::Unit&) const {}
    __device__ __forceinline__ void done(const pg8::Unit&) const {}
};
typedef const pg8::f32x4 (&AccRef)[2][2][4][2];


__device__ __forceinline__ float acc_ss(AccRef acc, int ai, int m) { return (sumsq4(acc[ai][0][m][0]) + sumsq4(acc[ai][0][m][1])) + (sumsq4(acc[ai][1][m][0]) + sumsq4(acc[ai][1][m][1])); }
__device__ __forceinline__ void epi_raw(AccRef acc, bf16* base, int ld, int row0, int lc0) {
#pragma unroll
    for (int ai = 0; ai < 2; ++ai)
#pragma unroll
        for (int m = 0; m < 4; ++m) { bf16* dst = base + (size_t)(row0 + ai * 128 + m * 16) * ld + lc0;
#pragma unroll
            for (int bj = 0; bj < 2; ++bj) st8(dst + 32 * bj, acc[ai][bj][m][0], acc[ai][bj][m][1]); }
}
__device__ __forceinline__ void epi_raw_ss(AccRef acc, bf16* base, int ld, int row0, int lc0, float* ssp, int nss, int idx, int fq) {
#pragma unroll
    for (int ai = 0; ai < 2; ++ai)
#pragma unroll
        for (int m = 0; m < 4; ++m) { const int row = row0 + ai * 128 + m * 16; const float ss = red_fq(acc_ss(acc, ai, m));
            if (fq == 0) ssp[(size_t)row * nss + idx] = ss;
            bf16* dst = base + (size_t)row * ld + lc0;
#pragma unroll
            for (int bj = 0; bj < 2; ++bj) st8(dst + 32 * bj, acc[ai][bj][m][0], acc[ai][bj][m][1]); }
}
__device__ __forceinline__ void epi_headnorm(AccRef acc, bf16* base, int ld, int row0, int lc0, const float* g, float sc, int fq) {
    f32x4 gv[2][2];
#pragma unroll
    for (int bj = 0; bj < 2; ++bj)
#pragma unroll
        for (int n = 0; n < 2; ++n) gv[bj][n] = *(const f32x4*)(g + 32 * bj + 8 * fq + 4 * n) * sc;
#pragma unroll
    for (int ai = 0; ai < 2; ++ai)
#pragma unroll
        for (int m = 0; m < 4; ++m) { const int row = row0 + ai * 128 + m * 16; const float r = rsqrtf(red_fq(acc_ss(acc, ai, m)) * (1.0f / 64.0f) + EPS);
            bf16* dst = base + (size_t)row * ld + lc0;
#pragma unroll
            for (int bj = 0; bj < 2; ++bj) st8(dst + 32 * bj, acc[ai][bj][m][0] * gv[bj][0] * r, acc[ai][bj][m][1] * gv[bj][1] * r); }
}
template <bool SILU> __device__ __forceinline__ void epi_act(AccRef acc, bf16* base, int row0, int lc0) {
#pragma unroll
    for (int ai = 0; ai < 2; ++ai)
#pragma unroll
        for (int m = 0; m < 4; ++m) { bf16* dst = base + (size_t)(row0 + ai * 128 + m * 16) * 1024 + lc0;
#pragma unroll
            for (int bj = 0; bj < 2; ++bj) { f32x4 v0 = acc[ai][bj][m][0], v1 = acc[ai][bj][m][1], o0, o1;
#pragma unroll
                for (int e = 0; e < 4; ++e) { const float s0 = sigmoidf_(v0[e]), s1 = sigmoidf_(v1[e]); o0[e] = SILU ? v0[e] * s0 : s0; o1[e] = SILU ? v1[e] * s1 : s1; }
                st8(dst + 32 * bj, o0, o1); } }
}

struct Epi1 {
    static constexpr bool PERM = true, AFTER_DRAIN = false;
    float* out; unsigned char* ws; const float *gq, *gk, *gkr; int mode;
    __device__ __forceinline__ void pre(const pg8::Unit&, int) const {}
    __device__ __forceinline__ void operator()(AccRef acc, const pg8::Unit& u, int wr, int wc, int, int) const {
        int ln_ = lane_id(); asm volatile("" : "+v"(ln_)); const int fr = ln_ & 15, fq = ln_ >> 4;
        const int row0 = u.pm * 256 + wr * 64 + fr, pn = u.pn, lc0 = 64 * wc + 8 * fq;
#ifdef PROBE
        if (mode == 1) { pg8::f32x4 t = acc[0][0][0][0];
#pragma unroll
            for (int i_ = 1; i_ < 32; ++i_) t += acc[i_ >> 4][(i_ >> 3) & 1][(i_ >> 1) & 3][i_ & 1];
            asm volatile("" :: "v"(t)); return; }
        if (mode == 2) { epi_raw(acc, (bf16*)(ws + WS_SGA) + (pn & 3) * 256, 1024, row0, lc0); return; }
#endif
        if (pn < 4) {
            epi_headnorm(acc, (bf16*)(ws + WS_QA) + pn * 256, 1024, row0, lc0, gq, QA_SCALE, fq);
        } else if (pn == 4) {
            if (wc < 2) epi_headnorm(acc, (bf16*)(ws + WS_KVA), 256, row0, lc0, gk, 1.0f, fq);
            else epi_raw(acc, (bf16*)(ws + WS_KVA), 256, row0, lc0);
        } else if (pn <= 8) {
            epi_act<true>(acc, (bf16*)out + (pn - 5) * 256, row0, lc0);
        } else if (pn == 9) {
            epi_raw_ss(acc, (bf16*)(ws + WS_CQKV), 256, row0, lc0, (float*)(ws + WS_SSCQ), 4, wc, fq);
        } else if (pn == 10) {
            if (wc < 2) epi_raw_ss(acc, (bf16*)(ws + WS_CQKV) + (size_t)T * 256, 128, row0, lc0, (float*)(ws + WS_SSCKV), 2, wc, fq);
            else if (wc == 2) {
                f32x4 gv[2];
#pragma unroll
                for (int n = 0; n < 2; ++n) gv[n] = *(const f32x4*)(gkr + 8 * fq + 4 * n);
                const float* rope = (const float*)(ws + WS_ROPE); bf16* KR = (bf16*)(ws + WS_KR);
#pragma unroll
                for (int ai = 0; ai < 2; ++ai)
#pragma unroll
                    for (int m = 0; m < 4; ++m) {
                        const int row = row0 + ai * 128 + m * 16;
                        const float ss = red_fq(sumsq4(acc[ai][0][m][0]) + sumsq4(acc[ai][0][m][1]));
                        const float r = rsqrtf(ss * (1.0f / 32.0f) + EPS);
                        const f32x4 a0 = acc[ai][0][m][0] * gv[0] * r, a1 = acc[ai][0][m][1] * gv[1] * r;
                        f32x4 p0, p1;
#pragma unroll
                        for (int e = 0; e < 4; ++e) { p0[e] = __shfl_xor(a0[e], 32); p1[e] = __shfl_xor(a1[e], 32); }
                        const float* rp = rope + (size_t)row * 32 + 8 * (fq & 1);
                        const f32x4 c0 = *(const f32x4*)(rp), c1 = *(const f32x4*)(rp + 4), s0 = *(const f32x4*)(rp + 16), s1 = *(const f32x4*)(rp + 20);
                        const float sg = fq < 2 ? -1.0f : 1.0f;
                        st8(KR + (size_t)row * 32 + 8 * fq, a0 * c0 + p0 * s0 * sg, a1 * c1 + p1 * s1 * sg);
                        asm volatile("" ::: "memory");
                    }
            }
        } else if (pn <= 14) {
            epi_act<true>(acc, (bf16*)out + (size_t)T * 1024 + (pn - 11) * 256, row0, lc0);
        } else {
            bf16* RA = (bf16*)(ws + WS_SGA); bf16* SB = (bf16*)(ws + WS_SGB); const int c0 = 128 * (pn - 15) + 32 * wc + 8 * fq;
#pragma unroll
            for (int ai = 0; ai < 2; ++ai)
#pragma unroll
                for (int m = 0; m < 4; ++m) { const size_t off = (size_t)(row0 + ai * 128 + m * 16) * 1024 + c0;
                    f32x4 r0, r1, b0, b1;
#pragma unroll
                    for (int e = 0; e < 4; ++e) {
                        const float ea0 = __builtin_amdgcn_exp2f(-acc[ai][0][m][0][e] * LOG2E), ea1 = __builtin_amdgcn_exp2f(-acc[ai][0][m][1][e] * LOG2E);
                        const float eb0 = __builtin_amdgcn_exp2f(-acc[ai][1][m][0][e] * LOG2E), eb1 = __builtin_amdgcn_exp2f(-acc[ai][1][m][1][e] * LOG2E);
                        b0[e] = fmaxf(__builtin_amdgcn_rcpf(1.0f + eb0), 1e-30f); b1[e] = fmaxf(__builtin_amdgcn_rcpf(1.0f + eb1), 1e-30f);
                        r0[e] = __builtin_amdgcn_rcpf((1.0f + ea0) * b0[e]); r1[e] = __builtin_amdgcn_rcpf((1.0f + ea1) * b1[e]); }
                    st8(RA + off, r0, r1); st8(SB + off, b0, b1); }
        }
    }
};
static_assert(WS_SGB == WS_SGA + (size_t)T * 1024 * 2, "SGA and SGB adjacent");

struct Epi2 {
    static constexpr bool PERM = true, AFTER_DRAIN = false;
    unsigned char* ws; const float* gkn; const float* gqn; int pn_off;
    __device__ __forceinline__ void pre(const pg8::Unit&, int) const {}
    __device__ __forceinline__ void operator()(AccRef acc, const pg8::Unit& u, int wr, int wc, int, int) const {
        int ln_ = lane_id(); asm volatile("" : "+v"(ln_)); const int fr = ln_ & 15, fq = ln_ >> 4;
        const int row0 = u.pm * 256 + wr * 64 + fr, pn = u.pn + pn_off, lc0 = 64 * wc + 8 * fq;
        if (pn < 4) epi_raw_ss(acc, (bf16*)(ws + WS_QBN) + pn * 256, 1024, row0, lc0, (float*)(ws + WS_SSQ), 32, 4 * pn + wc, fq);
        else if (pn < 6) {
            bf16* base = (bf16*)(ws + WS_QBR) + (pn - 4) * 256; float* SSQ = (float*)(ws + WS_SSQ); const float* rope = (const float*)(ws + WS_ROPE);
            f32x4 gr[2];
#pragma unroll
            for (int n = 0; n < 2; ++n) gr[n] = *(const f32x4*)(gqn + 64 + 8 * fq + 4 * n);
#pragma unroll
            for (int ai = 0; ai < 2; ++ai)
#pragma unroll
                for (int m = 0; m < 4; ++m) { const int row = row0 + ai * 128 + m * 16;
                    const float s0 = red_fq(sumsq4(acc[ai][0][m][0]) + sumsq4(acc[ai][0][m][1])), s1 = red_fq(sumsq4(acc[ai][1][m][0]) + sumsq4(acc[ai][1][m][1]));
                    if (fq == 0) *(f32x2*)(SSQ + (size_t)row * 32 + 16 + 8 * (pn - 4) + 2 * wc) = (f32x2){s0, s1};
                    const float* rp = rope + (size_t)row * 32 + 8 * (fq & 1);
                    const f32x4 c0 = *(const f32x4*)(rp), c1 = *(const f32x4*)(rp + 4), sn0 = *(const f32x4*)(rp + 16), sn1 = *(const f32x4*)(rp + 20);
                    const float sg = fq < 2 ? -1.0f : 1.0f;
                    bf16* dst = base + (size_t)row * 512 + lc0;
#pragma unroll
                    for (int bj = 0; bj < 2; ++bj) { const f32x4 a0 = acc[ai][bj][m][0] * gr[0], a1 = acc[ai][bj][m][1] * gr[1]; f32x4 p0, p1;
#pragma unroll
                        for (int e = 0; e < 4; ++e) { p0[e] = __shfl_xor(a0[e], 32); p1[e] = __shfl_xor(a1[e], 32); }
                        st8(dst + 32 * bj, a0 * c0 + p0 * sn0 * sg, a1 * c1 + p1 * sn1 * sg); }
                    asm volatile("" ::: "memory"); }
        }
        else {
            const float* SSCKV = (const float*)(ws + WS_SSCKV);
            float msl8[2][4];
#pragma unroll
            for (int ai = 0; ai < 2; ++ai)
#pragma unroll
                for (int m = 0; m < 4; ++m) { const f32x2 t = *(const f32x2*)(SSCKV + (size_t)(row0 + ai * 128 + m * 16) * 2); msl8[ai][m] = (t[0] + t[1]) * (1.0f / 128.0f) + EPS; }
            if (pn < 10) {
                bf16* base = (bf16*)(ws + WS_KN) + (pn - 6) * 256;
                f32x4 gv[2][2];
#pragma unroll
                for (int bj = 0; bj < 2; ++bj)
#pragma unroll
                    for (int n = 0; n < 2; ++n) gv[bj][n] = *(const f32x4*)(gkn + 32 * bj + 8 * fq + 4 * n) * *(const f32x4*)(gqn + 32 * bj + 8 * fq + 4 * n);
#pragma unroll
                for (int ai = 0; ai < 2; ++ai)
#pragma unroll
                    for (int m = 0; m < 4; ++m) { const int row = row0 + ai * 128 + m * 16;
                        const float msl = msl8[ai][m];
                        const float r = rsqrtf(red_fq(acc_ss(acc, ai, m)) * (1.0f / 64.0f) + EPS * msl);
                        bf16* dst = base + (size_t)row * 1024 + lc0;
#pragma unroll
                        for (int bj = 0; bj < 2; ++bj) st8(dst + 32 * bj, acc[ai][bj][m][0] * gv[bj][0] * r, acc[ai][bj][m][1] * gv[bj][1] * r);
                        asm volatile("" ::: "memory"); }
            } else {
                bf16* base = (bf16*)(ws + WS_VB) + (pn - 10) * 256;
#pragma unroll
                for (int ai = 0; ai < 2; ++ai)
#pragma unroll
                    for (int m = 0; m < 4; ++m) { const int row = row0 + ai * 128 + m * 16;
                        const float r = rsqrtf(msl8[ai][m]);
                        bf16* dst = base + (size_t)row * 1024 + lc0;
#pragma unroll
                        for (int bj = 0; bj < 2; ++bj) st8(dst + 32 * bj, acc[ai][bj][m][0] * r, acc[ai][bj][m][1] * r);
                        asm volatile("" ::: "memory"); }
            }
        }
    }
};

namespace mla {
using bf16x8 = __attribute__((ext_vector_type(8))) short;
using s16x4 = __attribute__((ext_vector_type(4))) short;
using f32x16 = __attribute__((ext_vector_type(16))) float;
constexpr int NW = 8, QBLK = 32, QB = 256, KVBLK = 64;
constexpr int KSLOT = 12288, VSLOT = 8192;
constexpr int LDS_K = 0, LDS_V = 3 * KSLOT, LDS_WS = LDS_V + 3 * VSLOT, LDS_OST = LDS_WS + NW * 256, LDS_TOTAL = LDS_OST + NW * 8192;
static_assert(LDS_TOTAL <= RING_BYTES, "MLA LDS map");
#define SBAR() __builtin_amdgcn_sched_barrier(0)
#define PIN(x) asm volatile("" : "+v"(x))
#define MFMA(a, b, c) __builtin_amdgcn_mfma_f32_32x32x16_bf16(a, b, c, 0, 0, 0)
#define WAIT_BAR(N) asm volatile("s_waitcnt vmcnt(" #N ") lgkmcnt(0)\n\ts_barrier" ::: "memory")
#define WAIT_BARH(NLO, NHI) do { if (wid < 4) { WAIT_BAR(NLO); } else { WAIT_BAR(NHI); } } while (0)

__device__ __forceinline__ int crow(int r, int hi) { return (r & 3) + 8 * (r >> 2) + 4 * hi; }
typedef __bf16 bf16x2_n __attribute__((ext_vector_type(2)));
typedef float f32x2_n __attribute__((ext_vector_type(2)));
__device__ __forceinline__ unsigned cvtpk(float lo, float hi) { const f32x2_n v = {lo, hi}; return __builtin_bit_cast(unsigned, __builtin_convertvector(v, bf16x2_n)); }
__device__ __forceinline__ void glds16(const void* g, unsigned lds_base) {
    unsigned sv; asm volatile("s_mov_b32 %0, m0\n\ts_mov_b32 m0, %2\n\ts_nop 0\n\tglobal_load_lds_dwordx4 %1, off\n\ts_mov_b32 m0, %0" : "=&s"(sv) : "v"(g), "s"(lds_base) : "memory"); }
typedef __attribute__((address_space(3))) const char* lds_cptr;
typedef short v4i16_t __attribute__((ext_vector_type(4)));
__device__ __forceinline__ void kload2(bf16x8* kf, lds_cptr kp, int d0) { kf[2 * d0] = *(const __attribute__((address_space(3))) bf16x8*)(kp + d0 * 2048); kf[2 * d0 + 1] = *(const __attribute__((address_space(3))) bf16x8*)(kp + d0 * 2048 + 512); }
__device__ __forceinline__ s16x4 vtr(lds_cptr p) { return __builtin_bit_cast(s16x4, __builtin_amdgcn_ds_read_tr16_b64_v4i16((__attribute__((address_space(3))) v4i16_t*)p)); }
__device__ __forceinline__ void cmask(f32x16& p0, f32x16& p1, int jb, int qrel, int hi) {
    int d = qrel - (64 * jb + 4 * hi); asm volatile("" : "+v"(d));
#pragma unroll
    for (int r = 0; r < 16; ++r) { const int c = (r & 3) + 8 * (r >> 2); if (c > d) p0[r] = -INFINITY; if (c + 32 > d) p1[r] = -INFINITY; } }

__device__ __forceinline__ void bmask(f32x16& p0, f32x16& p1, int jb, int wid, int qrel, int hi) {
    const int part = wid >> 1;
    if (jb == part) cmask(p0, p1, jb, qrel, hi);
    else if (jb > part) {
#pragma unroll
        for (int r = 0; r < 16; ++r) { p0[r] = -INFINITY; p1[r] = -INFINITY; } }
}
template <int VAR> __device__ __forceinline__ f32x16 mqk(bf16x8 a, bf16x8 b, f32x16 c) { if constexpr ((VAR & 128) != 0) return c; else return MFMA(a, b, c); }
template <int VAR> __device__ __forceinline__ f32x16 mpv(bf16x8 a, bf16x8 b, f32x16 c) { if constexpr ((VAR & 64) != 0) return c; else return MFMA(a, b, c); }
struct Ptrs { const bf16 *QBN, *QBR, *KN, *KR, *VB, *SZB; bf16* AB; const float *SSCQ, *rope, *gq, *SSQ; float* RS; unsigned long long* pts; };
#ifdef PROBE_MLAT
#define MSTAMP(k) do { if (blockIdx.x == 0 && wid == 0 && ui == PROBE_MLAT && lane_id() == 0) P.pts[k] = __builtin_amdgcn_s_memrealtime(); } while (0)
#else
#define MSTAMP(k) do { } while (0)
#endif

__device__ __forceinline__ void q_prep_units(int bh, int s, int ulo, int uhi, const Ptrs& P, const int wid) {
    const int lane = lane_id(), r32 = lane & 31, hi = lane >> 5; const int b = bh >> 4, h = bh & 15;
    if (hi != 0) return;
    f32x4 sc[8]; float s0[8], s1[8];
#pragma unroll
    for (int i = 0; i < 8; ++i) if (i >= ulo && i < uhi) { const int qb = (i & 1) ? 8 * (i >> 1) + 7 - s : 8 * (i >> 1) + s; const long row = (long)b * SEQ + qb * QB + wid * QBLK + r32;
        sc[i] = *(const f32x4*)(P.SSCQ + row * 4); s0[i] = P.SSQ[row * 32 + h]; s1[i] = P.SSQ[row * 32 + 16 + h]; }
#pragma unroll
    for (int i = 0; i < 8; ++i) if (i >= ulo && i < uhi) { const int qb = (i & 1) ? 8 * (i >> 1) + 7 - s : 8 * (i >> 1) + s; const long row = (long)b * SEQ + qb * QB + wid * QBLK + r32;
        const float msl = ((sc[i][0] + sc[i][1]) + (sc[i][2] + sc[i][3])) * (1.0f / 256.0f) + EPS;
        P.RS[row * 16 + h] = rsqrtf((s0[i] + s1[i]) * (1.0f / 96.0f) + EPS * msl) * QB_SCALE; }
}

template <int VAR> __device__ __forceinline__ void mla_cu(int bh, int s, int ulo, int uhi, const Ptrs& P, char* lds, const int wid) {
    const int b = bh >> 4, h = bh & 15;
    const long rowbase = (long)b * SEQ;
    if (wid >= 4) __builtin_amdgcn_s_setprio(1);
    bf16x8 qr[6]; float qscale = 0.f;
    int ks_prev = 2 * KSLOT, ks_cur = 0, ks_next = KSLOT, vs_prev = 2 * VSLOT, vs_cur = 0, vs_next = VSLOT;
#define QB_OF(i) (((i) & 1) ? 8 * ((i) >> 1) + 7 - s : 8 * ((i) >> 1) + s)
  for (int ui = ulo; ui < uhi; ++ui) {
    const int qb = QB_OF(ui); const bool first = ui == ulo, has_next = ui + 1 < uhi;
    MSTAMP(30);
    int lane = lane_id(); asm volatile("" : "+v"(lane));
    const int r32 = lane & 31, hi = lane >> 5;
    const int q0 = qb * QB, NT = (q0 + QB) / KVBLK;
    const unsigned lds0 = (unsigned)(uintptr_t)lds; float* wsf = (float*)(lds + LDS_WS) + wid * 64;
    const bf16* ksrc = P.KN + (rowbase + lane) * 1024 + h * 64 + wid * 8;
    const bf16* rsrc = P.KR + (rowbase + lane) * 32 + (wid & 3) * 8;
    const bf16* vsrc = P.VB + (rowbase + 16 * (wid & 3) + (lane >> 2)) * 1024 + h * 64 + (wid >> 2) * 32 + (lane & 3) * 8;
    const unsigned kdst = lds0 + LDS_K + wid * 1024, rdst = lds0 + LDS_K + (8 + (wid & 3)) * 1024, vdst = lds0 + LDS_V + wid * 1024;
#define DMA_K(t, slot) do { if (VAR & 4) break; glds16(ksrc + (long)(t) * KVBLK * 1024, (unsigned)__builtin_amdgcn_readfirstlane(kdst + (slot))); if (wid < 4) glds16(rsrc + (long)(t) * KVBLK * 32, (unsigned)__builtin_amdgcn_readfirstlane(rdst + (slot))); } while (0)
#define DMA_V(t, slot) if (!(VAR & 4)) glds16(vsrc + (long)(t) * KVBLK * 1024, (unsigned)__builtin_amdgcn_readfirstlane(vdst + (slot)))
    const lds_cptr vp0 = (lds_cptr)lds + LDS_V + ((lane >> 4) & 1) * 32 + (lane & 3) * 8 + (4 * hi + ((lane & 15) >> 2)) * 64;
    const lds_cptr kp0 = (lds_cptr)lds + LDS_K + hi * 1024 + r32 * 16;
#define LOADQ(Q0_) do { const long row_ = rowbase + (Q0_) + wid * QBLK + r32; \
        _Pragma("unroll") for (int d0 = 0; d0 < 4; ++d0) qr[d0] = *(const bf16x8*)(P.QBN + row_ * 1024 + h * 64 + d0 * 16 + hi * 8); \
        _Pragma("unroll") for (int d0 = 4; d0 < 6; ++d0) qr[d0] = *(const bf16x8*)(P.QBR + row_ * 512 + h * 32 + (d0 - 4) * 16 + hi * 8); \
        qscale = P.RS[row_ * 16 + h]; } while (0)
    if (first) { DMA_K(0, ks_cur); DMA_V(0, vs_cur); DMA_K(1, ks_next); LOADQ(q0); }
    float l_reg = 0.f; f32x16 o[2]; o[0] = f32x16{}; o[1] = f32x16{};
    const int qrel = wid * QBLK + r32;
    f32x16 pA0, pA1, pB0, pB1; bf16x8 kf[12]; s16x4 vlo[8], vhi[8]; u32x4 pw0, pw1, pw2, pw3;
#define ROT() do { ks_prev = ks_cur; ks_cur = ks_next; ks_next = (ks_next == 2 * KSLOT) ? 0 : ks_next + KSLOT; vs_prev = vs_cur; vs_cur = vs_next; vs_next = (vs_next == 2 * VSLOT) ? 0 : vs_next + VSLOT; } while (0)
#define EX(v) ((VAR & 2) ? (v) : __builtin_amdgcn_exp2f(v))
    if (first) { DMA_K(2, ks_prev); WAIT_BARH(5, 3); }
    else { WAIT_BARH(20, 18); }
#pragma unroll
    for (int d0 = 0; d0 < 6; ++d0) { const u32x4 w = __builtin_bit_cast(u32x4, qr[d0]); u32x4 pk;
        pk.x = cvtpk(bflo(w.x) * qscale, bfhi(w.x) * qscale); pk.y = cvtpk(bflo(w.y) * qscale, bfhi(w.y) * qscale); pk.z = cvtpk(bflo(w.z) * qscale, bfhi(w.z) * qscale); pk.w = cvtpk(bflo(w.w) * qscale, bfhi(w.w) * qscale);
        qr[d0] = __builtin_bit_cast(bf16x8, pk); }
    _Pragma("unroll") for (int d0 = 0; d0 < 6; ++d0) kload2(kf, kp0 + ks_cur, d0);
    pA0 = MFMA(kf[0], qr[0], f32x16{}); pA1 = MFMA(kf[1], qr[0], f32x16{});
    _Pragma("unroll") for (int d0 = 1; d0 < 6; ++d0) { pA0 = MFMA(kf[2 * d0], qr[d0], pA0); pA1 = MFMA(kf[2 * d0 + 1], qr[d0], pA1); }
    if (NT == 4) bmask(pA0, pA1, 0, wid, qrel, hi);
#pragma unroll
    for (int r = 0; r < 16; ++r) { pA0[r] = EX(pA0[r]); pA1[r] = EX(pA1[r]); }
    WAIT_BAR(0);
    DMA_K(3, ks_cur); DMA_V(1, vs_next); ROT();
    _Pragma("unroll") for (int d0 = 0; d0 < 6; ++d0) kload2(kf, kp0 + ks_cur, d0);
    WAIT_BARH(3, 2);
#define PKW(Pv, i) cvtpk(Pv[i], Pv[i + 1])
#define PAF(k) __builtin_bit_cast(bf16x8, pw##k)
#define VFR(i) (bf16x8){vlo[i][0], vlo[i][1], vlo[i][2], vlo[i][3], vhi[i][0], vhi[i][1], vhi[i][2], vhi[i][3]}
#define VRD(i) do { if (VAR & 16) break; vlo[i] = vtr(vp_ + (((i) >> 2) * 4096 + ((i) & 3) * 1024)); vhi[i] = vtr(vp_ + (((i) >> 2) * 4096 + ((i) & 3) * 1024 + 512)); } while (0)
#define KRD(G, d0) do { if ((G) && !(VAR & 32)) { kload2(kf, kp0 + ks_next, d0); SBAR(); } } while (0)
#define GAPA3F(MF, a0, a1, a2, W0, PW) do { MF; if (!(VAR & 1)) { sacc += a0; sacc2 = a1 + a2; } W0; PIN(PW); PIN(sacc); PIN(sacc2); SBAR(); } while (0)
#define GAPA3(MF, a0, a1, a2, W0, PW) do { MF; if (!(VAR & 1)) { sacc += a0; sacc2 += a1; sacc += a2; } W0; PIN(PW); PIN(sacc); PIN(sacc2); SBAR(); } while (0)
#define GAPA0(MF, W0, W1, PW) do { MF; W0; W1; PIN(PW); SBAR(); } while (0)
#define GAPA3W2(MF, a0, a1, a2, W0, W1, PW) do { MF; if (!(VAR & 1)) { sacc += a0; sacc2 += a1; sacc += a2; } W0; W1; PIN(PW); PIN(sacc); PIN(sacc2); SBAR(); } while (0)
#define GAPB(MF, X, i) do { MF; X[i] = EX(X[i]); X[i + 1] = EX(X[i + 1]); X[i + 2] = EX(X[i + 2]); X[i + 3] = EX(X[i + 3]); PIN(X); SBAR(); } while (0)
#define STEP(C0, C1, P0, P1, t, MASK, GK, GV, GL, PFX) STEPX(C0, C1, P0, P1, t, MASK, GK, GV, GL, PFX, (t) + 3, (t) + 1)
#define STEPX(C0, C1, P0, P1, t, MASK, GK, GV, GL, PFX, KT, VT) do { SBAR(); \
    const lds_cptr vp_ = vp0 + vs_prev; \
    VRD(0); SBAR(); float sacc = P0[0] + P0[1], sacc2 = 0.f; \
                    GAPA3F(C0 = mqk<VAR>(kf[0], qr[0], f32x16{}), P0[2], P0[3], P0[4],      pw0[0] = PKW(P0, 0),  pw0); \
    VRD(4); SBAR(); GAPA3(C1 = mqk<VAR>(kf[1], qr[0], f32x16{}), P0[5], P0[6], P0[7],       pw0[1] = PKW(P0, 2),  pw0); \
    VRD(1); SBAR(); GAPA3(C0 = mqk<VAR>(kf[2], qr[1], C0),   P0[8], P0[9], P0[10],      pw0[2] = PKW(P0, 4),  pw0); \
    VRD(5); SBAR(); GAPA3(C1 = mqk<VAR>(kf[3], qr[1], C1),   P0[11], P0[12], P0[13],    pw0[3] = PKW(P0, 6),  pw0); \
    VRD(2); SBAR(); GAPA3(C0 = mqk<VAR>(kf[4], qr[2], C0),   P0[14], P0[15], P1[0],     pw1[0] = PKW(P0, 8),  pw1); \
    VRD(6); SBAR(); GAPA3(C1 = mqk<VAR>(kf[5], qr[2], C1),   P1[1], P1[2], P1[3],       pw1[1] = PKW(P0, 10), pw1); \
    VRD(3); SBAR(); GAPA3(C0 = mqk<VAR>(kf[6], qr[3], C0),   P1[4], P1[5], P1[6],       pw1[2] = PKW(P0, 12), pw1); \
    VRD(7); SBAR(); GAPA3(C1 = mqk<VAR>(kf[7], qr[3], C1),   P1[7], P1[8], P1[9],       pw1[3] = PKW(P0, 14), pw1); \
                    GAPA3W2(C0 = mqk<VAR>(kf[8], qr[4], C0), P1[10], P1[11], P1[12],    pw2[0] = PKW(P1, 0),  pw2[1] = PKW(P1, 2),  pw2); \
                    GAPA3W2(C1 = mqk<VAR>(kf[9], qr[4], C1), P1[13], P1[14], P1[15],    pw2[2] = PKW(P1, 4),  pw2[3] = PKW(P1, 6),  pw2); \
                    GAPA0(C0 = mqk<VAR>(kf[10], qr[5], C0),  pw3[0] = PKW(P1, 8),  pw3[1] = PKW(P1, 10), pw3); \
                    GAPA0(C1 = mqk<VAR>(kf[11], qr[5], C1),  pw3[2] = PKW(P1, 12), pw3[3] = PKW(P1, 14), pw3); \
    l_reg += sacc + sacc2; \
    if (GK) DMA_K(KT, ks_cur); if (GV) DMA_V(VT, vs_next); PFX; \
    if (MASK) { const int jb_ = (t) - (NT - 4); if (jb_ >= 0) bmask(C0, C1, jb_, wid, qrel, hi); } \
    SBAR(); \
                GAPB(o[0] = mpv<VAR>(PAF(0), VFR(0), o[0]), C0, 0); \
    KRD(GL, 0); GAPB(o[1] = mpv<VAR>(PAF(0), VFR(4), o[1]), C0, 4); \
    KRD(GL, 1); GAPB(o[0] = mpv<VAR>(PAF(1), VFR(1), o[0]), C0, 8); \
    KRD(GL, 2); GAPB(o[1] = mpv<VAR>(PAF(1), VFR(5), o[1]), C0, 12); \
    KRD(GL, 3); GAPB(o[0] = mpv<VAR>(PAF(2), VFR(2), o[0]), C1, 0); \
    KRD(GL, 4); GAPB(o[1] = mpv<VAR>(PAF(2), VFR(6), o[1]), C1, 4); \
    KRD(GL, 5); GAPB(o[0] = mpv<VAR>(PAF(3), VFR(3), o[0]), C1, 8); \
                GAPB(o[1] = mpv<VAR>(PAF(3), VFR(7), o[1]), C1, 12); \
    } while (0)
    int t = 1;
    MSTAMP(31);
    for (; t + 5 < NT; t += 2) {
        STEP(pB0, pB1, pA0, pA1, t, false, true, true, true, (void)0);     if (VAR & 8) { asm volatile("s_waitcnt vmcnt(2) lgkmcnt(0)" ::: "memory"); } else { WAIT_BARH(3, 2); } ROT();
        STEP(pA0, pA1, pB0, pB1, t + 1, false, true, true, true, (void)0); if (VAR & 8) { asm volatile("s_waitcnt vmcnt(2) lgkmcnt(0)" ::: "memory"); } else { WAIT_BARH(3, 2); } ROT();
    }
    MSTAMP(32);
    if (NT > 4) {
        STEP(pB0, pB1, pA0, pA1, t, false, true, true, true, (void)0);     WAIT_BARH(3, 2); ROT();
        STEP(pA0, pA1, pB0, pB1, t + 1, true, true, true, true, (void)0);  WAIT_BARH(3, 2); ROT();
        t += 2;
    }
    STEPX(pB0, pB1, pA0, pA1, t, true, has_next, true, true, (void)0, 0, (t) + 1);        if (has_next) { WAIT_BARH(3, 2); } else { WAIT_BAR(1); } ROT();
    STEPX(pA0, pA1, pB0, pB1, t + 1, true, has_next, true, true, (void)0, 1, (t) + 2);    if (has_next) { WAIT_BARH(3, 2); } else { WAIT_BAR(1); } ROT();
#define PREFETCH_NEXT() do { if (has_next) { const int nq0_ = QB_OF(ui + 1) * QB; LOADQ(nq0_); } } while (0)
    MSTAMP(33);
    STEPX(pB0, pB1, pA0, pA1, NT - 1, true, has_next, has_next, false, PREFETCH_NEXT(), 2, 0);
    if (has_next) { WAIT_BARH(10, 9); } else { WAIT_BAR(0); }
    MSTAMP(34);
    u32x4 zz[4];
    { int lz = lane_id(); asm volatile("" : "+v"(lz)); const bf16* Zw = P.SZB + (rowbase + q0 + wid * QBLK) * 1024 + h * 64;
#pragma unroll
      for (int i = 0; i < 4; ++i) zz[i] = ld_hint<NT_ATTZ != 0>((const u32x4*)(Zw + (long)(i * 8 + (lz >> 3)) * 1024 + (lz & 7) * 8)); }
    { float sacc = pB0[0] + pB0[1];
#pragma unroll
      for (int r = 2; r < 16; ++r) sacc += pB0[r];
#pragma unroll
      for (int r = 0; r < 16; ++r) sacc += pB1[r];
      l_reg += sacc;
      pw0 = (u32x4){PKW(pB0, 0), PKW(pB0, 2), PKW(pB0, 4), PKW(pB0, 6)}; pw1 = (u32x4){PKW(pB0, 8), PKW(pB0, 10), PKW(pB0, 12), PKW(pB0, 14)};
      pw2 = (u32x4){PKW(pB1, 0), PKW(pB1, 2), PKW(pB1, 4), PKW(pB1, 6)}; pw3 = (u32x4){PKW(pB1, 8), PKW(pB1, 10), PKW(pB1, 12), PKW(pB1, 14)};
      const lds_cptr vp_ = vp0 + vs_cur; _Pragma("unroll") for (int i = 0; i < 8; ++i) VRD(i);
      o[0] = MFMA(PAF(0), VFR(0), o[0]); o[1] = MFMA(PAF(0), VFR(4), o[1]); o[0] = MFMA(PAF(1), VFR(1), o[0]); o[1] = MFMA(PAF(1), VFR(5), o[1]);
      o[0] = MFMA(PAF(2), VFR(2), o[0]); o[1] = MFMA(PAF(2), VFR(6), o[1]); o[0] = MFMA(PAF(3), VFR(3), o[0]); o[1] = MFMA(PAF(3), VFR(7), o[1]); }
    l_reg += __shfl_xor(l_reg, 32);
    int lane2 = lane_id(); asm volatile("" : "+v"(lane2));
    const int r32e = lane2 & 31, hie = lane2 >> 5;
    if (hie == 0) wsf[32 + r32e] = l_reg; asm volatile("s_waitcnt lgkmcnt(0)" ::: "memory");
    float rli[16];
#pragma unroll
    for (int r = 0; r < 16; ++r) rli[r] = __builtin_amdgcn_rcpf(wsf[32 + crow(r, hie)]);
    float* stg = (float*)(lds + LDS_OST) + wid * 2048;
#pragma unroll
    for (int r = 0; r < 16; ++r) { const int orow = crow(r, hie);
#pragma unroll
        for (int d0 = 0; d0 < 2; ++d0) stg[orow * 64 + d0 * 32 + r32e] = o[d0][r] * rli[r]; }
    asm volatile("s_waitcnt lgkmcnt(0)" ::: "memory");
    { const long row0 = rowbase + q0 + wid * QBLK; bf16* Ow = P.AB + row0 * 1024 + h * 64;
#pragma unroll
      for (int i = 0; i < 4; ++i) { const int row = i * 8 + (lane2 >> 3), ch = lane2 & 7;
          const f32x4 a0 = *(const f32x4*)(stg + row * 64 + ch * 8), a1 = *(const f32x4*)(stg + row * 64 + ch * 8 + 4); const u32x4 z = zz[i];
          u32x4 w; w.x = cvtpk(a0[0] * bflo(z.x), a0[1] * bfhi(z.x)); w.y = cvtpk(a0[2] * bflo(z.y), a0[3] * bfhi(z.y)); w.z = cvtpk(a1[0] * bflo(z.z), a1[1] * bfhi(z.z)); w.w = cvtpk(a1[2] * bflo(z.w), a1[3] * bfhi(z.w));
          st_hint<NT_ATTO != 0>(w, (u32x4*)(Ow + (long)row * 1024 + ch * 8)); } }
    asm volatile("s_waitcnt lgkmcnt(0)" ::: "memory");
    MSTAMP(35);
    ROT();
  }
    __builtin_amdgcn_s_setprio(0);
    asm volatile("s_waitcnt lgkmcnt(0)\n\ts_barrier" ::: "memory");
#undef QB_OF
#undef LOADQ
#undef PREFETCH_NEXT
#undef DMA_K
#undef DMA_V
#undef ROT
#undef EX
#undef PKW
#undef PAF
#undef VFR
#undef VRD
#undef KRD
#undef GAPA3
#undef GAPA3F
#undef GAPA0
#undef GAPA3W2
#undef GAPB
#undef STEP
}
#undef SBAR
#undef PIN
#undef MFMA
#undef WAIT_BAR
#undef WAIT_BARH
}

namespace swa {
using bf16x8 = __attribute__((ext_vector_type(8))) short;
using s16x4 = __attribute__((ext_vector_type(4))) short;
using f32x16 = __attribute__((ext_vector_type(16))) float;
typedef __attribute__((address_space(3))) const char* lds_cptr;
typedef short v4i16_t __attribute__((ext_vector_type(4)));
constexpr int L_K = 0, L_V = 32768, L_BT = 65536, L_WS = L_BT + 8192, L_OST = L_WS + 2048, L_TOTAL = L_OST + 8 * 8192;
static_assert(L_TOTAL <= LDS_BYTES, "SWA LDS map");
#define MFMA(a, b, c) __builtin_amdgcn_mfma_f32_32x32x16_bf16(a, b, c, 0, 0, 0)
__device__ __forceinline__ int crow(int r, int hi) { return (r & 3) + 8 * (r >> 2) + 4 * hi; }
__device__ __forceinline__ unsigned cvtpk(float lo, float hi) { unsigned r; asm("v_cvt_pk_bf16_f32 %0, %1, %2" : "=v"(r) : "v"(lo), "v"(hi)); return r; }
__device__ __forceinline__ s16x4 vtr(lds_cptr p) { return __builtin_bit_cast(s16x4, __builtin_amdgcn_ds_read_tr16_b64_v4i16((__attribute__((address_space(3))) v4i16_t*)p)); }

__device__ __forceinline__ void swa_unit(int b, int nblk, int g, const bf16* QA, const bf16* KVA, const bf16* SZA, bf16* AA, const float* BT, const float* sinks, LAS unsigned char* lds, const int wid) {
    const int lane = lane_id(), r32 = lane & 31, hi = lane >> 5, tid = wid * 64 + lane;
    const long rowbase = (long)b * SEQ;
    __syncthreads();
#pragma unroll
    for (int i = 0; i < 4; ++i) { const int e = tid + 512 * i, key = e >> 3, ch = e & 7; const int tok = (nblk - 1) * 128 + key;
        u32x4 kv = (u32x4){0u, 0u, 0u, 0u}, vv = kv;
        if (tok >= 0) { const bf16* src = KVA + (rowbase + tok) * 256 + g * 64 + ch * 8; kv = *(const u32x4*)src; vv = *(const u32x4*)(src + 128); }
        *(LAS u32x4*)(lds + L_K + ch * 4096 + key * 16) = kv;
        *(LAS u32x4*)(lds + L_V + (key >> 6) * 8192 + (ch >> 2) * 4096 + (key & 63) * 64 + (ch & 3) * 16) = vv; }
    for (int e = tid; e < 8 * 256; e += 512) { const int dist = (e & 255) - 64; ((LAS float*)(lds + L_BT))[e] = (unsigned)dist < 128u ? BT[(g * 8 + (e >> 8)) * 128 + dist] : -INFINITY; }
    __syncthreads();
    const lds_cptr kp0 = (lds_cptr)lds + L_K + hi * 4096 + r32 * 16;
    const lds_cptr vp0 = (lds_cptr)lds + L_V + ((lane >> 4) & 1) * 32 + (lane & 3) * 8 + (4 * hi + ((lane & 15) >> 2)) * 64;
    LAS float* wsf = (LAS float*)(lds + L_WS) + wid * 64; LAS float* stg = (LAS float*)(lds + L_OST) + wid * 2048;
    bf16x8 qn[4];
    { const int task = wid * 4, hq = task >> 2, w4 = task & 3, head = g * 8 + hq; const long row0 = rowbase + nblk * 128 + 32 * w4;
#pragma unroll
      for (int d0 = 0; d0 < 4; ++d0) qn[d0] = *(const bf16x8*)(QA + (row0 + r32) * 1024 + head * 64 + d0 * 16 + hi * 8); }
    for (int tk = 0; tk < 4; ++tk) {
        const int task = wid * 4 + tk, hq = task >> 2, w4 = task & 3, head = g * 8 + hq, i0 = 32 * w4;
        const long row0 = rowbase + nblk * 128 + i0;
        bf16x8 qr[4];
#pragma unroll
        for (int d0 = 0; d0 < 4; ++d0) qr[d0] = qn[d0];
        u32x4 zz[4];
        { const bf16* Zw = SZA + row0 * 1024 + head * 64;
#pragma unroll
          for (int i = 0; i < 4; ++i) zz[i] = ld_hint<NT_ATTZ != 0>((const u32x4*)(Zw + (long)(i * 8 + (lane >> 3)) * 1024 + (lane & 7) * 8)); }
        if (tk < 3) { const int t2 = task + 1, hq2 = t2 >> 2, w42 = t2 & 3, head2 = g * 8 + hq2; const long r2 = rowbase + nblk * 128 + 32 * w42;
#pragma unroll
          for (int d0 = 0; d0 < 4; ++d0) qn[d0] = *(const bf16x8*)(QA + (r2 + r32) * 1024 + head2 * 64 + d0 * 16 + hi * 8); }
        f32x16 o[2]; o[0] = f32x16{}; o[1] = f32x16{};
        float l_reg = 0.f;
        const LAS float* tb = (const LAS float*)(lds + L_BT) + hq * 256 + 5 + i0 + 128 - 4 * hi + r32;
        const int jt0 = w4 >> 1; const bool first = nblk == 0;
#pragma unroll 1
        for (int jj = 0; jj < 3; ++jj) {
            const int jt = jt0 + jj;
            if (first && jt < 2) continue;
            f32x16 p0, p1;
            { const LAS float* tp = tb - 64 * jt;
#pragma unroll
              for (int r = 0; r < 16; ++r) { const int cr = (r & 3) + 8 * (r >> 2); p0[r] = tp[59 - cr]; p1[r] = tp[27 - cr]; } }
            { const lds_cptr kp = kp0 + jt * 1024;
              bf16x8 k0 = *(const __attribute__((address_space(3))) bf16x8*)(kp), k1 = *(const __attribute__((address_space(3))) bf16x8*)(kp + 512);
              p0 = MFMA(k0, qr[0], p0); p1 = MFMA(k1, qr[0], p1);
#pragma unroll
              for (int d0 = 1; d0 < 4; ++d0) { k0 = *(const __attribute__((address_space(3))) bf16x8*)(kp + d0 * 8192); k1 = *(const __attribute__((address_space(3))) bf16x8*)(kp + d0 * 8192 + 512);
                  p0 = MFMA(k0, qr[d0], p0); p1 = MFMA(k1, qr[d0], p1); } }
#pragma unroll
            for (int r = 0; r < 16; ++r) { p0[r] = __builtin_amdgcn_exp2f(p0[r]); p1[r] = __builtin_amdgcn_exp2f(p1[r]); }
            float sacc = 0.f;
#pragma unroll
            for (int r = 0; r < 16; ++r) sacc += p0[r] + p1[r];
            l_reg += sacc;
            u32x4 pw0 = (u32x4){cvtpk(p0[0], p0[1]), cvtpk(p0[2], p0[3]), cvtpk(p0[4], p0[5]), cvtpk(p0[6], p0[7])}, pw1 = (u32x4){cvtpk(p0[8], p0[9]), cvtpk(p0[10], p0[11]), cvtpk(p0[12], p0[13]), cvtpk(p0[14], p0[15])};
            u32x4 pw2 = (u32x4){cvtpk(p1[0], p1[1]), cvtpk(p1[2], p1[3]), cvtpk(p1[4], p1[5]), cvtpk(p1[6], p1[7])}, pw3 = (u32x4){cvtpk(p1[8], p1[9]), cvtpk(p1[10], p1[11]), cvtpk(p1[12], p1[13]), cvtpk(p1[14], p1[15])};
            const lds_cptr vp_ = vp0 + jt * 8192;
#define VF(i) ({ const s16x4 lo_ = vtr(vp_ + (((i) >> 2) * 4096 + ((i) & 3) * 1024)), hi_ = vtr(vp_ + (((i) >> 2) * 4096 + ((i) & 3) * 1024 + 512)); (bf16x8){lo_[0], lo_[1], lo_[2], lo_[3], hi_[0], hi_[1], hi_[2], hi_[3]}; })
            o[0] = MFMA(__builtin_bit_cast(bf16x8, pw0), VF(0), o[0]); o[1] = MFMA(__builtin_bit_cast(bf16x8, pw0), VF(4), o[1]);
            o[0] = MFMA(__builtin_bit_cast(bf16x8, pw1), VF(1), o[0]); o[1] = MFMA(__builtin_bit_cast(bf16x8, pw1), VF(5), o[1]);
            o[0] = MFMA(__builtin_bit_cast(bf16x8, pw2), VF(2), o[0]); o[1] = MFMA(__builtin_bit_cast(bf16x8, pw2), VF(6), o[1]);
            o[0] = MFMA(__builtin_bit_cast(bf16x8, pw3), VF(3), o[0]); o[1] = MFMA(__builtin_bit_cast(bf16x8, pw3), VF(7), o[1]);
#undef VF
        }
        l_reg += __shfl_xor(l_reg, 32);
        l_reg += __builtin_amdgcn_exp2f(sinks[head] * LOG2E);
        if (hi == 0) wsf[32 + r32] = l_reg;
        asm volatile("s_waitcnt lgkmcnt(0)" ::: "memory");
        float rli[16];
#pragma unroll
        for (int r = 0; r < 16; ++r) rli[r] = __builtin_amdgcn_rcpf(wsf[32 + crow(r, hi)]);
#pragma unroll
        for (int r = 0; r < 16; ++r) { const int orow = crow(r, hi);
#pragma unroll
            for (int d0 = 0; d0 < 2; ++d0) stg[orow * 64 + d0 * 32 + r32] = o[d0][r] * rli[r]; }
        asm volatile("s_waitcnt lgkmcnt(0)" ::: "memory");
        { bf16* Ow = AA + row0 * 1024 + head * 64;
#pragma unroll
          for (int i = 0; i < 4; ++i) { const int row = i * 8 + (lane >> 3), ch = lane & 7;
              const f32x4 a0 = *(const LAS f32x4*)(stg + row * 64 + ch * 8), a1 = *(const LAS f32x4*)(stg + row * 64 + ch * 8 + 4); const u32x4 z = zz[i];
              u32x4 w; w.x = cvtpk(a0[0] * bflo(z.x), a0[1] * bfhi(z.x)); w.y = cvtpk(a0[2] * bflo(z.y), a0[3] * bfhi(z.y)); w.z = cvtpk(a1[0] * bflo(z.z), a1[1] * bfhi(z.z)); w.w = cvtpk(a1[2] * bflo(z.w), a1[3] * bfhi(z.w));
              st_hint<NT_ATTO != 0>(w, (u32x4*)(Ow + (long)row * 1024 + ch * 8)); } }
        asm volatile("s_waitcnt lgkmcnt(0)" ::: "memory");
    }
}
#undef MFMA
}

struct Epi3c {
    static constexpr bool PERM = true, AFTER_DRAIN = false;
    bf16* __restrict__ MG; const bf16* __restrict__ SGA; const bf16* __restrict__ SGB;
    __device__ __forceinline__ void pre(const pg8::Unit&, int) const {}
    __device__ __forceinline__ void mid(pg8::f32x4 (&acc)[2][2][4][2], const pg8::Unit& u, int wr, int wc) const {
        int ln_ = lane_id(); asm volatile("" : "+v"(ln_)); const int fr = ln_ & 15, fq = ln_ >> 4;
        const int row0 = u.pm * 256 + wr * 64 + fr, lc0 = u.pn * 256 + 64 * wc + 8 * fq;
#pragma unroll
        for (int ai = 0; ai < 2; ++ai) {
            u32x4 ga[4][2];
#pragma unroll
            for (int m = 0; m < 4; ++m)
#pragma unroll
                for (int bj = 0; bj < 2; ++bj) ga[m][bj] = ld_hint<NT_SG != 0>((const u32x4*)(SGA + (size_t)(row0 + ai * 128 + m * 16) * 1024 + lc0 + 32 * bj));
#pragma unroll
            for (int m = 0; m < 4; ++m)
#pragma unroll
                for (int bj = 0; bj < 2; ++bj) {
                    const u32x4 A = ga[m][bj];
                    const float a_[8] = {bflo(A.x), bfhi(A.x), bflo(A.y), bfhi(A.y), bflo(A.z), bfhi(A.z), bflo(A.w), bfhi(A.w)};
#pragma unroll
                    for (int e = 0; e < 4; ++e) { acc[ai][bj][m][0][e] *= a_[e]; acc[ai][bj][m][1][e] *= a_[4 + e]; }
                }
            asm volatile("" ::: "memory");
        }
    }
    __device__ __forceinline__ void operator()(AccRef acc, const pg8::Unit& u, int wr, int wc, int, int) const {
        int ln_ = lane_id(); asm volatile("" : "+v"(ln_)); const int fr = ln_ & 15, fq = ln_ >> 4;
        const int row0 = u.pm * 256 + wr * 64 + fr, lc0 = u.pn * 256 + 64 * wc + 8 * fq;
#pragma unroll
        for (int ai = 0; ai < 2; ++ai) {
            u32x4 gb[4][2];
#pragma unroll
            for (int m = 0; m < 4; ++m)
#pragma unroll
                for (int bj = 0; bj < 2; ++bj) gb[m][bj] = ld_hint<NT_SG != 0>((const u32x4*)(SGB + (size_t)(row0 + ai * 128 + m * 16) * 1024 + lc0 + 32 * bj));
#pragma unroll
            for (int m = 0; m < 4; ++m)
#pragma unroll
                for (int bj = 0; bj < 2; ++bj) {
                    const u32x4 g = gb[m][bj];
                    f32x4 v0 = acc[ai][bj][m][0], v1 = acc[ai][bj][m][1];
                    v0[0] *= fmaxf(bflo(g.x), 1e-30f); v0[1] *= fmaxf(bfhi(g.x), 1e-30f); v0[2] *= fmaxf(bflo(g.y), 1e-30f); v0[3] *= fmaxf(bfhi(g.y), 1e-30f);
                    v1[0] *= fmaxf(bflo(g.z), 1e-30f); v1[1] *= fmaxf(bfhi(g.z), 1e-30f); v1[2] *= fmaxf(bflo(g.w), 1e-30f); v1[3] *= fmaxf(bfhi(g.w), 1e-30f);
                    st8(MG + (size_t)(row0 + ai * 128 + m * 16) * 1024 + lc0 + 32 * bj, v0, v1);
                }
            asm volatile("" ::: "memory");
        }
    }
};

struct Epi4 {
    static constexpr bool PERM = false, AFTER_DRAIN = false;
    const float* __restrict__ x; float* __restrict__ X1F; bf16* __restrict__ X1B; float* __restrict__ SSX1; int mode;
    mutable float tch[4];
    __device__ __forceinline__ void pre(const pg8::Unit& u, int tid) const {
        const float* p = x + (size_t)(u.pm * 256 + (tid >> 1)) * 1024 + u.pn * 256 + (tid & 1) * 128;
#pragma unroll
        for (int i = 0; i < 4; ++i) tch[i] = p[32 * i];
    }
    __device__ __forceinline__ void operator()(AccRef acc, const pg8::Unit& u, int wr, int wc, int, int) const {
        int ln_ = lane_id(); asm volatile("" : "+v"(ln_)); const int fr = ln_ & 15, fq = ln_ >> 4;
        asm volatile("" :: "v"(tch[0]), "v"(tch[1]), "v"(tch[2]), "v"(tch[3]));
        const int row0 = u.pm * 256 + wr * 64 + fr, c0 = u.pn * 256 + 32 * wc + 4 * fq;
#ifdef PROBE
        if (mode == 1) { pg8::f32x4 t = acc[0][0][0][0];
#pragma unroll
            for (int i_ = 1; i_ < 32; ++i_) t += acc[i_ >> 4][(i_ >> 3) & 1][(i_ >> 1) & 3][i_ & 1];
            asm volatile("" :: "v"(t)); return; }
        if (mode == 2) { pg8::f32x4 t = acc[0][0][0][0];
#pragma unroll
            for (int ai = 0; ai < 2; ++ai) { f32x4 xv[4][2][2];
#pragma unroll
                for (int m = 0; m < 4; ++m)
#pragma unroll
                    for (int bj = 0; bj < 2; ++bj)
#pragma unroll
                        for (int n = 0; n < 2; ++n) xv[m][bj][n] = *(const f32x4*)(x + (size_t)(row0 + ai * 128 + m * 16) * 1024 + c0 + 128 * bj + 16 * n);
#pragma unroll
                for (int m = 0; m < 4; ++m)
#pragma unroll
                    for (int bj = 0; bj < 2; ++bj)
#pragma unroll
                        for (int n = 0; n < 2; ++n) t += xv[m][bj][n] + acc[ai][bj][m][n];
                asm volatile("" ::: "memory"); }
            asm volatile("" :: "v"(t)); return; }
        if (mode == 4) {
#pragma unroll
            for (int ai = 0; ai < 2; ++ai)
#pragma unroll
                for (int m = 0; m < 4; ++m)
#pragma unroll
                    for (int bj = 0; bj < 2; ++bj)
#pragma unroll
                        for (int n = 0; n < 2; ++n) { const int row = u.pm * 256 + wr * 64 + ai * 128 + m * 16 + (fr & ~1) + n; const int col = u.pn * 256 + 128 * bj + 32 * wc + ((fr & 1) * 4 + fq) * 4;
                            const size_t off = (size_t)row * 1024 + col; const f32x4 v = acc[ai][bj][m][n];
                            *(f32x4*)(X1F + off) = v; u32x2 w; w.x = cvt_pk_bf16(v[0], v[1]); w.y = cvt_pk_bf16(v[2], v[3]); *(u32x2*)(X1B + off) = w; }
            return; }
        if (mode == 3) {
#pragma unroll
            for (int ai = 0; ai < 2; ++ai)
#pragma unroll
                for (int m = 0; m < 4; ++m)
#pragma unroll
                    for (int bj = 0; bj < 2; ++bj)
#pragma unroll
                        for (int n = 0; n < 2; ++n) { const size_t off = (size_t)(row0 + ai * 128 + m * 16) * 1024 + c0 + 128 * bj + 16 * n; const f32x4 v = acc[ai][bj][m][n];
                            *(f32x4*)(X1F + off) = v; u32x2 w; w.x = cvt_pk_bf16(v[0], v[1]); w.y = cvt_pk_bf16(v[2], v[3]); *(u32x2*)(X1B + off) = w; }
            return; }
#endif
#pragma unroll
        for (int ai = 0; ai < 2; ++ai) {
            f32x4 xv[4][2][2];
#pragma unroll
            for (int m = 0; m < 4; ++m)
#pragma unroll
                for (int bj = 0; bj < 2; ++bj)
#pragma unroll
                    for (int n = 0; n < 2; ++n) xv[m][bj][n] = __builtin_nontemporal_load((const f32x4*)(x + (size_t)(row0 + ai * 128 + m * 16) * 1024 + c0 + 128 * bj + 16 * n));
#pragma unroll
            for (int m = 0; m < 4; ++m) {
                const int row = row0 + ai * 128 + m * 16; float ss = 0.f;
#pragma unroll
                for (int bj = 0; bj < 2; ++bj)
#pragma unroll
                    for (int n = 0; n < 2; ++n) {
                        const size_t off = (size_t)row * 1024 + c0 + 128 * bj + 16 * n;
                        const f32x4 v = xv[m][bj][n] + acc[ai][bj][m][n];
                        ss += sumsq4(v);
                        u32x2 w; w.x = cvt_pk_bf16(v[0], v[1]); w.y = cvt_pk_bf16(v[2], v[3]); st_hint<NT_X1B != 0>(w, (u32x2*)(X1B + off));
                    }
                ss = red_fq(ss);
                if (fq == 0) SSX1[(size_t)row * 16 + u.pn * 4 + wc] = ss;
            }
            asm volatile("" ::: "memory");
        }
    }
};

struct EpiE {
    static constexpr bool PERM = true, AFTER_DRAIN = false;
    bf16* ER; float* SSE;
    __device__ __forceinline__ void pre(const pg8::Unit&, int) const {}
    __device__ __forceinline__ void operator()(AccRef acc, const pg8::Unit& u, int wr, int wc, int, int) const {
        int ln_ = lane_id(); asm volatile("" : "+v"(ln_)); const int fr = ln_ & 15, fq = ln_ >> 4;
        const int row0 = u.pm * 256 + wr * 64 + fr, lc0 = u.pn * 256 + 64 * wc + 8 * fq;
#pragma unroll
        for (int ai = 0; ai < 2; ++ai)
#pragma unroll
            for (int m = 0; m < 4; ++m) {
                const int row = row0 + ai * 128 + m * 16;
                float ss = (sumsq4(acc[ai][0][m][0]) + sumsq4(acc[ai][0][m][1])) + (sumsq4(acc[ai][1][m][0]) + sumsq4(acc[ai][1][m][1]));
                ss = red_fq(ss);
                if (fq == 0) SSE[(size_t)row * 16 + u.pn * 4 + wc] = ss;
                bf16* dst = ER + (size_t)row * 1024 + lc0;
#pragma unroll
                for (int bj = 0; bj < 2; ++bj) st8(dst + 32 * bj, acc[ai][bj][m][0], acc[ai][bj][m][1]);
            }
    }
};

struct Epi5 {
    static constexpr bool PERM = false, AFTER_DRAIN = false;
    float* __restrict__ out; const bf16* __restrict__ X1B; const bf16* __restrict__ ER; const float* __restrict__ SSX1; const float* __restrict__ SSE; const float* __restrict__ gpost;
    mutable float tch[4];
    __device__ __forceinline__ void pre(const pg8::Unit& u, int tid) const {
        const size_t o = (size_t)(u.pm * 256 + (tid >> 1)) * 1024 + u.pn * 256 + (tid & 1) * 128;
        tch[0] = *(const float*)(X1B + o); tch[1] = *(const float*)(X1B + o + 64); tch[2] = *(const float*)(ER + o); tch[3] = *(const float*)(ER + o + 64);
    }
    __device__ __forceinline__ void operator()(AccRef acc, const pg8::Unit& u, int wr, int wc, int, int) const {
        int ln_ = lane_id(); asm volatile("" : "+v"(ln_)); const int fr = ln_ & 15, fq = ln_ >> 4;
        asm volatile("" :: "v"(tch[0]), "v"(tch[1]), "v"(tch[2]), "v"(tch[3]));
        const int row0 = u.pm * 256 + wr * 64 + fr, c0 = u.pn * 256 + 32 * wc + 4 * fq;
        f32x4 gp[2][2];
#pragma unroll
        for (int bj = 0; bj < 2; ++bj)
#pragma unroll
            for (int n = 0; n < 2; ++n) gp[bj][n] = *(const f32x4*)(gpost + c0 + 128 * bj + 16 * n);
#pragma unroll
        for (int ai = 0; ai < 2; ++ai)
#pragma unroll
            for (int mp = 0; mp < 2; ++mp) {
                f32x4 sa[2], sb[2]; u32x2 xv[2][2][2], ev[2][2][2];
#pragma unroll
                for (int mm = 0; mm < 2; ++mm) { const int row = row0 + ai * 128 + (2 * mp + mm) * 16;
                    sa[mm] = *(const f32x4*)(SSX1 + (size_t)row * 16 + 4 * fq); sb[mm] = *(const f32x4*)(SSE + (size_t)row * 16 + 4 * fq);
#pragma unroll
                    for (int bj = 0; bj < 2; ++bj)
#pragma unroll
                        for (int n = 0; n < 2; ++n) { const size_t off = (size_t)row * 1024 + c0 + 128 * bj + 16 * n; xv[mm][bj][n] = ld_hint<NT_X1ER != 0>((const u32x2*)(X1B + off)); ev[mm][bj][n] = ld_hint<NT_X1ER != 0>((const u32x2*)(ER + off)); } }
#pragma unroll
                for (int mm = 0; mm < 2; ++mm) { const int m = 2 * mp + mm, row = row0 + ai * 128 + m * 16;
                    const float s1 = red_fq((sa[mm][0] + sa[mm][1]) + (sa[mm][2] + sa[mm][3])), se = red_fq((sb[mm][0] + sb[mm][1]) + (sb[mm][2] + sb[mm][3]));
                    const float r1 = rsqrtf(s1 * (1.0f / 1024.0f) + EPS), re = rsqrtf(se * (1.0f / 1024.0f) + EPS);
#pragma unroll
                    for (int bj = 0; bj < 2; ++bj)
#pragma unroll
                        for (int n = 0; n < 2; ++n) {
                            const size_t off = (size_t)row * 1024 + c0 + 128 * bj + 16 * n;
                            const u32x2 xw = xv[mm][bj][n]; const f32x4 x1 = (f32x4){bflo(xw.x), bfhi(xw.x), bflo(xw.y), bfhi(xw.y)}; const u32x2 e = ev[mm][bj][n];
                            const f32x4 a = acc[ai][bj][m][n] * r1; f32x4 em = (f32x4){bflo(e.x), bfhi(e.x), bflo(e.y), bfhi(e.y)}; em = em * gp[bj][n] * re;
                            f32x4 o;
#pragma unroll
                            for (int q = 0; q < 4; ++q) o[q] = x1[q] + sigmoidf_(a[q]) * em[q];
                            __builtin_nontemporal_store(o, (f32x4*)(out + off));
                        } }
                asm volatile("" ::: "memory");
            }
    }
};

__device__ __forceinline__ float wave_sum(float v) {
#pragma unroll
    for (int o = 1; o < 64; o <<= 1) v += __shfl_xor(v, o);
    return v;
}
struct TrDesc { const float* W; const float* kg; bf16* WT; int ldw, srcc0, krows, K, drow0, k0; };
__device__ __forceinline__ void tr_load(const TrDesc& d, f32x4 (&v)[8], int lane) {
#pragma unroll
    for (int i = 0; i < 8; ++i) { const int kk = 8 * i + (lane >> 3), k = d.k0 + kk; v[i] = (f32x4){0.f, 0.f, 0.f, 0.f};
        if (d.srcc0 >= 0 && k < d.krows) { v[i] = ld_hint<NT_WLD != 0>((const f32x4*)(d.W + (size_t)k * d.ldw + d.srcc0 + 4 * (lane & 7))); if (d.kg) v[i] = v[i] * d.kg[k]; } }
}
__device__ __forceinline__ void tr_store(const TrDesc& d, const f32x4 (&v)[8], LAS float* scr, int lane) {
#pragma unroll
    for (int i = 0; i < 8; ++i) { LAS float* p_ = scr + (8 * i + (lane >> 3)) * 33 + 4 * (lane & 7); p_[0] = v[i][0]; p_[1] = v[i][1]; p_[2] = v[i][2]; p_[3] = v[i][3]; }
    LDS_WAIT(); asm volatile("" ::: "memory");
    const int c = lane & 7;
#pragma unroll
    for (int j = 0; j < 4; ++j) { const int n = (lane >> 3) + 8 * j; const LAS float* s = scr + (8 * c) * 33 + n;
        u32x4 o; o.x = pk2(s[0 * 33], s[1 * 33]); o.y = pk2(s[2 * 33], s[3 * 33]); o.z = pk2(s[4 * 33], s[5 * 33]); o.w = pk2(s[6 * 33], s[7 * 33]);
        *(u32x4*)(d.WT + (size_t)(d.drow0 + n) * d.K + d.k0 + 8 * c) = o; }
    LDS_WAIT(); asm volatile("" ::: "memory");
}
__device__ __forceinline__ void sincos_red(double a, double& s, double& c) {
    const double k = rint(a * 0.63661977236758134308); const double r = fma(-k, 6.123233995736766e-17, fma(-k, 1.5707963267948966, a)); const double r2 = r * r;
    double sp = -1.0 / 1307674368000.0; sp = fma(sp, r2, 1.0 / 6227020800.0); sp = fma(sp, r2, -1.0 / 39916800.0); sp = fma(sp, r2, 1.0 / 362880.0); sp = fma(sp, r2, -1.0 / 5040.0); sp = fma(sp, r2, 1.0 / 120.0); sp = fma(sp, r2, -1.0 / 6.0); sp = fma(sp * r2, r, r);
    double cp = 1.0 / 20922789888000.0; cp = fma(cp, r2, -1.0 / 87178291200.0); cp = fma(cp, r2, 1.0 / 479001600.0); cp = fma(cp, r2, -1.0 / 3628800.0); cp = fma(cp, r2, 1.0 / 40320.0); cp = fma(cp, r2, -1.0 / 720.0); cp = fma(cp, r2, 1.0 / 24.0); cp = fma(cp, r2, -0.5); cp = fma(cp, r2, 1.0);
    const int q = (int)k & 3;
    s = (q == 0) ? sp : (q == 1) ? cp : (q == 2) ? -sp : -cp; c = (q == 0) ? cp : (q == 1) ? -sp : (q == 2) ? -cp : sp;
}
__device__ __forceinline__ int hp_row(int L0) { const int lc = L0 & 255; return (L0 & ~255) + 128 * ((lc >> 5) & 1) + 32 * (lc >> 6); }

constexpr int TR_I1 = (N1 / 32) * 16, TR_I2 = 32 * 16, TR_I5 = 48 * 4, TR_I6 = 32 * 2, TR_I7 = 32 * 4;
constexpr int TR_EARLY = TR_I1 + TR_I5 + 2 * TR_I6, TR_ALL = TR_EARLY + 4 * TR_I2 + TR_I7;
__device__ __forceinline__ TrDesc tr_decode(const Args& a, int it) {
    unsigned char* ws = a.ws;
    constexpr int I1 = TR_I1, I2 = TR_I2, I5 = TR_I5, I6 = TR_I6;
    {
        int r = it;
        if (r < I1) { const int nb = r / 16, kb = r % 16, L0 = nb * 32; int src = L0 < 2720 ? L0 : (L0 < 2816 ? -1 : L0 - 96);
            if (L0 >= 3840) { const int j = (L0 - 3840) >> 8, lc = L0 & 255, wc_ = lc >> 6, bj_ = (lc >> 5) & 1; src = (bj_ ? 4768 : 3744) + 128 * j + 32 * wc_; }
            return TrDesc{a.in[4], nullptr, (bf16*)(ws + WS_BT1), DIN, src, 1024, 1024, hp_row(L0), kb * 64}; } r -= I1;
        if (r < I5) { const int nb = r / 4, kb = r % 4, L0 = nb * 32; const int src = L0 < 1024 ? (L0 >> 6) * 96 + (L0 & 63) : ((L0 - 1024) >> 5) * 96 + 64;
            return TrDesc{a.in[11], a.in[10], (bf16*)(ws + WS_BT2), 1536, src, 256, 256, hp_row(L0), kb * 64}; } r -= I5;
        if (r < I6) { const int nb = r / 2, kb = r % 2; return TrDesc{a.in[13], a.in[12], (bf16*)(ws + WS_BT2) + (size_t)1536 * 256, 1024, nb * 32, 128, 128, hp_row(nb * 32), kb * 64}; } r -= I6;
        if (r < I6) { const int nb = r / 2, kb = r % 2; return TrDesc{a.in[14], a.in[12], (bf16*)(ws + WS_BT2) + (size_t)1536 * 256 + (size_t)1024 * 128, 1024, nb * 32, 128, 128, hp_row(nb * 32), kb * 64}; } r -= I6;
        if (r < I2) { const int nb = r / 16, kb = r % 16; return TrDesc{a.in[9], nullptr, (bf16*)(ws + WS_BT3), 1024, nb * 32, 1024, 2048, hp_row(nb * 32), kb * 64}; } r -= I2;
        if (r < I2) { const int nb = r / 16, kb = r % 16; return TrDesc{a.in[18], nullptr, (bf16*)(ws + WS_BT3) + 1024, 1024, nb * 32, 1024, 2048, hp_row(nb * 32), kb * 64}; } r -= I2;
        if (r < I2) { const int nb = r / 16, kb = r % 16; return TrDesc{a.in[19], nullptr, (bf16*)(ws + WS_WOUT), 1024, nb * 32, 1024, 1024, nb * 32, kb * 64}; } r -= I2;
        if (r < I2) { const int nb = r / 16, kb = r % 16; return TrDesc{a.in[21], a.in[20], (bf16*)(ws + WS_WG), 1024, nb * 32, 1024, 1024, nb * 32, kb * 64}; } r -= I2;
        { const int nb = r / 4, kb = r % 4; return TrDesc{a.in[22], nullptr, (bf16*)(ws + WS_WPP), 1024, nb * 32, 256, 256, hp_row(nb * 32), kb * 64}; }
    }
}

__device__ __forceinline__ void tr_items(Frame& F, const Args& a, int it0, int it1, int worker, int nworkers) {
    LAS float* scr = (LAS float*)(F.lds + F.wave * 16384);
    const int lane = F.lane;
    for (int it = it0 + worker; it < it1; it += 2 * nworkers) {
        const bool two = it + nworkers < it1;
        const TrDesc d0 = tr_decode(a, it), d1 = tr_decode(a, two ? it + nworkers : it);
        f32x4 v0[8], v1[8];
        tr_load(d0, v0, lane); if (two) tr_load(d1, v1, lane);
        tr_store(d0, v0, scr, lane); if (two) tr_store(d1, v1, scr, lane);
    }
}

__device__ __forceinline__ void p0_prologue(Frame& F, const Args& a) {
    unsigned char* ws = a.ws;
    const int gw = F.vcu * NWAVES + F.wave, NGW = F.G * NWAVES, lane = F.lane;
    tr_items(F, a, 0, TR_EARLY, gw, NGW);
    FSTAMP(F, 10);
    {
        const float* x = a.in[0]; const float* g = a.in[3]; bf16* XN = (bf16*)(ws + WS_XN);
        f32x4 gv[4];
#pragma unroll
        for (int j = 0; j < 4; ++j) gv[j] = *(const f32x4*)(g + 4 * lane + 256 * j);
        for (int m = gw; m < T; m += 4 * NGW) {
            f32x4 v[4][4]; float ssq[4];
#pragma unroll
            for (int r = 0; r < 4; ++r) { const int mr = m + r * NGW < T ? m + r * NGW : m; const f32x4* xr = (const f32x4*)(x + (size_t)mr * DM) + lane;
#pragma unroll
                for (int j = 0; j < 4; ++j) v[r][j] = __builtin_nontemporal_load(xr + 64 * j); }
#pragma unroll
            for (int r = 0; r < 4; ++r) { float s_ = 0.f;
#pragma unroll
                for (int j = 0; j < 4; ++j) s_ += sumsq4(v[r][j]);
                ssq[r] = s_; }
#pragma unroll
            for (int o = 1; o < 64; o <<= 1) {
#pragma unroll
                for (int r = 0; r < 4; ++r) ssq[r] += __shfl_xor(ssq[r], o); }
#pragma unroll
            for (int r = 0; r < 4; ++r) { const int mr = m + r * NGW; if (mr < T) { const float rr = rsqrtf(ssq[r] * (1.0f / DM) + EPS);
                unsigned long long* o8 = (unsigned long long*)(XN + (size_t)mr * DM) + lane;
#pragma unroll
                for (int j = 0; j < 4; ++j) { const f32x4 w = v[r][j] * gv[j] * rr; o8[64 * j] = (unsigned long long)cvt_pk_bf16(w[0], w[1]) | ((unsigned long long)cvt_pk_bf16(w[2], w[3]) << 32); } } }
        }
    }
    FSTAMP(F, 11);
    {
        const int gt = F.vcu * NTHR + F.tid, NGT = F.G * NTHR; const int* pos = (const int*)a.in[2]; float* rope = (float*)(ws + WS_ROPE);
        float invf_c = (float)exp2(-(double)(gt & 15) * (13.287712379549449 / 16.0));
        for (int e = gt; e < T * 16; e += NGT) { const int row = e >> 4, i = e & 15;
            const float invf = (NGT & 15) == 0 ? invf_c : (float)exp2(-(double)i * (13.287712379549449 / 16.0)); const float ang = (float)pos[row] * invf;
            double sv, cv; sincos_red((double)ang, sv, cv); rope[(size_t)row * 32 + i] = (float)cv; rope[(size_t)row * 32 + 16 + i] = (float)sv; }
        float* bt = (float*)(ws + WS_BT); const float* rb = a.in[8];
        for (int e = gt; e < 16 * 128; e += NGT) { const int h = e >> 7, d = e & 127;
            int b = d; if (d >= 16) { b = 16 + (int)(logf((float)d * (1.0f / 16.0f)) / logf(8.0f) * 16.0f); b = b < 31 ? b : 31; }
            bt[e] = rb[b * 16 + h] * LOG2E; }
    }
    FSTAMP(F, 12);
}
__device__ __forceinline__ void p_to_bf16(Frame& F, const Args& a, int worker, int nworkers) {
    const int gt = worker * NTHR + F.tid, NGT = nworkers * NTHR; const f32x4* p = (const f32x4*)a.in[1]; u32x2* o = (u32x2*)(a.ws + WS_PB);
    for (int e = gt; e < T * 256 / 4; e += NGT) { const f32x4 v = ld_hint<NT_PLD != 0>(p + e); u32x2 w; w.x = cvt_pk_bf16(v[0], v[1]); w.y = cvt_pk_bf16(v[2], v[3]); st_hint<NT_PST != 0>(w, o + e); }
}

__device__ __forceinline__ void cvt8(u32x4 w, LAS float* d) {
    *(LAS f32x4*)d = (f32x4){bflo(w.x), bfhi(w.x), bflo(w.y), bfhi(w.y)}; *(LAS f32x4*)(d + 4) = (f32x4){bflo(w.z), bfhi(w.z), bflo(w.w), bfhi(w.w)};
}
__device__ __forceinline__ void mla_simple(Frame& F, const Args& a) {
    unsigned char* ws = a.ws;
    const bf16 *QBN = (const bf16*)(ws + WS_QBN), *QBR = (const bf16*)(ws + WS_QBR), *KN = (const bf16*)(ws + WS_KN), *KR = (const bf16*)(ws + WS_KR), *VB = (const bf16*)(ws + WS_VB);
    const bf16* SZB = (const bf16*)a.out + (size_t)T * 1024; bf16* AB = (bf16*)(ws + WS_QBN);
    const float *SSCQ = (const float*)(ws + WS_SSCQ), *rope = (const float*)(ws + WS_ROPE), *gq = a.in[15];
    LAS float* Kf = (LAS float*)F.lds; LAS float* Vf = Kf + 64 * 96;
    const int tid = F.tid;
    for (int ui = F.vcu; ui < 1024; ui += F.G) {
        const int bh = ui & 63, s = ui >> 6; const int qb = ((s >> 2) & 1) ? 4 * (s >> 2) + 3 - (s & 3) : 4 * (s >> 2) + (s & 3);
        const int b = bh >> 4, h = bh & 15; const int qpos = qb * 512 + tid; const size_t row = (size_t)b * SEQ + qpos;
        f32x4 q[24];
        {
            const u32x4* qn = (const u32x4*)(QBN + row * 1024 + h * 64); const u32x4* qr = (const u32x4*)(QBR + row * 512 + h * 32);
#pragma unroll
            for (int c = 0; c < 12; ++c) { const u32x4 w = c < 8 ? qn[c] : qr[c - 8];
                q[2 * c] = (f32x4){bflo(w.x), bfhi(w.x), bflo(w.y), bfhi(w.y)}; q[2 * c + 1] = (f32x4){bflo(w.z), bfhi(w.z), bflo(w.w), bfhi(w.w)}; }
            const float* SSQ = (const float*)(ws + WS_SSQ); const float ss = SSQ[row * 32 + h] + SSQ[row * 32 + 16 + h];
            const f32x4 sc = *(const f32x4*)(SSCQ + row * 4);
            const float msl = ((sc[0] + sc[1]) + (sc[2] + sc[3])) * (1.0f / 256.0f) + EPS;
            const float r = rsqrtf(ss * (1.0f / 96.0f) + EPS * msl);
#pragma unroll
            for (int c = 0; c < 24; ++c) q[c] = q[c] * r;
#pragma unroll
            for (int c = 0; c < 24; ++c) q[c] = q[c] * QB_SCALE;
        }
        f32x4 o[16];
#pragma unroll
        for (int c = 0; c < 16; ++c) o[c] = (f32x4){0.f, 0.f, 0.f, 0.f};
        float mrun = -INFINITY, l = 0.f;
        const int nkt = (qb + 1) * 8;
        for (int kt = 0; kt < nkt; ++kt) {
            __syncthreads();
            { const int key = tid >> 3, ch = tid & 7; const size_t kr = (size_t)b * SEQ + kt * 64 + key;
              cvt8(*(const u32x4*)(KN + kr * 1024 + h * 64 + ch * 8), Kf + key * 96 + ch * 8);
              cvt8(*(const u32x4*)(VB + kr * 1024 + h * 64 + ch * 8), Vf + key * 64 + ch * 8);
              if (tid < 256) { const int k2 = tid >> 2, c2 = tid & 3; cvt8(*(const u32x4*)(KR + ((size_t)b * SEQ + kt * 64 + k2) * 32 + c2 * 8), Kf + k2 * 96 + 64 + c2 * 8); } }
            __syncthreads();
            for (int c8 = 0; c8 < 8; ++c8) {
                float sv[8]; float cm = -INFINITY;
#pragma unroll
                for (int j = 0; j < 8; ++j) { const LAS f32x4* kp = (const LAS f32x4*)(Kf + (c8 * 8 + j) * 96); f32x4 acc = q[0] * kp[0];
#pragma unroll
                    for (int c = 1; c < 24; ++c) acc += q[c] * kp[c];
                    float sj = (acc[0] + acc[1]) + (acc[2] + acc[3]);
                    if (kt * 64 + c8 * 8 + j > qpos) sj = -INFINITY;
                    sv[j] = sj; cm = fmaxf(cm, sj); }
                const float mn = fmaxf(mrun, cm), f = __builtin_amdgcn_exp2f(mrun - mn); mrun = mn; l *= f;
#pragma unroll
                for (int c = 0; c < 16; ++c) o[c] = o[c] * f;
#pragma unroll
                for (int j = 0; j < 8; ++j) { const float p = __builtin_amdgcn_exp2f(sv[j] - mn); l += p; const LAS f32x4* vp = (const LAS f32x4*)(Vf + (c8 * 8 + j) * 64);
#pragma unroll
                    for (int c = 0; c < 16; ++c) o[c] += vp[c] * p; }
            }
        }
        const float rl = 1.0f / l;
        const u32x4* sz = (const u32x4*)(SZB + row * 1024 + h * 64); u32x4* dst = (u32x4*)(AB + row * 1024 + h * 64);
#pragma unroll
        for (int c = 0; c < 8; ++c) { const u32x4 g = sz[c]; f32x4 v0 = o[2 * c] * rl, v1 = o[2 * c + 1] * rl;
            v0[0] *= bflo(g.x); v0[1] *= bfhi(g.x); v0[2] *= bflo(g.y); v0[3] *= bfhi(g.y); v1[0] *= bflo(g.z); v1[1] *= bfhi(g.z); v1[2] *= bflo(g.w); v1[3] *= bfhi(g.w);
            u32x4 w; w.x = cvt_pk_bf16(v0[0], v0[1]); w.y = cvt_pk_bf16(v0[2], v0[3]); w.z = cvt_pk_bf16(v1[0], v1[1]); w.w = cvt_pk_bf16(v1[2], v1[3]); dst[c] = w; }
    }
    __syncthreads();
}
__device__ __forceinline__ void swa_simple(Frame& F, const Args& a) {
    unsigned char* ws = a.ws;
    const bf16 *QA = (const bf16*)(ws + WS_QA), *KVA = (const bf16*)(ws + WS_KVA); const bf16* SZA = (const bf16*)a.out; bf16* AA = (bf16*)(ws + WS_QA);
    const float *bt = (const float*)(ws + WS_BT), *sinks = a.in[7];
    LAS float* Kf = (LAS float*)F.lds; LAS float* Vf = Kf + 256 * 64;
    const int tid = F.tid;
    for (int ui = F.vcu; ui < 256; ui += F.G) {
        const int b = ui >> 6, nblk = ui & 63;
        for (int g = 0; g < 2; ++g) {
            __syncthreads();
            for (int e = tid; e < 256 * 8; e += NTHR) { const int c = e >> 3, ch = e & 7; const int tok = (nblk - 1) * 128 + c;
                if (tok >= 0) { const size_t kr = (size_t)b * SEQ + tok;
                    cvt8(*(const u32x4*)(KVA + kr * 256 + g * 64 + ch * 8), Kf + c * 64 + ch * 8);
                    cvt8(*(const u32x4*)(KVA + kr * 256 + 128 + g * 64 + ch * 8), Vf + c * 64 + ch * 8); }
                else { const u32x4 z = (u32x4){0u, 0u, 0u, 0u}; cvt8(z, Kf + c * 64 + ch * 8); cvt8(z, Vf + c * 64 + ch * 8); } }
            __syncthreads();
            for (int itr = 0; itr < 2; ++itr) {
                const int p = tid + NTHR * itr, ql = p & 127, head = g * 8 + (p >> 7); const int ql0 = ql & ~63;
                const size_t row = (size_t)b * SEQ + nblk * 128 + ql;
                f32x4 q[16];
                { const u32x4* qp = (const u32x4*)(QA + row * 1024 + head * 64);
#pragma unroll
                  for (int c = 0; c < 8; ++c) { const u32x4 w = qp[c]; q[2 * c] = (f32x4){bflo(w.x), bfhi(w.x), bflo(w.y), bfhi(w.y)}; q[2 * c + 1] = (f32x4){bflo(w.z), bfhi(w.z), bflo(w.w), bfhi(w.w)}; } }
                f32x4 o[16];
#pragma unroll
                for (int c = 0; c < 16; ++c) o[c] = (f32x4){0.f, 0.f, 0.f, 0.f};
                float mrun = sinks[head] * LOG2E, l = 1.0f;
                const float* bth = bt + head * 128;
                for (int c0 = ql0 + 1; c0 < ql0 + 192; c0 += 8) {
                    float sv[8]; float cm = -INFINITY;
#pragma unroll
                    for (int j = 0; j < 8; ++j) { const int c = c0 + j; const int cc = c < 256 ? c : 255; const LAS f32x4* kp = (const LAS f32x4*)(Kf + cc * 64); f32x4 acc = q[0] * kp[0];
#pragma unroll
                        for (int d = 1; d < 16; ++d) acc += q[d] * kp[d];
                        const int dist = ql + 128 - c; const bool valid = dist >= 0 && dist < 128 && c < 256 && !(nblk == 0 && c < 128);
                        float sj = (acc[0] + acc[1]) + (acc[2] + acc[3]) + bth[dist & 127];
                        sj = valid ? sj : -INFINITY; sv[j] = sj; cm = fmaxf(cm, sj); }
                    const float mn = fmaxf(mrun, cm), f = __builtin_amdgcn_exp2f(mrun - mn); mrun = mn; l *= f;
#pragma unroll
                    for (int d = 0; d < 16; ++d) o[d] = o[d] * f;
#pragma unroll
                    for (int j = 0; j < 8; ++j) { const int c = c0 + j; const int cc = c < 256 ? c : 255; const float pj = __builtin_amdgcn_exp2f(sv[j] - mn); l += pj; const LAS f32x4* vp = (const LAS f32x4*)(Vf + cc * 64);
#pragma unroll
                        for (int d = 0; d < 16; ++d) o[d] += vp[d] * pj; }
                }
                const float rl = 1.0f / l;
                const u32x4* sz = (const u32x4*)(SZA + row * 1024 + head * 64); u32x4* dst = (u32x4*)(AA + row * 1024 + head * 64);
#pragma unroll
                for (int c = 0; c < 8; ++c) { const u32x4 gz = sz[c]; f32x4 v0 = o[2 * c] * rl, v1 = o[2 * c + 1] * rl;
                    v0[0] *= bflo(gz.x); v0[1] *= bfhi(gz.x); v0[2] *= bflo(gz.y); v0[3] *= bfhi(gz.y); v1[0] *= bflo(gz.z); v1[1] *= bfhi(gz.z); v1[2] *= bflo(gz.w); v1[3] *= bfhi(gz.w);
                    u32x4 w; w.x = cvt_pk_bf16(v0[0], v0[1]); w.y = cvt_pk_bf16(v0[2], v0[3]); w.z = cvt_pk_bf16(v1[0], v1[1]); w.w = cvt_pk_bf16(v1[2], v1[3]); dst[c] = w; }
            }
        }
    }
    __syncthreads();
}

__device__ __forceinline__ void swa_phase(Frame& F, const Args& a) {
    unsigned char* ws = a.ws;
    unsigned* qctr = (unsigned*)(ws + WS_CTL + 8192); volatile LAS unsigned* qw = (volatile LAS unsigned*)(F.lds + LDS_BYTES - 128);
    const bool asker = F.wave == 0 && lane_id() == 0;
    unsigned got = 0u; if (asker) got = __hip_atomic_fetch_add(qctr, 1u, __ATOMIC_RELAXED, __HIP_MEMORY_SCOPE_AGENT);
    float gqm, gkm, rbm, skm;
    { const int l = F.lane; float v = fabsf(a.in[5][l]), w = fabsf(a.in[6][l]), z = 0.f, y = fabsf(a.in[7][l & 15]);
#pragma unroll
      for (int j = 0; j < 8; ++j) z = fmaxf(z, fabsf(a.in[8][l + 64 * j]));
#pragma unroll
      for (int o = 1; o < 64; o <<= 1) { v = fmaxf(v, __shfl_xor(v, o)); w = fmaxf(w, __shfl_xor(w, o)); z = fmaxf(z, __shfl_xor(z, o)); y = fmaxf(y, __shfl_xor(y, o)); }
      gqm = v; gkm = w; rbm = z; skm = y; }
    const float Mb = fmaxf(1.01f * QA_SCALE * 64.0f * gqm * gkm + rbm * LOG2E, skm * LOG2E);
    bool general = !(__builtin_amdgcn_readfirstlane(__float_as_int(Mb)) < __float_as_int(64.0f));
#ifdef FORCE_SIMPLE
    general = true;
#endif
    if (general) { swa_simple(F, a); return; }
#define SWA_UNIT(u) swa::swa_unit((u) >> 7, ((u) >> 1) & 63, (u) & 1, (const bf16*)(ws + WS_QA), (const bf16*)(ws + WS_KVA), (const bf16*)a.out, (bf16*)(ws + WS_QA), (const float*)(ws + WS_BT), a.in[7], F.lds, F.wave)
    for (;;) {
        if (asker) qw[0] = got;
        __syncthreads();
        const unsigned u = qw[0];
        if (u >= 512u) break;
        if (asker) got = __hip_atomic_fetch_add(qctr, 1u, __ATOMIC_RELAXED, __HIP_MEMORY_SCOPE_AGENT);
        SWA_UNIT((int)u);
    }
#undef SWA_UNIT
    __syncthreads();
}

#if defined(PROBE) && defined(PROBE_MLAV)
__device__ __forceinline__ void mla_probe_pass(Frame& F, const Args& a, char* lds) {
    unsigned char* ws = a.ws;
    const mla::Ptrs P{(const bf16*)(ws + WS_QBN), (const bf16*)(ws + WS_QBR), (const bf16*)(ws + WS_KN), (const bf16*)(ws + WS_KR), (const bf16*)(ws + WS_VB), (const bf16*)a.out + (size_t)T * 1024,
                      (bf16*)a.out, (const float*)(ws + WS_SSCQ), (const float*)(ws + WS_ROPE), a.in[15], (const float*)(ws + WS_SSQ), (float*)(ws + WS_RS), (unsigned long long*)(ws + WS_CTL + 4096)};
    for (int vv = F.vcu; vv < 256; vv += F.G) {
        const int bh = vv >> 2, s = vv & 3;
#ifndef PROBE_ULO
#define PROBE_ULO 0
#define PROBE_UHI 8
#endif
        mla::mla_cu<PROBE_MLAV>(bh, s, PROBE_ULO, PROBE_UHI, P, lds, F.wave);
    }
}
#endif
__device__ __forceinline__ void mla_phase(Frame& F, const Args& a, char* lds) {
    unsigned char* ws = a.ws;
    const mla::Ptrs P{(const bf16*)(ws + WS_QBN), (const bf16*)(ws + WS_QBR), (const bf16*)(ws + WS_KN), (const bf16*)(ws + WS_KR), (const bf16*)(ws + WS_VB), (const bf16*)a.out + (size_t)T * 1024,
                      (bf16*)(ws + WS_QBN), (const float*)(ws + WS_SSCQ), (const float*)(ws + WS_ROPE), a.in[15], (const float*)(ws + WS_SSQ), (float*)(ws + WS_RS), (unsigned long long*)(ws + WS_CTL + 4096)};
    float gqm, gknm, gkrm;
    { const int l = F.lane; float v = fmaxf(fabsf(a.in[15][l]), fabsf(a.in[15][64 + (l & 31)])), w = fabsf(a.in[16][l]), z = fabsf(a.in[17][l & 31]);
#pragma unroll
      for (int o = 1; o < 64; o <<= 1) { v = fmaxf(v, __shfl_xor(v, o)); w = fmaxf(w, __shfl_xor(w, o)); z = fmaxf(z, __shfl_xor(z, o)); }
      gqm = v; gknm = w; gkrm = z; }
    const float Mb = 1.01f * QB_SCALE * sqrtf(96.0f) * gqm * sqrtf(64.0f * gknm * gknm + 32.0f * gkrm * gkrm);
#ifdef FORCE_SIMPLE
    { mla_simple(F, a); return; }
#endif
    if (!(__builtin_amdgcn_readfirstlane(__float_as_int(Mb)) < __float_as_int(64.0f))) { mla_simple(F, a); return; }
    unsigned* qctr = (unsigned*)(ws + WS_CTL + 8192 + 256); volatile LAS unsigned* qw = (volatile LAS unsigned*)(F.lds + LDS_BYTES - 128);
    const bool asker = F.wave == 0 && lane_id() == 0, dyn = F.G == 256;
    int vv = F.vcu, bh = vv >> 2, s = vv & 3, ulo = dyn ? 1 : 0, uhi = 8;
    if (vv >= 256) return;
    mla::q_prep_units(bh, s, ulo, uhi, P, F.wave);
    for (;;) {
        mla::mla_cu<0>(bh, s, ulo, uhi, P, lds, F.wave);
        if (dyn) {
            if (asker) qw[0] = __hip_atomic_fetch_add(qctr, 1u, __ATOMIC_RELAXED, __HIP_MEMORY_SCOPE_AGENT);
            __syncthreads();
            const unsigned idx = qw[0];
            __syncthreads();
            if (idx >= 256u) break;
            bh = (int)(idx & 63u); s = 3 - (int)(idx >> 6); ulo = 0; uhi = 1;
            mla::q_prep_units(bh, s, 0, 1, P, F.wave);
        } else {
            vv += F.G; if (vv >= 256) break;
            bh = vv >> 2; s = vv & 3;
            mla::q_prep_units(bh, s, 0, 8, P, F.wave);
        }
    }
}

#define RLX_AGENT __ATOMIC_RELAXED, __HIP_MEMORY_SCOPE_AGENT
#define XB_TMO      128
#define XB_XCNT(j)  (256  + 64 * (j))
#define XB_XSUB(j)  (1280 + 64 * (j))
#define XB_XGEN(j)  (2304 + 64 * (j))
#define XB_TOP      3328
#define XB_TOPGEN   3392
#define XCD_BAR_WORDS 3456
#define XB_SPIN_CAP (1u << 18)

__device__ __forceinline__ unsigned xb_ld(unsigned* p)              { return __hip_atomic_load(p, __ATOMIC_RELAXED, __HIP_MEMORY_SCOPE_AGENT); }
__device__ __forceinline__ unsigned xb_add(unsigned* p, unsigned v) { return __hip_atomic_fetch_add(p, v, __ATOMIC_RELAXED, __HIP_MEMORY_SCOPE_AGENT); }
__device__ __forceinline__ unsigned xb_xcc_id() { return (unsigned)__builtin_amdgcn_s_getreg((3 << 11) | 20) & 0xFu; }
#define XB_SPIN(cond, bar) do { unsigned _sp = 0; while (cond) { __builtin_amdgcn_s_sleep(1); \
    if ((++_sp & 255u) == 0u) { if (xb_ld(&(bar)[XB_TMO])) break; if (_sp > XB_SPIN_CAP) { atomicAdd(&(bar)[XB_TMO], 1u); break; } } } } while (0)

struct XcdBarrier {
    unsigned* bar; unsigned x; bool leader;
    volatile LAS unsigned* st;
};

__device__ __forceinline__ XcdBarrier xcd_barrier_post(unsigned* bar, volatile LAS unsigned* st, bool leader) {
    XcdBarrier b; b.bar = bar; b.x = xb_xcc_id(); b.st = st; b.leader = leader;
    if (b.leader) (void)xb_add(&bar[XB_XCNT(b.x)], 1u);
    return b;
}
__device__ __forceinline__ void xcd_barrier_complete(unsigned* bar, unsigned x, unsigned& nloc, unsigned& nx) {
    const unsigned G = gridDim.x * gridDim.y * gridDim.z;
    unsigned sum, cnt, mine, sp = 0u;
    for (;;) {
        sum = 0u; cnt = 0u; mine = 0u;
#pragma unroll
        for (unsigned j = 0; j < 16; ++j) { const unsigned c = xb_ld(&bar[XB_XCNT(j)]); sum += c; cnt += (c > 0u) ? 1u : 0u; mine = (j == x) ? c : mine; }
        if (sum == G) break;
        __builtin_amdgcn_s_sleep(1);
        if ((++sp & 255u) == 0u) { if (xb_ld(&bar[XB_TMO])) break; if (sp > XB_SPIN_CAP) { atomicAdd(&bar[XB_TMO], 1u); break; } }
    }
    nloc = mine > 0u ? mine : 1u; nx = cnt > 0u ? cnt : 1u;
}

__device__ __forceinline__ void xcd_barrier(const XcdBarrier& b, bool leader) {
    asm volatile("s_waitcnt vmcnt(0)" ::: "memory");
    __syncthreads();
    if (leader) {
        unsigned* bar = b.bar;
        __builtin_amdgcn_s_waitcnt(0);
        unsigned nloc = b.st[0], nx = b.st[1];
        if (nloc == 0u) { xcd_barrier_complete(bar, b.x, nloc, nx); b.st[0] = nloc; b.st[1] = nx; }
        const unsigned old = xb_add(&bar[XB_XSUB(b.x)], 1u);
        const unsigned gen = old / nloc;
        if (old + 1u == (gen + 1u) * nloc) {
            __builtin_amdgcn_fence(__ATOMIC_RELEASE, "agent");
            asm volatile("s_waitcnt vmcnt(0)" ::: "memory");
            const unsigned og = xb_add(&bar[XB_TOP], 1u);
            const unsigned tg = og / nx;
            if (og + 1u == (tg + 1u) * nx) xb_add(&bar[XB_TOPGEN], 1u);
            else XB_SPIN(xb_ld(&bar[XB_TOPGEN]) == tg, bar);
            __builtin_amdgcn_fence(__ATOMIC_ACQUIRE, "agent");
            xb_add(&bar[XB_XGEN(b.x)], 1u);
            asm volatile("s_waitcnt vmcnt(0)" ::: "memory");
        } else {
            XB_SPIN(xb_ld(&bar[XB_XGEN(b.x)]) == gen, bar);
            __builtin_amdgcn_fence(__ATOMIC_ACQUIRE, "agent");
            asm volatile("s_waitcnt vmcnt(0)" ::: "memory");
        }
    }
    __syncthreads();
}

__device__ __forceinline__ void grid_barrier(unsigned* ctr, unsigned target, int wave) {
    asm volatile("s_waitcnt vmcnt(0) lgkmcnt(0)" ::: "memory");
    __syncthreads();
    if (wave == 0 && lane_id() == 0) {
        __builtin_amdgcn_fence(__ATOMIC_RELEASE, "agent");
        asm volatile("s_waitcnt vmcnt(0)" ::: "memory");
        __hip_atomic_fetch_add(ctr, 1u, __ATOMIC_RELAXED, __HIP_MEMORY_SCOPE_AGENT);
        const unsigned long long t0 = __builtin_amdgcn_s_memrealtime();
        while (__hip_atomic_load(ctr, __ATOMIC_RELAXED, __HIP_MEMORY_SCOPE_AGENT) < target) {
            __builtin_amdgcn_s_sleep(2);
            if (__builtin_amdgcn_s_memrealtime() - t0 > 200000000ull) break;
        }
        __builtin_amdgcn_fence(__ATOMIC_ACQUIRE, "agent");
        asm volatile("s_waitcnt vmcnt(0)" ::: "memory");
    }
    __syncthreads();
}

constexpr int NPHASE = 7;
__global__ void __launch_bounds__(NTHR, 2) mk_fwd(Args a) {
    extern __shared__ __attribute__((aligned(16))) unsigned char lds[];
    cg::grid_group grid = cg::this_grid();
    Frame F; F.lds = (LAS unsigned char*)lds; F.wave = __builtin_amdgcn_readfirstlane((int)threadIdx.x >> 6); F.lane = lane_id(); F.tid = F.wave * 64 + F.lane;
    F.G = gridDim.x; { const int bx = blockIdx.x; F.vcu = (F.G % 8 == 0) ? (bx % 8) * (F.G / 8) + bx / 8 : bx; }
    unsigned char* ws = a.ws;
    const int lo = a.ph_lo, hi = a.ph_hi;
#define IN(k) (lo <= (k) && (k) < hi)
#define RELANE() do { F.lane = lane_id(); F.tid = F.wave * 64 + F.lane; } while (0)
    volatile LAS unsigned* xst = (volatile LAS unsigned*)(F.lds + LDS_BYTES - 256);
    if (F.wave == 0 && lane_id() < 2) xst[lane_id() & 1] = 0u;
    __syncthreads();
    const XcdBarrier xbar = xcd_barrier_post((unsigned*)(ws + WS_CTL + 16384), xst, F.wave == 0 && lane_id() == 0);
#ifdef PROBE_BAR
    for (int i_ = 0; i_ < 8; ++i_) xcd_barrier(xbar, F.wave == 0 && lane_id() == 0);
#endif
#if defined(PROBE) && defined(PROBE_IMBP)
#define IMBREC(k) do { if ((k) == PROBE_IMBP && F.wave == 0 && lane_id() == 0) { const unsigned long long t_ = __builtin_amdgcn_s_memrealtime(); atomicMin(&pts[20], t_); atomicMax(&pts[21], t_); } } while (0)
#else
#define IMBREC(k) do { } while (0)
#endif
#define SEAM(k) do { IMBREC(k); if (IN(k) && IN((k) + 1)) xcd_barrier(xbar, F.wave == 0 && lane_id() == 0); STAMP((k) + 1); } while (0)
#ifdef PROBE
    unsigned long long* pts = (unsigned long long*)(ws + WS_CTL + 4096); F.pts = pts;
#define STAMP(k) do { if (blockIdx.x == 0 && F.wave == 0 && lane_id() == 0) pts[k] = __builtin_amdgcn_s_memrealtime(); } while (0)
#else
#define STAMP(k) do { } while (0)
#endif
    STAMP(0);
#if defined(PROBE) && (defined(PROBE_IMB) || defined(PROBE_IMBP))
    if (blockIdx.x == 0 && F.wave == 0 && lane_id() == 0) pts[20] = ~0ull;
#endif
    if (lo > hi) grid.sync();
    bf16* SZA = (bf16*)a.out; bf16* SZB = SZA + (size_t)T * 1024;

#ifndef SKIP_P0
    if (IN(0)) { RELANE(); p0_prologue(F, a); }
#endif
    SEAM(0);

    int K1024 = 1024, K256 = 256; asm volatile("" : "+s"(K1024), "+s"(K256));
    if (IN(1)) {
        pg8::Gemm g{(const bf16*)(ws + WS_XN), (const bf16*)(ws + WS_BT1), T, N1, K1024}; pg8::StaticOrder S; S.init(T, N1, F.G, (int)blockIdx.x);
#if defined(PROBE) && defined(PROBE_MODE1)
        { Epi1 E0{a.out, ws, a.in[5], a.in[6], a.in[17], PROBE_MODE1};
          pg8::gemm_phase<Epi1, pg8::StaticOrder, true, true>(F.lds, g, S, E0, F.wave * 64 + lane_id());
          xcd_barrier(xbar, F.wave == 0 && lane_id() == 0); STAMP(2); }
#define PROBE_SKIP_STAMP2 1
#endif
        Epi1 E{a.out, ws, a.in[5], a.in[6], a.in[17], 0};
#ifndef SKIP_G1
        pg8::gemm_phase<Epi1, pg8::StaticOrder, true, true>(F.lds, g, S, E, F.wave * 64 + lane_id());
#endif
        { const int nwg = (T / 256) * (N1 / 256), rounds = (nwg + F.G - 1) / F.G, first_short = nwg - (rounds - 1) * F.G;
          int nshort = F.G - first_short, w = (int)blockIdx.x - first_short;
          if (nshort == 0) { nshort = F.G; w = (int)blockIdx.x; }
          if (w >= 0) { RELANE(); p_to_bf16(F, a, w, nshort); tr_items(F, a, TR_EARLY, TR_ALL, w * NWAVES + F.wave, nshort * NWAVES); } }
    }
#if defined(PROBE) && defined(PROBE_MODE1)
    if (IN(1) && IN(2)) xcd_barrier(xbar, F.wave == 0 && lane_id() == 0);
#else
    SEAM(1);
#endif

    if (IN(2)) {
        int K128 = 128; asm volatile("" : "+s"(K128));
        { pg8::Gemm g{(const bf16*)(ws + WS_CQKV), (const bf16*)(ws + WS_BT2), T, 1536, K256}; pg8::StaticOrder S; S.init(T, 1536, F.G, (int)blockIdx.x);
          Epi2 E{ws, a.in[16], a.in[15], 0};
#ifndef SKIP_G2
          pg8::gemm_phase<Epi2, pg8::StaticOrder, true, true>(F.lds, g, S, E, F.wave * 64 + lane_id());
#endif
        }
        { pg8::Gemm g{(const bf16*)(ws + WS_CQKV) + (size_t)T * 256, (const bf16*)(ws + WS_BT2) + (size_t)1536 * 256, T, 2048, K128}; pg8::StaticOrder S; S.init(T, 2048, F.G, (int)blockIdx.x);
          Epi2 E{ws, a.in[16], a.in[15], 6};
#ifndef SKIP_G2
          pg8::gemm_phase<Epi2, pg8::StaticOrder, true, true>(F.lds, g, S, E, F.wave * 64 + lane_id());
#endif
        }
    } SEAM(2);

    if (IN(3)) {
#if !defined(SKIP_SWA) && (defined(PROBE_MLAV) || defined(PROBE_SWA))
        RELANE(); swa_phase(F, a);
#ifdef PROBE_SWA
        STAMP(8);
#endif
#endif
#ifndef SKIP_MLA
#ifdef MLA_SIMPLE
        RELANE(); mla_simple(F, a);
#else
#if defined(PROBE) && defined(PROBE_MLAV)
        __syncthreads(); STAMP(3);
        RELANE(); mla_probe_pass(F, a, (char*)lds);
        xcd_barrier(xbar, F.wave == 0 && lane_id() == 0); STAMP(4);
#endif
        RELANE(); mla_phase(F, a, (char*)lds);
#if !defined(SKIP_SWA) && !(defined(PROBE_MLAV) || defined(PROBE_SWA))
        RELANE(); swa_phase(F, a);
#endif
#if defined(PROBE) && defined(PROBE_IMB)
        if (F.wave == 0 && lane_id() == 0) { const unsigned long long t_ = __builtin_amdgcn_s_memrealtime(); atomicMin(&pts[20], t_); atomicMax(&pts[21], t_); }
#endif
#endif
#endif
    }
#if defined(PROBE) && defined(PROBE_MLAV)
    if (IN(3) && IN(4)) xcd_barrier(xbar, F.wave == 0 && lane_id() == 0);
#else
    SEAM(3);
#endif

    if (IN(4)) {
        int K2048 = 2048; asm volatile("" : "+s"(K2048));
        pg8::Gemm g{(const bf16*)(ws + WS_QA), (const bf16*)(ws + WS_BT3), T, 1024, K2048}; pg8::StaticOrder S; S.init(T, 1024, F.G, (int)blockIdx.x);
        Epi3c E{(bf16*)(ws + WS_MG), (const bf16*)(ws + WS_SGA), (const bf16*)(ws + WS_SGB)};
#ifndef SKIP_G3
        pg8::gemm_phase_cat<Epi3c, pg8::StaticOrder, true, true>(F.lds, g, S, E, F.wave * 64 + lane_id(), 1024, 16, (long)(WS_QBN - WS_QA));
#endif
    } SEAM(4);

    int p5mode = 0;
#if defined(PROBE) && defined(PROBE_MODE5)
    if (IN(5)) {
        p5mode = PROBE_MODE5;
        { pg8::Gemm g{(const bf16*)(ws + WS_MG), (const bf16*)(ws + WS_WOUT), T, 1024, K1024}; pg8::StaticOrder S; S.init(T, 1024, F.G, (int)blockIdx.x);
          Epi4 E{a.in[0], (float*)(ws + WS_X1F), (bf16*)(ws + WS_X1B), (float*)(ws + WS_SSX1), p5mode};
#ifdef PROBE_HALF
          if ((F.vcu & 1) == 0)
#endif
          pg8::gemm_phase<Epi4, pg8::StaticOrder, true, true>(F.lds, g, S, E, F.wave * 64 + lane_id()); }
        xcd_barrier(xbar, F.wave == 0 && lane_id() == 0); STAMP(6);
        p5mode = 0; asm volatile("" : "+s"(p5mode));
    }
#endif
    if (IN(5)) {
        for (int st = 0; st < 2; ++st) {
            if (((st ^ F.vcu) & 1) == 0) {
                pg8::Gemm g{(const bf16*)(ws + WS_MG), (const bf16*)(ws + WS_WOUT), T, 1024, K1024}; pg8::StaticOrder S; S.init(T, 1024, F.G, (int)blockIdx.x);
                Epi4 E{a.in[0], (float*)(ws + WS_X1F), (bf16*)(ws + WS_X1B), (float*)(ws + WS_SSX1), p5mode};
#ifndef SKIP_G4
                pg8::gemm_phase<Epi4, pg8::StaticOrder, true, true>(F.lds, g, S, E, F.wave * 64 + lane_id());
#endif
            } else {
                pg8::Gemm g{(const bf16*)(ws + WS_PB), (const bf16*)(ws + WS_WPP), T, 1024, K256}; pg8::StaticOrder S; S.init(T, 1024, F.G, (int)blockIdx.x);
                EpiE E{(bf16*)(ws + WS_ER), (float*)(ws + WS_SSE)};
#ifndef SKIP_GE
                pg8::gemm_phase<EpiE, pg8::StaticOrder, true, true>(F.lds, g, S, E, F.wave * 64 + lane_id());
#endif
            }
        }
    }
#if defined(PROBE) && defined(PROBE_MODE5)
    if (IN(5) && IN(6)) xcd_barrier(xbar, F.wave == 0 && lane_id() == 0);
#else
    SEAM(5);
#endif

    if (IN(6)) {
        pg8::Gemm g{(const bf16*)(ws + WS_X1B), (const bf16*)(ws + WS_WG), T, 1024, K1024}; pg8::StaticOrder S; S.init(T, 1024, F.G, (int)blockIdx.x);
        Epi5 E{a.out, (const bf16*)(ws + WS_X1B), (const bf16*)(ws + WS_ER), (const float*)(ws + WS_SSX1), (const float*)(ws + WS_SSE), a.in[23]};
#ifndef SKIP_G5
        pg8::gemm_phase<Epi5, pg8::StaticOrder, true, true>(F.lds, g, S, E, F.wave * 64 + lane_id());
#endif
    }
#ifdef PROBE
    xcd_barrier(xbar, F.wave == 0 && lane_id() == 0); STAMP(7);
    if (blockIdx.x == 0) {
        __syncthreads();
        volatile unsigned long long* vts = pts;
#ifdef PROBE_SWA
#ifdef PROBE_SWAONLY
        const float sw = (float)(vts[8] - vts[3]) * 0.01f;
#else
        const float sw = ((float)(vts[4] - vts[8]) * 0.01f - 600.0f) * 0.25f;
#endif
        if (F.wave == 0 && lane_id() == 0) a.out[0] += sw * PROBE_SCALE;
        if (0)
#endif
        {}
#if PROBE_A >= 10
        const float sa = (PROBE_A >= 31 && PROBE_A <= 35) ? (float)(vts[PROBE_A] - vts[PROBE_A - 1]) * 0.01f : (PROBE_A == 21) ? (float)(vts[21] - vts[20]) * 0.01f : (PROBE_A == 14) ? (float)(vts[14] - vts[4]) * 0.01f : (PROBE_A == 10) ? (float)(vts[10] - vts[0]) * 0.01f : (PROBE_A == 13) ? (float)(vts[1] - vts[12]) * 0.01f : (float)(vts[PROBE_A] - vts[PROBE_A - 1]) * 0.01f;
        const float sb = 0.f;
#else
        const float sa = (PROBE_A == 7) ? (float)(vts[7] - vts[0]) * 0.01f : (float)(vts[PROBE_A + 1] - vts[PROBE_A]) * 0.01f;
        const float sb = (PROBE_B == 7) ? (float)(vts[7] - vts[0]) * 0.01f : (float)(vts[PROBE_B + 1] - vts[PROBE_B]) * 0.01f;
#endif
        RELANE();
        (void)sb;
#ifndef PROBE_OFFSET
#define PROBE_OFFSET 0.0f
#endif
#ifndef PROBE_SWA
        if (F.tid == 0) a.out[0] += (sa - PROBE_OFFSET) * PROBE_SCALE;
#endif
    }
#endif
#undef IN
#undef SEAM
}

#ifndef MK_N_LAUNCHES
#define MK_N_LAUNCHES 1
#endif
extern "C" void kernel_launch(void* const* d_in, const int* in_sizes, int n_in, void* d_out, int out_size, void* d_ws, size_t ws_size, hipStream_t stream) {
    static int grid = 0;
    if (grid == 0) {
        if (n_in != 24 || in_sizes[0] != T * DM || out_size != T * DM || ws_size < WS_END) { fprintf(stderr, "kernel_launch: unexpected shapes / workspace (n_in %d, ws %zu)\n", n_in, ws_size); grid = -1; return; }
        int dev = 0, cus = 0, per_cu = 0;
        if (hipGetDevice(&dev) != hipSuccess || hipDeviceGetAttribute(&cus, hipDeviceAttributeMultiprocessorCount, dev) != hipSuccess) { grid = -1; return; }
        if (hipFuncSetAttribute((const void*)mk_fwd, hipFuncAttributeMaxDynamicSharedMemorySize, LDS_BYTES) != hipSuccess) { fprintf(stderr, "kernel_launch: hipFuncSetAttribute failed\n"); grid = -1; return; }
        if (hipOccupancyMaxActiveBlocksPerMultiprocessor(&per_cu, (const void*)mk_fwd, NTHR, LDS_BYTES) != hipSuccess || per_cu < 1) { fprintf(stderr, "kernel_launch: occupancy query says %d\n", per_cu); per_cu = 1; }
        (void)hipGetLastError();
        grid = cus;
    }
    if (grid < 0) return;
    Args a{};
    for (int i = 0; i < 24; ++i) a.in[i] = (const float*)d_in[i];
    a.out = (float*)d_out; a.ws = (unsigned char*)d_ws;
    if (hipMemsetAsync((char*)d_ws + WS_CTL, 0, 32768, stream) != hipSuccess) { fprintf(stderr, "kernel_launch: hipMemsetAsync failed\n"); return; }
#if MK_N_LAUNCHES == 1
    a.ph_lo = 0; a.ph_hi = NPHASE;
    void* args[] = {&a};
    hipError_t e = hipLaunchCooperativeKernel((const void*)mk_fwd, dim3(grid), dim3(NTHR), args, LDS_BYTES, stream);
    if (e != hipSuccess) fprintf(stderr, "kernel_launch: cooperative launch failed: %s (grid %d)\n", hipGetErrorString(e), grid);
#else
    for (int ph = 0; ph < NPHASE; ++ph) { a.ph_lo = ph; a.ph_hi = ph + 1; hipLaunchKernelGGL(mk_fwd, dim3(grid), dim3(NTHR), LDS_BYTES, stream, a); }
#endif
}
```

```cpp
#include <hip/hip_runtime.h>
#include <hip/hip_cooperative_groups.h>
#include <cstdio>
#include <cstdint>
namespace cg = cooperative_groups;
namespace pg8 {
#define PG8_LAS __attribute__((address_space(3)))
typedef unsigned short bf16_t;
typedef short bf16x8 __attribute__((ext_vector_type(8)));
typedef float f32x4 __attribute__((ext_vector_type(4)));
typedef unsigned u32x4 __attribute__((ext_vector_type(4)));
constexpr int BM = 256, BK = 64, HALF = 128, HTB = HALF * BK * 2  , STAGE_BYTES = 8 * HTB, NXCD = 8, WGM = 8;

__host__ __device__ __forceinline__ int lds_byte(int r, int c) { const int st = (r >> 4) * 2 + (c >> 5), rr = r & 15, cc = c & 31, ob = rr * 64 + cc * 2; return st * 1024 + (ob ^ (((ob >> 9) & 1) << 5)); }
__host__ __device__ __forceinline__ void stage_rc(int b, int& R, int& C) { const int st = b / 1024, sb = b % 1024, swz = sb ^ (((sb >> 9) & 1) << 5); R = (st >> 1) * 16 + swz / 64; C = (st & 1) * 32 + (swz % 64) / 2; }
__host__ __device__ __forceinline__ int perm32(int rho) { const int n = rho >> 4, i = rho & 15; return 8 * (i >> 2) + 4 * n + (i & 3); }

struct Unit { int pm, pn; };
struct Gemm { const bf16_t* A; const bf16_t* Bt; int M, N, K; };

struct StaticOrder {
    int nM, nN, nwg, G, c;
    __host__ __device__ void init(int M, int N, int G_, int c_) { nM = M / BM; nN = N / BM; nwg = nM * nN; G = G_; c = c_; }
    __host__ __device__ bool next(int i, Unit& u) const {
        const long L = (long)i * G + c; if (L >= nwg) return false;
        int wgid = (int)L; { const int q = nwg / NXCD, r = nwg % NXCD, xcd = wgid % NXCD, off = wgid / NXCD; wgid = (xcd < r ? xcd * (q + 1) : r * (q + 1) + (xcd - r) * q) + off; }
        const int nig = WGM * nN, gid = wgid / nig, fm = gid * WGM, gsz = (nM - fm) < WGM ? (nM - fm) : WGM;
        u.pm = fm + ((wgid % nig) % gsz); u.pn = (wgid % nig) / gsz; return true;
    }
    __device__ __forceinline__ void a_ready(const Unit&) const {}
    __device__ __forceinline__ void done(const Unit&) const {}
};

__device__ __forceinline__ unsigned cvt_pk_bf16(float lo, float hi) { unsigned r; asm volatile("v_cvt_pk_bf16_f32 %0, %1, %2" : "=v"(r) : "v"(lo), "v"(hi)); return r; }
typedef float f32x2 __attribute__((ext_vector_type(2)));
template <class Epi, class Sched, bool ALIGN_EPI = false, bool SP2 = false>
__device__ __forceinline__ void gemm_phase(PG8_LAS unsigned char* lds, const Gemm g, const Sched& S, const Epi& E, const int tid_in) {
    const int tid = tid_in, wid = __builtin_amdgcn_readfirstlane(tid >> 6), lane = tid & 63, wr = wid >> 2, wc = wid & 3, fr = lane & 15, fq = lane >> 4;
    const int K = g.K, nt = K / BK;
    unsigned voffA[2], voffB[2];
#pragma unroll
    for (int i = 0; i < 2; ++i) { int R, C; stage_rc(tid * 16 + i * 8192, R, C); const int Rb = Epi::PERM ? ((R & ~31) + perm32(R & 31)) : R;
        voffA[i] = (unsigned)(R * K + C) * 2u; voffB[i] = (unsigned)(Rb * K + C) * 2u; }
    const size_t kstep = (size_t)(BK * 2);
    const size_t hstep = (size_t)HALF * K * 2;
    const size_t tstep = 2 * hstep;
    const unsigned ldsw = (unsigned)wid * 1024u;
    const int aoff = lds_byte(wr * 64 + fr, fq * 8), boff = lds_byte(wc * 32 + fr, fq * 8);
#define PG8_SA(b, h) (((b) * 2 + (h)) * HTB)
#define PG8_SB(b, h) ((4 + (b) * 2 + (h)) * HTB)
#define PG8_STAGE(bufoff, gbase, voff) do { _Pragma("unroll") for (int _i = 0; _i < 2; ++_i) \
        __builtin_amdgcn_global_load_lds((const unsigned*)((const char*)(gbase) + (voff)[_i]), (PG8_LAS unsigned*)(lds + (bufoff) + ldsw + _i * 8192), 16, 0, 0); } while (0)
#define PG8_LDA(dst, b, h) do { _Pragma("unroll") for (int m = 0; m < 4; ++m) _Pragma("unroll") for (int k = 0; k < 2; ++k) dst[m][k] = *(const PG8_LAS bf16x8*)(lds + PG8_SA(b, h) + aoff + m * 2048 + k * 1024); } while (0)
#define PG8_LDB(dst, b, h) do { _Pragma("unroll") for (int n = 0; n < 2; ++n) _Pragma("unroll") for (int k = 0; k < 2; ++k) dst[n][k] = *(const PG8_LAS bf16x8*)(lds + PG8_SB(b, h) + boff + n * 2048 + k * 1024); } while (0)
#define PG8_MMA(ai, bj, At, Bt) do { __builtin_amdgcn_s_setprio(1); _Pragma("unroll") for (int m = 0; m < 4; ++m) _Pragma("unroll") for (int n = 0; n < 2; ++n) _Pragma("unroll") for (int k = 0; k < 2; ++k) \
        acc[ai][bj][m][n] = __builtin_amdgcn_mfma_f32_16x16x32_bf16(Bt[n][k], At[m][k], acc[ai][bj][m][n], 0, 0, 0); __builtin_amdgcn_s_setprio(0); } while (0)
#define PG8_WAIT_V(n) asm volatile("s_waitcnt vmcnt(" #n ")" ::: "memory")
#define PG8_WAIT_L(n) asm volatile("s_waitcnt lgkmcnt(" #n ")" ::: "memory")
#define PG8_BAR __builtin_amdgcn_s_barrier()
#define PG8_SCHED __builtin_amdgcn_sched_barrier(0)
    Unit cur, nxt; int ui = 0;
    if (!S.next(0, cur)) return;
    f32x4 acc[2][2][4][2];
#pragma unroll
    for (int a = 0; a < 2; ++a)
#pragma unroll
        for (int b = 0; b < 2; ++b)
#pragma unroll
            for (int m = 0; m < 4; ++m)
#pragma unroll
                for (int n = 0; n < 2; ++n) acc[a][b][m][n] = (f32x4){0.f, 0.f, 0.f, 0.f};
    bf16x8 At[4][2], B0[2][2], B1[2][2];
    const char* cA = (const char*)g.A + (size_t)cur.pm * tstep; const char* cB = (const char*)g.Bt + (size_t)cur.pn * tstep;
    S.a_ready(cur);
    if constexpr (SP2) {
        PG8_STAGE(PG8_SB(0, 0), cB, voffB); PG8_STAGE(PG8_SB(0, 1), cB + hstep, voffB); PG8_STAGE(PG8_SA(0, 0), cA, voffA); PG8_STAGE(PG8_SA(0, 1), cA + hstep, voffA);
        if (wr == 1) PG8_BAR;
        PG8_WAIT_V(2); PG8_BAR;
        PG8_STAGE(PG8_SB(1, 0), cB + kstep, voffB); PG8_STAGE(PG8_SA(1, 0), cA + kstep, voffA); PG8_STAGE(PG8_SB(1, 1), cB + hstep + kstep, voffB);
        PG8_WAIT_V(6); PG8_BAR;
    } else {
        PG8_STAGE(PG8_SB(0, 0), cB, voffB); PG8_STAGE(PG8_SA(0, 0), cA, voffA); PG8_STAGE(PG8_SB(0, 1), cB + hstep, voffB); PG8_STAGE(PG8_SA(0, 1), cA + hstep, voffA);
        if (wr == 1) PG8_BAR;
        PG8_WAIT_V(4); PG8_BAR;
        PG8_STAGE(PG8_SB(1, 0), cB + kstep, voffB); PG8_STAGE(PG8_SA(1, 0), cA + kstep, voffA); PG8_STAGE(PG8_SB(1, 1), cB + hstep + kstep, voffB);
        PG8_WAIT_V(6); PG8_BAR;
    }
    for (;;) {
        const bool has_next = S.next(ui + 1, nxt);
        const char* nA = has_next ? (const char*)g.A + (size_t)nxt.pm * tstep : cA; const char* nB = has_next ? (const char*)g.Bt + (size_t)nxt.pn * tstep : cB;
        for (int t = 0; t < nt; t += 2) {
            const bool last = (t == nt - 2);
            const char* a1 = cA + (size_t)(t + 1) * kstep;
            const char* a2 = last ? nA : cA + (size_t)(t + 2) * kstep; const char* b2 = last ? nB : cB + (size_t)(t + 2) * kstep;
            const char* a3 = a2 + kstep; const char* b3 = b2 + kstep;
            if (last && has_next) S.a_ready(nxt);
            if constexpr (SP2) {
            PG8_LDB(B0, 0, 0); PG8_LDB(B1, 0, 1); PG8_SCHED; PG8_LDA(At, 0, 0); PG8_STAGE(PG8_SA(1, 1), a1 + hstep, voffA);
            PG8_WAIT_V(8); PG8_WAIT_L(0); PG8_BAR; PG8_MMA(0, 0, At, B0); PG8_MMA(0, 1, At, B1); PG8_BAR; PG8_SCHED;
            PG8_LDA(At, 0, 1); PG8_STAGE(PG8_SB(0, 0), b2, voffB); PG8_STAGE(PG8_SB(0, 1), b2 + hstep, voffB); PG8_STAGE(PG8_SA(0, 0), a2, voffA);
            PG8_WAIT_V(8); PG8_WAIT_L(0); PG8_BAR; PG8_MMA(1, 0, At, B0); PG8_MMA(1, 1, At, B1); PG8_BAR; PG8_SCHED;
            PG8_LDB(B0, 1, 0); PG8_LDB(B1, 1, 1); PG8_SCHED; PG8_LDA(At, 1, 0); PG8_STAGE(PG8_SA(0, 1), a2 + hstep, voffA);
            PG8_WAIT_V(8); PG8_WAIT_L(0); PG8_BAR; PG8_MMA(0, 0, At, B0); PG8_MMA(0, 1, At, B1); PG8_BAR; PG8_SCHED;
            PG8_LDA(At, 1, 1); PG8_STAGE(PG8_SB(1, 0), b3, voffB); PG8_STAGE(PG8_SB(1, 1), b3 + hstep, voffB); PG8_STAGE(PG8_SA(1, 0), a3, voffA);
            PG8_WAIT_V(8); PG8_WAIT_L(0); PG8_BAR; PG8_MMA(1, 0, At, B0); PG8_MMA(1, 1, At, B1); PG8_BAR; PG8_SCHED;
            } else {
            PG8_LDB(B0, 0, 0); PG8_SCHED; PG8_LDA(At, 0, 0); PG8_STAGE(PG8_SA(1, 1), a1 + hstep, voffA);
            PG8_WAIT_L(8); PG8_BAR; PG8_WAIT_L(0); PG8_MMA(0, 0, At, B0); PG8_BAR; PG8_SCHED;
            PG8_LDB(B1, 0, 1); PG8_STAGE(PG8_SB(0, 0), b2, voffB);
            PG8_BAR; PG8_WAIT_L(0); PG8_MMA(0, 1, At, B1); PG8_BAR;
            PG8_LDA(At, 0, 1); PG8_STAGE(PG8_SA(0, 0), a2, voffA);
            PG8_BAR; PG8_WAIT_L(0); PG8_MMA(1, 0, At, B0); PG8_BAR; PG8_SCHED;
            PG8_STAGE(PG8_SB(0, 1), b2 + hstep, voffB);
            PG8_WAIT_V(6); PG8_BAR; PG8_MMA(1, 1, At, B1); PG8_BAR;
            PG8_LDB(B0, 1, 0); PG8_SCHED; PG8_LDA(At, 1, 0); PG8_STAGE(PG8_SA(0, 1), a2 + hstep, voffA);
            PG8_WAIT_L(8); PG8_BAR; PG8_WAIT_L(0); PG8_MMA(0, 0, At, B0); PG8_BAR; PG8_SCHED;
            PG8_LDB(B1, 1, 1); PG8_STAGE(PG8_SB(1, 0), b3, voffB);
            PG8_BAR; PG8_WAIT_L(0); PG8_MMA(0, 1, At, B1); PG8_BAR;
            PG8_LDA(At, 1, 1); PG8_STAGE(PG8_SA(1, 0), a3, voffA);
            PG8_BAR; PG8_WAIT_L(0); PG8_MMA(1, 0, At, B0); PG8_BAR; PG8_SCHED;
            PG8_STAGE(PG8_SB(1, 1), b3 + hstep, voffB);
            PG8_WAIT_V(6); PG8_BAR; PG8_MMA(1, 1, At, B1); PG8_BAR;
            }
        }
        if constexpr (ALIGN_EPI) { if (wr == 0) PG8_BAR; }
        if constexpr (!Epi::AFTER_DRAIN) { E(acc, cur, wr, wc, fr, fq); S.done(cur); }
        if (!has_next) break;
#pragma unroll
        for (int a = 0; a < 2; ++a)
#pragma unroll
            for (int b = 0; b < 2; ++b)
#pragma unroll
                for (int m = 0; m < 4; ++m)
#pragma unroll
                    for (int n = 0; n < 2; ++n) acc[a][b][m][n] = (f32x4){0.f, 0.f, 0.f, 0.f};
        cur = nxt; cA = nA; cB = nB; ++ui;
        if constexpr (ALIGN_EPI) { if (wr == 1) PG8_BAR; }
    }
    PG8_WAIT_V(0);
    if constexpr (!ALIGN_EPI) { if (wr == 0) PG8_BAR; }
    PG8_BAR;
    if constexpr (Epi::AFTER_DRAIN) { E.fused(acc, cur, wr, wc, fr, fq, lds, wid, lane); S.done(cur); }
#undef PG8_SA
#undef PG8_SB
#undef PG8_STAGE
#undef PG8_LDA
#undef PG8_LDB
#undef PG8_MMA
#undef PG8_WAIT_V
#undef PG8_WAIT_L
#undef PG8_BAR
#undef PG8_SCHED
}
}
namespace pg8 {
template <class Epi, class Sched, bool ALIGN_EPI = false, bool SP2 = false>
__device__ __forceinline__ void gemm_phase_cat(PG8_LAS unsigned char* lds, const Gemm g, const Sched& S, const Epi& E, const int tid_in, const int lda, const int KH, const long dA) {
    const int tid = tid_in, wid = __builtin_amdgcn_readfirstlane(tid >> 6), lane = tid & 63, wr = wid >> 2, wc = wid & 3, fr = lane & 15, fq = lane >> 4;
    const int K = g.K, nt = K / BK;
    unsigned voffA[2], voffB[2];
#pragma unroll
    for (int i = 0; i < 2; ++i) { int R, C; stage_rc(tid * 16 + i * 8192, R, C); const int Rb = Epi::PERM ? ((R & ~31) + perm32(R & 31)) : R;
        voffA[i] = (unsigned)(R * lda + C) * 2u; voffB[i] = (unsigned)(Rb * K + C) * 2u; }
    const size_t kstep = (size_t)(BK * 2);
    const size_t hstep = (size_t)HALF * K * 2, tstep = 2 * hstep;
    const size_t hstepA = (size_t)HALF * lda * 2, tstepA = 2 * hstepA;
    const size_t dsplit = (size_t)dA - (size_t)KH * kstep;
#define PG8_APT(base, kt) ((base) + (size_t)(kt) * kstep + ((kt) >= KH ? dsplit : (size_t)0))
    const unsigned ldsw = (unsigned)wid * 1024u;
    const int aoff = lds_byte(wr * 64 + fr, fq * 8), boff = lds_byte(wc * 32 + fr, fq * 8);
#define PG8_SA(b, h) (((b) * 2 + (h)) * HTB)
#define PG8_SB(b, h) ((4 + (b) * 2 + (h)) * HTB)
#define PG8_STAGE(bufoff, gbase, voff) do { _Pragma("unroll") for (int _i = 0; _i < 2; ++_i) \
        __builtin_amdgcn_global_load_lds((const unsigned*)((const char*)(gbase) + (voff)[_i]), (PG8_LAS unsigned*)(lds + (bufoff) + ldsw + _i * 8192), 16, 0, 0); } while (0)
#define PG8_LDA(dst, b, h) do { _Pragma("unroll") for (int m = 0; m < 4; ++m) _Pragma("unroll") for (int k = 0; k < 2; ++k) dst[m][k] = *(const PG8_LAS bf16x8*)(lds + PG8_SA(b, h) + aoff + m * 2048 + k * 1024); } while (0)
#define PG8_LDB(dst, b, h) do { _Pragma("unroll") for (int n = 0; n < 2; ++n) _Pragma("unroll") for (int k = 0; k < 2; ++k) dst[n][k] = *(const PG8_LAS bf16x8*)(lds + PG8_SB(b, h) + boff + n * 2048 + k * 1024); } while (0)
#define PG8_MMA(ai, bj, At, Bt) do { __builtin_amdgcn_s_setprio(1); _Pragma("unroll") for (int m = 0; m < 4; ++m) _Pragma("unroll") for (int n = 0; n < 2; ++n) _Pragma("unroll") for (int k = 0; k < 2; ++k) \
        acc[ai][bj][m][n] = __builtin_amdgcn_mfma_f32_16x16x32_bf16(Bt[n][k], At[m][k], acc[ai][bj][m][n], 0, 0, 0); __builtin_amdgcn_s_setprio(0); } while (0)
#define PG8_WAIT_V(n) asm volatile("s_waitcnt vmcnt(" #n ")" ::: "memory")
#define PG8_WAIT_L(n) asm volatile("s_waitcnt lgkmcnt(" #n ")" ::: "memory")
#define PG8_BAR __builtin_amdgcn_s_barrier()
#define PG8_SCHED __builtin_amdgcn_sched_barrier(0)
    Unit cur, nxt; int ui = 0;
    if (!S.next(0, cur)) return;
    f32x4 acc[2][2][4][2];
#pragma unroll
    for (int a = 0; a < 2; ++a)
#pragma unroll
        for (int b = 0; b < 2; ++b)
#pragma unroll
            for (int m = 0; m < 4; ++m)
#pragma unroll
                for (int n = 0; n < 2; ++n) acc[a][b][m][n] = (f32x4){0.f, 0.f, 0.f, 0.f};
    bf16x8 At[4][2], B0[2][2], B1[2][2];
    const char* cA = (const char*)g.A + (size_t)cur.pm * tstepA; const char* cB = (const char*)g.Bt + (size_t)cur.pn * tstep;
    S.a_ready(cur);
    if constexpr (SP2) {
        PG8_STAGE(PG8_SB(0, 0), cB, voffB); PG8_STAGE(PG8_SB(0, 1), cB + hstep, voffB); PG8_STAGE(PG8_SA(0, 0), cA, voffA); PG8_STAGE(PG8_SA(0, 1), cA + hstepA, voffA);
        if (wr == 1) PG8_BAR;
        PG8_WAIT_V(2); PG8_BAR;
        PG8_STAGE(PG8_SB(1, 0), cB + kstep, voffB); PG8_STAGE(PG8_SA(1, 0), cA + kstep, voffA); PG8_STAGE(PG8_SB(1, 1), cB + hstep + kstep, voffB);
        PG8_WAIT_V(6); PG8_BAR;
    } else {
        PG8_STAGE(PG8_SB(0, 0), cB, voffB); PG8_STAGE(PG8_SA(0, 0), cA, voffA); PG8_STAGE(PG8_SB(0, 1), cB + hstep, voffB); PG8_STAGE(PG8_SA(0, 1), cA + hstepA, voffA);
        if (wr == 1) PG8_BAR;
        PG8_WAIT_V(4); PG8_BAR;
        PG8_STAGE(PG8_SB(1, 0), cB + kstep, voffB); PG8_STAGE(PG8_SA(1, 0), cA + kstep, voffA); PG8_STAGE(PG8_SB(1, 1), cB + hstep + kstep, voffB);
        PG8_WAIT_V(6); PG8_BAR;
    }
    for (;;) {
        const bool has_next = S.next(ui + 1, nxt);
        const char* nA = has_next ? (const char*)g.A + (size_t)nxt.pm * tstepA : cA; const char* nB = has_next ? (const char*)g.Bt + (size_t)nxt.pn * tstep : cB;
        for (int t = 0; t < nt; t += 2) {
            const bool last = (t == nt - 2);
            if (t == KH) E.mid(acc, cur, wr, wc);
            const char* a1 = PG8_APT(cA, t + 1);
            const char* a2 = last ? nA : PG8_APT(cA, t + 2); const char* b2 = last ? nB : cB + (size_t)(t + 2) * kstep;
            const char* a3 = last ? nA + kstep : PG8_APT(cA, t + 3); const char* b3 = b2 + kstep;
            if (last && has_next) S.a_ready(nxt);
            if constexpr (SP2) {
            PG8_LDB(B0, 0, 0); PG8_LDB(B1, 0, 1); PG8_SCHED; PG8_LDA(At, 0, 0); PG8_STAGE(PG8_SA(1, 1), a1 + hstepA, voffA);
            PG8_WAIT_V(8); PG8_WAIT_L(0); PG8_BAR; PG8_MMA(0, 0, At, B0); PG8_MMA(0, 1, At, B1); PG8_BAR; PG8_SCHED;
            PG8_LDA(At, 0, 1); PG8_STAGE(PG8_SB(0, 0), b2, voffB); PG8_STAGE(PG8_SB(0, 1), b2 + hstep, voffB); PG8_STAGE(PG8_SA(0, 0), a2, voffA);
            PG8_WAIT_V(8); PG8_WAIT_L(0); PG8_BAR; PG8_MMA(1, 0, At, B0); PG8_MMA(1, 1, At, B1); PG8_BAR; PG8_SCHED;
            PG8_LDB(B0, 1, 0); PG8_LDB(B1, 1, 1); PG8_SCHED; PG8_LDA(At, 1, 0); PG8_STAGE(PG8_SA(0, 1), a2 + hstepA, voffA);
            PG8_WAIT_V(8); PG8_WAIT_L(0); PG8_BAR; PG8_MMA(0, 0, At, B0); PG8_MMA(0, 1, At, B1); PG8_BAR; PG8_SCHED;
            PG8_LDA(At, 1, 1); PG8_STAGE(PG8_SB(1, 0), b3, voffB); PG8_STAGE(PG8_SB(1, 1), b3 + hstep, voffB); PG8_STAGE(PG8_SA(1, 0), a3, voffA);
            PG8_WAIT_V(8); PG8_WAIT_L(0); PG8_BAR; PG8_MMA(1, 0, At, B0); PG8_MMA(1, 1, At, B1); PG8_BAR; PG8_SCHED;
            } else {
            PG8_LDB(B0, 0, 0); PG8_SCHED; PG8_LDA(At, 0, 0); PG8_STAGE(PG8_SA(1, 1), a1 + hstepA, voffA);
            PG8_WAIT_L(8); PG8_BAR; PG8_WAIT_L(0); PG8_MMA(0, 0, At, B0); PG8_BAR; PG8_SCHED;
            PG8_LDB(B1, 0, 1); PG8_STAGE(PG8_SB(0, 0), b2, voffB);
            PG8_BAR; PG8_WAIT_L(0); PG8_MMA(0, 1, At, B1); PG8_BAR;
            PG8_LDA(At, 0, 1); PG8_STAGE(PG8_SA(0, 0), a2, voffA);
            PG8_BAR; PG8_WAIT_L(0); PG8_MMA(1, 0, At, B0); PG8_BAR; PG8_SCHED;
            PG8_STAGE(PG8_SB(0, 1), b2 + hstep, voffB);
            PG8_WAIT_V(6); PG8_BAR; PG8_MMA(1, 1, At, B1); PG8_BAR;
            PG8_LDB(B0, 1, 0); PG8_SCHED; PG8_LDA(At, 1, 0); PG8_STAGE(PG8_SA(0, 1), a2 + hstepA, voffA);
            PG8_WAIT_L(8); PG8_BAR; PG8_WAIT_L(0); PG8_MMA(0, 0, At, B0); PG8_BAR; PG8_SCHED;
            PG8_LDB(B1, 1, 1); PG8_STAGE(PG8_SB(1, 0), b3, voffB);
            PG8_BAR; PG8_WAIT_L(0); PG8_MMA(0, 1, At, B1); PG8_BAR;
            PG8_LDA(At, 1, 1); PG8_STAGE(PG8_SA(1, 0), a3, voffA);
            PG8_BAR; PG8_WAIT_L(0); PG8_MMA(1, 0, At, B0); PG8_BAR; PG8_SCHED;
            PG8_STAGE(PG8_SB(1, 1), b3 + hstep, voffB);
            PG8_WAIT_V(6); PG8_BAR; PG8_MMA(1, 1, At, B1); PG8_BAR;
            }
        }
        if constexpr (ALIGN_EPI) { if (wr == 0) PG8_BAR; }
        if constexpr (!Epi::AFTER_DRAIN) { E(acc, cur, wr, wc, fr, fq); S.done(cur); }
        if (!has_next) break;
#pragma unroll
        for (int a = 0; a < 2; ++a)
#pragma unroll
            for (int b = 0; b < 2; ++b)
#pragma unroll
                for (int m = 0; m < 4; ++m)
#pragma unroll
                    for (int n = 0; n < 2; ++n) acc[a][b][m][n] = (f32x4){0.f, 0.f, 0.f, 0.f};
        cur = nxt; cA = nA; cB = nB; ++ui;
        if constexpr (ALIGN_EPI) { if (wr == 1) PG8_BAR; }
    }
    PG8_WAIT_V(0);
    if constexpr (!ALIGN_EPI) { if (wr == 0) PG8_BAR; }
    PG8_BAR;
    if constexpr (Epi::AFTER_DRAIN) { E.fused(acc, cur, wr, wc, fr, fq, lds, wid, lane); S.done(cur); }
#undef PG8_APT
#undef PG8_SA
#undef PG8_SB
#undef PG8_STAGE
#undef PG8_LDA
#undef PG8_LDB
#undef PG8_MMA
#undef PG8_WAIT_V
#undef PG8_WAIT_L
#undef PG8_BAR
#undef PG8_SCHED
}
}

#define GAS __attribute__((address_space(1)))
#define LAS __attribute__((address_space(3)))
typedef unsigned short bf16;
typedef unsigned u32x4 __attribute__((ext_vector_type(4)));
typedef unsigned u32x2 __attribute__((ext_vector_type(2)));
typedef float f32x4 __attribute__((ext_vector_type(4)));
typedef float f32x2 __attribute__((ext_vector_type(2)));
using pg8::cvt_pk_bf16;

constexpr int NWAVES = 8, NTHR = 512;
constexpr int T = 32768, SEQ = 8192, NB = 4, DM = 1024;
constexpr int DIN = 5792, N1 = 5888;
constexpr float EPS = 1e-6f, LOG2E = 1.4426950408889634f;
constexpr float QA_SCALE = 0.125f * LOG2E;
constexpr float QB_SCALE = 0.10206207261596575f * LOG2E;

constexpr size_t MiB = 1u << 20;
constexpr size_t WS_CTL = 0, WS_BT = 64 * 1024;
constexpr size_t WS_SSCQ = 1 * MiB, WS_SSCKV = 1 * MiB + 512 * 1024;
constexpr size_t WS_KR = 2 * MiB, WS_ROPE = 4 * MiB;
constexpr size_t WS_BT1 = 8 * MiB, WS_BT3 = 20 * MiB, WS_WOUT = 24 * MiB, WS_WG = 26 * MiB, WS_BT2 = 28 * MiB, WS_WPP = 30 * MiB;
constexpr size_t WS_XN = 32 * MiB;
constexpr size_t WS_QA = 96 * MiB;
constexpr size_t WS_KVA = 160 * MiB;
constexpr size_t WS_CQKV = 176 * MiB;
constexpr size_t WS_SGA = 208 * MiB, WS_SGB = 272 * MiB;
constexpr size_t WS_QBN = 336 * MiB;
constexpr size_t WS_QBR = 400 * MiB;
constexpr size_t WS_KN = 432 * MiB;
constexpr size_t WS_SSQ = 200 * MiB;
constexpr size_t WS_RS = 204 * MiB;
constexpr size_t WS_PBX = 496 * MiB;
constexpr size_t WS_END = 512 * MiB;
constexpr size_t WS_VB = WS_XN, WS_X1B = WS_XN, WS_ER = WS_QA, WS_PB = WS_PBX, WS_SSX1 = WS_CQKV, WS_SSE = WS_CQKV + 2 * MiB, WS_MG = WS_KN, WS_X1F = WS_SGA  ;

constexpr int RING_BYTES = 131072, LDS_BYTES = 147456;

#ifndef NT_ST8
#define NT_ST8 0
#endif
#ifndef NT_SG
#define NT_SG 0
#endif
#ifndef NT_X1ER
#define NT_X1ER 0
#endif
#ifndef NT_X1B
#define NT_X1B 0
#endif
#ifndef NT_PLD
#define NT_PLD 1
#endif
#ifndef NT_PST
#define NT_PST 0
#endif
#ifndef NT_ATTZ
#define NT_ATTZ 1
#endif
#ifndef NT_ATTO
#define NT_ATTO 1
#endif
#ifndef NT_WLD
#define NT_WLD 1
#endif
template <bool NT, class V> __device__ __forceinline__ V ld_hint(const V* p) { if constexpr (NT) return __builtin_nontemporal_load(p); else return *p; }
template <bool NT, class V> __device__ __forceinline__ void st_hint(V v, V* p) { if constexpr (NT) __builtin_nontemporal_store(v, p); else *p = v; }
#define LDS_WAIT() asm volatile("s_waitcnt lgkmcnt(0)" ::: "memory")
__device__ __forceinline__ unsigned f2bf(float f) { unsigned u = __builtin_bit_cast(unsigned, f); return (u + 0x7fffu + ((u >> 16) & 1u)) >> 16; }
__device__ __forceinline__ unsigned pk2(float lo, float hi) { return f2bf(lo) | (f2bf(hi) << 16); }
__device__ __forceinline__ float bf2f(unsigned short b) { return __builtin_bit_cast(float, (unsigned)b << 16); }
__device__ __forceinline__ float bflo(unsigned w) { return __builtin_bit_cast(float, w << 16); }
__device__ __forceinline__ float bfhi(unsigned w) { return __builtin_bit_cast(float, w & 0xffff0000u); }
__device__ __forceinline__ float sigmoidf_(float v) { return __builtin_amdgcn_rcpf(1.0f + __builtin_amdgcn_exp2f(-v * LOG2E)); }
__device__ __forceinline__ void st8(bf16* p, f32x4 a, f32x4 b) { u32x4 w; w.x = cvt_pk_bf16(a[0], a[1]); w.y = cvt_pk_bf16(a[2], a[3]); w.z = cvt_pk_bf16(b[0], b[1]); w.w = cvt_pk_bf16(b[2], b[3]);
#if defined(ST8_SC1) && ST8_SC1
    asm volatile("global_store_dwordx4 %0, %1, off sc1\n\ts_nop 1" :: "v"(p), "v"(w) : "memory");
#else
    st_hint<NT_ST8 != 0>(w, (u32x4*)p);
#endif
}
__device__ __forceinline__ float sumsq4(f32x4 a) { return (a[0] * a[0] + a[1] * a[1]) + (a[2] * a[2] + a[3] * a[3]); }
__device__ __forceinline__ float red_fq(float s) { s += __shfl_xor(s, 16); s += __shfl_xor(s, 32); return s; }

__device__ __forceinline__ int lane_id() { int l; asm volatile("v_mbcnt_lo_u32_b32 %0, -1, 0\n\tv_mbcnt_hi_u32_b32 %0, -1, %0" : "=v"(l)); return l; }

struct Args { const float* in[24]; float* out; unsigned char* ws; int ph_lo, ph_hi; };

struct Frame {
    LAS unsigned char* lds;
    int tid, lane, wave, vcu, G;
#ifdef PROBE
    unsigned long long* pts;
#endif
};
#ifdef PROBE
#define FSTAMP(F, k) do { if (blockIdx.x == 0 && (F).wave == 0 && lane_id() == 0) (F).pts[k] = __builtin_amdgcn_s_memrealtime(); } while (0)
#else
#define FSTAMP(F, k) do { } while (0)
#endif

struct Order2 {
    pg8::StaticOrder so;
    __device__ bool next(int i, pg8::Unit& u) const { if (!so.next(i, u)) return false; if (u.pn >= 6) u.pm += 128; return true; }
    __device__ __forceinline__ void a_ready(const pg8::Unit&) const {}
    __device__ __forceinline__ void done(const pg8::Unit&) const {}
};
typedef const pg8::f32x4 (&AccRef)[2][2][4][2];


__device__ __forceinline__ float acc_ss(AccRef acc, int ai, int m) { return (sumsq4(acc[ai][0][m][0]) + sumsq4(acc[ai][0][m][1])) + (sumsq4(acc[ai][1][m][0]) + sumsq4(acc[ai][1][m][1])); }
__device__ __forceinline__ void epi_raw(AccRef acc, bf16* base, int ld, int row0, int lc0) {
#pragma unroll
    for (int ai = 0; ai < 2; ++ai)
#pragma unroll
        for (int m = 0; m < 4; ++m) { bf16* dst = base + (size_t)(row0 + ai * 128 + m * 16) * ld + lc0;
#pragma unroll
            for (int bj = 0; bj < 2; ++bj) st8(dst + 32 * bj, acc[ai][bj][m][0], acc[ai][bj][m][1]); }
}
__device__ __forceinline__ void epi_raw_ss(AccRef acc, bf16* base, int ld, int row0, int lc0, float* ssp, int nss, int idx, int fq) {
#pragma unroll
    for (int ai = 0; ai < 2; ++ai)
#pragma unroll
        for (int m = 0; m < 4; ++m) { const int row = row0 + ai * 128 + m * 16; const float ss = red_fq(acc_ss(acc, ai, m));
            if (fq == 0) ssp[(size_t)row * nss + idx] = ss;
            bf16* dst = base + (size_t)row * ld + lc0;
#pragma unroll
            for (int bj = 0; bj < 2; ++bj) st8(dst + 32 * bj, acc[ai][bj][m][0], acc[ai][bj][m][1]); }
}
__device__ __forceinline__ void epi_headnorm(AccRef acc, bf16* base, int ld, int row0, int lc0, const float* g, float sc, int fq) {
    f32x4 gv[2][2];
#pragma unroll
    for (int bj = 0; bj < 2; ++bj)
#pragma unroll
        for (int n = 0; n < 2; ++n) gv[bj][n] = *(const f32x4*)(g + 32 * bj + 8 * fq + 4 * n) * sc;
#pragma unroll
    for (int ai = 0; ai < 2; ++ai)
#pragma unroll
        for (int m = 0; m < 4; ++m) { const int row = row0 + ai * 128 + m * 16; const float r = rsqrtf(red_fq(acc_ss(acc, ai, m)) * (1.0f / 64.0f) + EPS);
            bf16* dst = base + (size_t)row * ld + lc0;
#pragma unroll
            for (int bj = 0; bj < 2; ++bj) st8(dst + 32 * bj, acc[ai][bj][m][0] * gv[bj][0] * r, acc[ai][bj][m][1] * gv[bj][1] * r); }
}
template <bool SILU> __device__ __forceinline__ void epi_act(AccRef acc, bf16* base, int row0, int lc0) {
#pragma unroll
    for (int ai = 0; ai < 2; ++ai)
#pragma unroll
        for (int m = 0; m < 4; ++m) { bf16* dst = base + (size_t)(row0 + ai * 128 + m * 16) * 1024 + lc0;
#pragma unroll
            for (int bj = 0; bj < 2; ++bj) { f32x4 v0 = acc[ai][bj][m][0], v1 = acc[ai][bj][m][1], o0, o1;
#pragma unroll
                for (int e = 0; e < 4; ++e) { const float s0 = sigmoidf_(v0[e]), s1 = sigmoidf_(v1[e]); o0[e] = SILU ? v0[e] * s0 : s0; o1[e] = SILU ? v1[e] * s1 : s1; }
                st8(dst + 32 * bj, o0, o1); } }
}

struct Epi1 {
    static constexpr bool PERM = true, AFTER_DRAIN = false;
    float* out; unsigned char* ws; const float *gq, *gk, *gkr; int mode;
    __device__ __forceinline__ void operator()(AccRef acc, const pg8::Unit& u, int wr, int wc, int, int) const {
        int ln_ = lane_id(); asm volatile("" : "+v"(ln_)); const int fr = ln_ & 15, fq = ln_ >> 4;
        const int row0 = u.pm * 256 + wr * 64 + fr, pn = u.pn, lc0 = 64 * wc + 8 * fq;
#ifdef PROBE
        if (mode == 1) { pg8::f32x4 t = acc[0][0][0][0];
#pragma unroll
            for (int i_ = 1; i_ < 32; ++i_) t += acc[i_ >> 4][(i_ >> 3) & 1][(i_ >> 1) & 3][i_ & 1];
            asm volatile("" :: "v"(t)); return; }
        if (mode == 2) { epi_raw(acc, (bf16*)(ws + WS_SGA) + (pn & 3) * 256, 1024, row0, lc0); return; }
#endif
        if (pn < 4) {
            epi_headnorm(acc, (bf16*)(ws + WS_QA) + pn * 256, 1024, row0, lc0, gq, QA_SCALE, fq);
        } else if (pn == 4) {
            if (wc < 2) epi_headnorm(acc, (bf16*)(ws + WS_KVA), 256, row0, lc0, gk, 1.0f, fq);
            else epi_raw(acc, (bf16*)(ws + WS_KVA), 256, row0, lc0);
        } else if (pn <= 8) {
            epi_act<true>(acc, (bf16*)out + (pn - 5) * 256, row0, lc0);
        } else if (pn == 9) {
            epi_raw_ss(acc, (bf16*)(ws + WS_CQKV), 256, row0, lc0, (float*)(ws + WS_SSCQ), 4, wc, fq);
        } else if (pn == 10) {
            if (wc < 2) epi_raw_ss(acc, (bf16*)(ws + WS_CQKV) + (size_t)T * 256, 128, row0, lc0, (float*)(ws + WS_SSCKV), 2, wc, fq);
            else if (wc == 2) {
                f32x4 gv[2];
#pragma unroll
                for (int n = 0; n < 2; ++n) gv[n] = *(const f32x4*)(gkr + 8 * fq + 4 * n);
                const float* rope = (const float*)(ws + WS_ROPE); bf16* KR = (bf16*)(ws + WS_KR);
#pragma unroll
                for (int ai = 0; ai < 2; ++ai)
#pragma unroll
                    for (int m = 0; m < 4; ++m) {
                        const int row = row0 + ai * 128 + m * 16;
                        const float ss = red_fq(sumsq4(acc[ai][0][m][0]) + sumsq4(acc[ai][0][m][1]));
                        const float r = rsqrtf(ss * (1.0f / 32.0f) + EPS);
                        const f32x4 a0 = acc[ai][0][m][0] * gv[0] * r, a1 = acc[ai][0][m][1] * gv[1] * r;
                        f32x4 p0, p1;
#pragma unroll
                        for (int e = 0; e < 4; ++e) { p0[e] = __shfl_xor(a0[e], 32); p1[e] = __shfl_xor(a1[e], 32); }
                        const float* rp = rope + (size_t)row * 32 + 8 * (fq & 1);
                        const f32x4 c0 = *(const f32x4*)(rp), c1 = *(const f32x4*)(rp + 4), s0 = *(const f32x4*)(rp + 16), s1 = *(const f32x4*)(rp + 20);
                        const float sg = fq < 2 ? -1.0f : 1.0f;
                        st8(KR + (size_t)row * 32 + 8 * fq, a0 * c0 + p0 * s0 * sg, a1 * c1 + p1 * s1 * sg);
                        asm volatile("" ::: "memory");
                    }
            }
        } else if (pn <= 14) {
            epi_act<true>(acc, (bf16*)out + (size_t)T * 1024 + (pn - 11) * 256, row0, lc0);
        } else {
            bf16* RA = (bf16*)(ws + WS_SGA); bf16* SB = (bf16*)(ws + WS_SGB); const int c0 = 128 * (pn - 15) + 32 * wc + 8 * fq;
#pragma unroll
            for (int ai = 0; ai < 2; ++ai)
#pragma unroll
                for (int m = 0; m < 4; ++m) { const size_t off = (size_t)(row0 + ai * 128 + m * 16) * 1024 + c0;
                    f32x4 r0, r1, b0, b1;
#pragma unroll
                    for (int e = 0; e < 4; ++e) {
                        const float ea0 = __builtin_amdgcn_exp2f(-acc[ai][0][m][0][e] * LOG2E), ea1 = __builtin_amdgcn_exp2f(-acc[ai][0][m][1][e] * LOG2E);
                        const float eb0 = __builtin_amdgcn_exp2f(-acc[ai][1][m][0][e] * LOG2E), eb1 = __builtin_amdgcn_exp2f(-acc[ai][1][m][1][e] * LOG2E);
                        b0[e] = fmaxf(__builtin_amdgcn_rcpf(1.0f + eb0), 1e-30f); b1[e] = fmaxf(__builtin_amdgcn_rcpf(1.0f + eb1), 1e-30f);
                        r0[e] = __builtin_amdgcn_rcpf((1.0f + ea0) * b0[e]); r1[e] = __builtin_amdgcn_rcpf((1.0f + ea1) * b1[e]); }
                    st8(RA + off, r0, r1); st8(SB + off, b0, b1); }
        }
    }
};
static_assert(WS_SGB == WS_SGA + (size_t)T * 1024 * 2, "SGA and SGB adjacent");

struct Epi2 {
    static constexpr bool PERM = true, AFTER_DRAIN = false;
    unsigned char* ws; const float* gkn; const float* gqn; int pn_off;
    __device__ __forceinline__ void operator()(AccRef acc, const pg8::Unit& u, int wr, int wc, int, int) const {
        int ln_ = lane_id(); asm volatile("" : "+v"(ln_)); const int fr = ln_ & 15, fq = ln_ >> 4;
        const int row0 = u.pm * 256 + wr * 64 + fr, pn = u.pn + pn_off, lc0 = 64 * wc + 8 * fq;
        if (pn < 4) epi_raw_ss(acc, (bf16*)(ws + WS_QBN) + pn * 256, 1024, row0, lc0, (float*)(ws + WS_SSQ), 32, 4 * pn + wc, fq);
        else if (pn < 6) {
            bf16* base = (bf16*)(ws + WS_QBR) + (pn - 4) * 256; float* SSQ = (float*)(ws + WS_SSQ); const float* rope = (const float*)(ws + WS_ROPE);
            f32x4 gr[2];
#pragma unroll
            for (int n = 0; n < 2; ++n) gr[n] = *(const f32x4*)(gqn + 64 + 8 * fq + 4 * n);
#pragma unroll
            for (int ai = 0; ai < 2; ++ai)
#pragma unroll
                for (int m = 0; m < 4; ++m) { const int row = row0 + ai * 128 + m * 16;
                    const float s0 = red_fq(sumsq4(acc[ai][0][m][0]) + sumsq4(acc[ai][0][m][1])), s1 = red_fq(sumsq4(acc[ai][1][m][0]) + sumsq4(acc[ai][1][m][1]));
                    if (fq == 0) *(f32x2*)(SSQ + (size_t)row * 32 + 16 + 8 * (pn - 4) + 2 * wc) = (f32x2){s0, s1};
                    const float* rp = rope + (size_t)row * 32 + 8 * (fq & 1);
                    const f32x4 c0 = *(const f32x4*)(rp), c1 = *(const f32x4*)(rp + 4), sn0 = *(const f32x4*)(rp + 16), sn1 = *(const f32x4*)(rp + 20);
                    const float sg = fq < 2 ? -1.0f : 1.0f;
                    bf16* dst = base + (size_t)row * 512 + lc0;
#pragma unroll
                    for (int bj = 0; bj < 2; ++bj) { const f32x4 a0 = acc[ai][bj][m][0] * gr[0], a1 = acc[ai][bj][m][1] * gr[1]; f32x4 p0, p1;
#pragma unroll
                        for (int e = 0; e < 4; ++e) { p0[e] = __shfl_xor(a0[e], 32); p1[e] = __shfl_xor(a1[e], 32); }
                        st8(dst + 32 * bj, a0 * c0 + p0 * sn0 * sg, a1 * c1 + p1 * sn1 * sg); }
                    asm volatile("" ::: "memory"); }
        }
        else {
            const float* SSCKV = (const float*)(ws + WS_SSCKV);
            float msl8[2][4];
#pragma unroll
            for (int ai = 0; ai < 2; ++ai)
#pragma unroll
                for (int m = 0; m < 4; ++m) { const f32x2 t = *(const f32x2*)(SSCKV + (size_t)(row0 + ai * 128 + m * 16) * 2); msl8[ai][m] = (t[0] + t[1]) * (1.0f / 128.0f) + EPS; }
            if (pn < 10) {
                bf16* base = (bf16*)(ws + WS_KN) + (pn - 6) * 256;
                f32x4 gv[2][2];
#pragma unroll
                for (int bj = 0; bj < 2; ++bj)
#pragma unroll
                    for (int n = 0; n < 2; ++n) gv[bj][n] = *(const f32x4*)(gkn + 32 * bj + 8 * fq + 4 * n) * *(const f32x4*)(gqn + 32 * bj + 8 * fq + 4 * n);
#pragma unroll
                for (int ai = 0; ai < 2; ++ai)
#pragma unroll
                    for (int m = 0; m < 4; ++m) { const int row = row0 + ai * 128 + m * 16;
                        const float msl = msl8[ai][m];
                        const float r = rsqrtf(red_fq(acc_ss(acc, ai, m)) * (1.0f / 64.0f) + EPS * msl);
                        bf16* dst = base + (size_t)row * 1024 + lc0;
#pragma unroll
                        for (int bj = 0; bj < 2; ++bj) st8(dst + 32 * bj, acc[ai][bj][m][0] * gv[bj][0] * r, acc[ai][bj][m][1] * gv[bj][1] * r);
                        asm volatile("" ::: "memory"); }
            } else {
                bf16* base = (bf16*)(ws + WS_VB) + (pn - 10) * 256;
#pragma unroll
                for (int ai = 0; ai < 2; ++ai)
#pragma unroll
                    for (int m = 0; m < 4; ++m) { const int row = row0 + ai * 128 + m * 16;
                        const float r = rsqrtf(msl8[ai][m]);
                        bf16* dst = base + (size_t)row * 1024 + lc0;
#pragma unroll
                        for (int bj = 0; bj < 2; ++bj) st8(dst + 32 * bj, acc[ai][bj][m][0] * r, acc[ai][bj][m][1] * r);
                        asm volatile("" ::: "memory"); }
            }
        }
    }
};

namespace mla {
using bf16x8 = __attribute__((ext_vector_type(8))) short;
using s16x4 = __attribute__((ext_vector_type(4))) short;
using f32x16 = __attribute__((ext_vector_type(16))) float;
constexpr int NW = 8, QBLK = 32, QB = 256, KVBLK = 64;
constexpr int KSLOT = 12288, VSLOT = 8192;
constexpr int LDS_K = 0, LDS_V = 3 * KSLOT, LDS_WS = LDS_V + 3 * VSLOT, LDS_OST = LDS_WS + NW * 256, LDS_TOTAL = LDS_OST + NW * 8192;
static_assert(LDS_TOTAL <= RING_BYTES, "MLA LDS map");
#define SBAR() __builtin_amdgcn_sched_barrier(0)
#define PIN(x) asm volatile("" : "+v"(x))
#define MFMA(a, b, c) __builtin_amdgcn_mfma_f32_32x32x16_bf16(a, b, c, 0, 0, 0)
#define WAIT_BAR(N) asm volatile("s_waitcnt vmcnt(" #N ") lgkmcnt(0)\n\ts_barrier" ::: "memory")
#define WAIT_BARH(NLO, NHI) do { if (wid < 4) { WAIT_BAR(NLO); } else { WAIT_BAR(NHI); } } while (0)

__device__ __forceinline__ int crow(int r, int hi) { return (r & 3) + 8 * (r >> 2) + 4 * hi; }
typedef __bf16 bf16x2_n __attribute__((ext_vector_type(2)));
typedef float f32x2_n __attribute__((ext_vector_type(2)));
__device__ __forceinline__ unsigned cvtpk(float lo, float hi) { const f32x2_n v = {lo, hi}; return __builtin_bit_cast(unsigned, __builtin_convertvector(v, bf16x2_n)); }
__device__ __forceinline__ void glds16(const void* g, unsigned lds_base) {
    unsigned sv; asm volatile("s_mov_b32 %0, m0\n\ts_mov_b32 m0, %2\n\ts_nop 0\n\tglobal_load_lds_dwordx4 %1, off\n\ts_mov_b32 m0, %0" : "=&s"(sv) : "v"(g), "s"(lds_base) : "memory"); }
typedef __attribute__((address_space(3))) const char* lds_cptr;
typedef short v4i16_t __attribute__((ext_vector_type(4)));
__device__ __forceinline__ void kload2(bf16x8* kf, lds_cptr kp, int d0) { kf[2 * d0] = *(const __attribute__((address_space(3))) bf16x8*)(kp + d0 * 2048); kf[2 * d0 + 1] = *(const __attribute__((address_space(3))) bf16x8*)(kp + d0 * 2048 + 512); }
__device__ __forceinline__ s16x4 vtr(lds_cptr p) { return __builtin_bit_cast(s16x4, __builtin_amdgcn_ds_read_tr16_b64_v4i16((__attribute__((address_space(3))) v4i16_t*)p)); }
__device__ __forceinline__ void cmask(f32x16& p0, f32x16& p1, int jb, int qrel, int hi) {
    int d = qrel - (64 * jb + 4 * hi); asm volatile("" : "+v"(d));
#pragma unroll
    for (int r = 0; r < 16; ++r) { const int c = (r & 3) + 8 * (r >> 2); if (c > d) p0[r] = -INFINITY; if (c + 32 > d) p1[r] = -INFINITY; } }

__device__ __forceinline__ void bmask(f32x16& p0, f32x16& p1, int jb, int wid, int qrel, int hi) {
    const int part = wid >> 1;
    if (jb == part) cmask(p0, p1, jb, qrel, hi);
    else if (jb > part) {
#pragma unroll
        for (int r = 0; r < 16; ++r) { p0[r] = -INFINITY; p1[r] = -INFINITY; } }
}
template <int VAR> __device__ __forceinline__ f32x16 mqk(bf16x8 a, bf16x8 b, f32x16 c) { if constexpr ((VAR & 128) != 0) return c; else return MFMA(a, b, c); }
template <int VAR> __device__ __forceinline__ f32x16 mpv(bf16x8 a, bf16x8 b, f32x16 c) { if constexpr ((VAR & 64) != 0) return c; else return MFMA(a, b, c); }
struct Ptrs { const bf16 *QBN, *QBR, *KN, *KR, *VB, *SZB; bf16* AB; const float *SSCQ, *rope, *gq, *SSQ; float* RS; unsigned long long* pts; };
#ifdef PROBE_MLAT
#define MSTAMP(k) do { if (blockIdx.x == 0 && wid == 0 && ui == PROBE_MLAT && lane_id() == 0) P.pts[k] = __builtin_amdgcn_s_memrealtime(); } while (0)
#else
#define MSTAMP(k) do { } while (0)
#endif

__device__ __forceinline__ void q_prep_units(int bh, int s, int ulo, int uhi, const Ptrs& P, const int wid) {
    const int lane = lane_id(), r32 = lane & 31, hi = lane >> 5; const int b = bh >> 4, h = bh & 15;
    if (hi != 0) return;
    f32x4 sc[8]; float s0[8], s1[8];
#pragma unroll
    for (int i = 0; i < 8; ++i) if (i >= ulo && i < uhi) { const int qb = (i & 1) ? 8 * (i >> 1) + 7 - s : 8 * (i >> 1) + s; const long row = (long)b * SEQ + qb * QB + wid * QBLK + r32;
        sc[i] = *(const f32x4*)(P.SSCQ + row * 4); s0[i] = P.SSQ[row * 32 + h]; s1[i] = P.SSQ[row * 32 + 16 + h]; }
#pragma unroll
    for (int i = 0; i < 8; ++i) if (i >= ulo && i < uhi) { const int qb = (i & 1) ? 8 * (i >> 1) + 7 - s : 8 * (i >> 1) + s; const long row = (long)b * SEQ + qb * QB + wid * QBLK + r32;
        const float msl = ((sc[i][0] + sc[i][1]) + (sc[i][2] + sc[i][3])) * (1.0f / 256.0f) + EPS;
        P.RS[row * 16 + h] = rsqrtf((s0[i] + s1[i]) * (1.0f / 96.0f) + EPS * msl) * QB_SCALE; }
}

template <int VAR> __device__ __forceinline__ void mla_cu(int bh, int s, int ulo, int uhi, const Ptrs& P, char* lds, const int wid) {
    const int b = bh >> 4, h = bh & 15;
    const long rowbase = (long)b * SEQ;
    if (wid >= 4) __builtin_amdgcn_s_setprio(1);
    bf16x8 qr[6]; float qscale = 0.f;
    int ks_prev = 2 * KSLOT, ks_cur = 0, ks_next = KSLOT, vs_prev = 2 * VSLOT, vs_cur = 0, vs_next = VSLOT;
#define QB_OF(i) (((i) & 1) ? 8 * ((i) >> 1) + 7 - s : 8 * ((i) >> 1) + s)
  for (int ui = ulo; ui < uhi; ++ui) {
    const int qb = QB_OF(ui); const bool first = ui == ulo, has_next = ui + 1 < uhi;
    MSTAMP(30);
    int lane = lane_id(); asm volatile("" : "+v"(lane));
    const int r32 = lane & 31, hi = lane >> 5;
    const int q0 = qb * QB, NT = (q0 + QB) / KVBLK;
    const unsigned lds0 = (unsigned)(uintptr_t)lds; float* wsf = (float*)(lds + LDS_WS) + wid * 64;
    const bf16* ksrc = P.KN + (rowbase + lane) * 1024 + h * 64 + wid * 8;
    const bf16* rsrc = P.KR + (rowbase + lane) * 32 + (wid & 3) * 8;
    const bf16* vsrc = P.VB + (rowbase + 16 * (wid & 3) + (lane >> 2)) * 1024 + h * 64 + (wid >> 2) * 32 + (lane & 3) * 8;
    const unsigned kdst = lds0 + LDS_K + wid * 1024, rdst = lds0 + LDS_K + (8 + (wid & 3)) * 1024, vdst = lds0 + LDS_V + wid * 1024;
#define DMA_K(t, slot) do { if (VAR & 4) break; glds16(ksrc + (long)(t) * KVBLK * 1024, (unsigned)__builtin_amdgcn_readfirstlane(kdst + (slot))); if (wid < 4) glds16(rsrc + (long)(t) * KVBLK * 32, (unsigned)__builtin_amdgcn_readfirstlane(rdst + (slot))); } while (0)
#define DMA_V(t, slot) if (!(VAR & 4)) glds16(vsrc + (long)(t) * KVBLK * 1024, (unsigned)__builtin_amdgcn_readfirstlane(vdst + (slot)))
    const lds_cptr vp0 = (lds_cptr)lds + LDS_V + ((lane >> 4) & 1) * 32 + (lane & 3) * 8 + (4 * hi + ((lane & 15) >> 2)) * 64;
    const lds_cptr kp0 = (lds_cptr)lds + LDS_K + hi * 1024 + r32 * 16;
#define LOADQ(Q0_) do { const long row_ = rowbase + (Q0_) + wid * QBLK + r32; \
        _Pragma("unroll") for (int d0 = 0; d0 < 4; ++d0) qr[d0] = *(const bf16x8*)(P.QBN + row_ * 1024 + h * 64 + d0 * 16 + hi * 8); \
        _Pragma("unroll") for (int d0 = 4; d0 < 6; ++d0) qr[d0] = *(const bf16x8*)(P.QBR + row_ * 512 + h * 32 + (d0 - 4) * 16 + hi * 8); \
        qscale = P.RS[row_ * 16 + h]; } while (0)
    if (first) { DMA_K(0, ks_cur); DMA_V(0, vs_cur); DMA_K(1, ks_next); LOADQ(q0); }
    float l_reg = 0.f; f32x16 o[2]; o[0] = f32x16{}; o[1] = f32x16{};
    const int qrel = wid * QBLK + r32;
    f32x16 pA0, pA1, pB0, pB1; bf16x8 kf[12]; s16x4 vlo[8], vhi[8]; u32x4 pw0, pw1, pw2, pw3;
#define ROT() do { ks_prev = ks_cur; ks_cur = ks_next; ks_next = (ks_next == 2 * KSLOT) ? 0 : ks_next + KSLOT; vs_prev = vs_cur; vs_cur = vs_next; vs_next = (vs_next == 2 * VSLOT) ? 0 : vs_next + VSLOT; } while (0)
#define EX(v) ((VAR & 2) ? (v) : __builtin_amdgcn_exp2f(v))
    if (first) { DMA_K(2, ks_prev); WAIT_BARH(5, 3); }
    else { WAIT_BARH(20, 18); }
#pragma unroll
    for (int d0 = 0; d0 < 6; ++d0) { const u32x4 w = __builtin_bit_cast(u32x4, qr[d0]); u32x4 pk;
        pk.x = cvtpk(bflo(w.x) * qscale, bfhi(w.x) * qscale); pk.y = cvtpk(bflo(w.y) * qscale, bfhi(w.y) * qscale); pk.z = cvtpk(bflo(w.z) * qscale, bfhi(w.z) * qscale); pk.w = cvtpk(bflo(w.w) * qscale, bfhi(w.w) * qscale);
        qr[d0] = __builtin_bit_cast(bf16x8, pk); }
    _Pragma("unroll") for (int d0 = 0; d0 < 6; ++d0) kload2(kf, kp0 + ks_cur, d0);
    pA0 = MFMA(kf[0], qr[0], f32x16{}); pA1 = MFMA(kf[1], qr[0], f32x16{});
    _Pragma("unroll") for (int d0 = 1; d0 < 6; ++d0) { pA0 = MFMA(kf[2 * d0], qr[d0], pA0); pA1 = MFMA(kf[2 * d0 + 1], qr[d0], pA1); }
    if (NT == 4) bmask(pA0, pA1, 0, wid, qrel, hi);
#pragma unroll
    for (int r = 0; r < 16; ++r) { pA0[r] = EX(pA0[r]); pA1[r] = EX(pA1[r]); }
    WAIT_BAR(0);
    DMA_K(3, ks_cur); DMA_V(1, vs_next); ROT();
    _Pragma("unroll") for (int d0 = 0; d0 < 6; ++d0) kload2(kf, kp0 + ks_cur, d0);
    WAIT_BARH(3, 2);
#define PKW(Pv, i) cvtpk(Pv[i], Pv[i + 1])
#define PAF(k) __builtin_bit_cast(bf16x8, pw##k)
#define VFR(i) (bf16x8){vlo[i][0], vlo[i][1], vlo[i][2], vlo[i][3], vhi[i][0], vhi[i][1], vhi[i][2], vhi[i][3]}
#define VRD(i) do { if (VAR & 16) break; vlo[i] = vtr(vp_ + (((i) >> 2) * 4096 + ((i) & 3) * 1024)); vhi[i] = vtr(vp_ + (((i) >> 2) * 4096 + ((i) & 3) * 1024 + 512)); } while (0)
#define KRD(G, d0) do { if ((G) && !(VAR & 32)) { kload2(kf, kp0 + ks_next, d0); SBAR(); } } while (0)
#define GAPA3F(MF, a0, a1, a2, W0, PW) do { MF; if (!(VAR & 1)) { sacc += a0; sacc2 = a1 + a2; } W0; PIN(PW); PIN(sacc); PIN(sacc2); SBAR(); } while (0)
#define GAPA3(MF, a0, a1, a2, W0, PW) do { MF; if (!(VAR & 1)) { sacc += a0; sacc2 += a1; sacc += a2; } W0; PIN(PW); PIN(sacc); PIN(sacc2); SBAR(); } while (0)
#define GAPA0(MF, W0, W1, PW) do { MF; W0; W1; PIN(PW); SBAR(); } while (0)
#define GAPA3W2(MF, a0, a1, a2, W0, W1, PW) do { MF; if (!(VAR & 1)) { sacc += a0; sacc2 += a1; sacc += a2; } W0; W1; PIN(PW); PIN(sacc); PIN(sacc2); SBAR(); } while (0)
#define GAPB(MF, X, i) do { MF; X[i] = EX(X[i]); X[i + 1] = EX(X[i + 1]); X[i + 2] = EX(X[i + 2]); X[i + 3] = EX(X[i + 3]); PIN(X); SBAR(); } while (0)
#define STEP(C0, C1, P0, P1, t, MASK, GK, GV, GL, PFX) STEPX(C0, C1, P0, P1, t, MASK, GK, GV, GL, PFX, (t) + 3, (t) + 1)
#define STEPX(C0, C1, P0, P1, t, MASK, GK, GV, GL, PFX, KT, VT) do { SBAR(); \
    const lds_cptr vp_ = vp0 + vs_prev; \
    VRD(0); SBAR(); float sacc = P0[0] + P0[1], sacc2 = 0.f; \
                    GAPA3F(C0 = mqk<VAR>(kf[0], qr[0], f32x16{}), P0[2], P0[3], P0[4],      pw0[0] = PKW(P0, 0),  pw0); \
    VRD(4); SBAR(); GAPA3(C1 = mqk<VAR>(kf[1], qr[0], f32x16{}), P0[5], P0[6], P0[7],       pw0[1] = PKW(P0, 2),  pw0); \
    VRD(1); SBAR(); GAPA3(C0 = mqk<VAR>(kf[2], qr[1], C0),   P0[8], P0[9], P0[10],      pw0[2] = PKW(P0, 4),  pw0); \
    VRD(5); SBAR(); GAPA3(C1 = mqk<VAR>(kf[3], qr[1], C1),   P0[11], P0[12], P0[13],    pw0[3] = PKW(P0, 6),  pw0); \
    VRD(2); SBAR(); GAPA3(C0 = mqk<VAR>(kf[4], qr[2], C0),   P0[14], P0[15], P1[0],     pw1[0] = PKW(P0, 8),  pw1); \
    VRD(6); SBAR(); GAPA3(C1 = mqk<VAR>(kf[5], qr[2], C1),   P1[1], P1[2], P1[3],       pw1[1] = PKW(P0, 10), pw1); \
    VRD(3); SBAR(); GAPA3(C0 = mqk<VAR>(kf[6], qr[3], C0),   P1[4], P1[5], P1[6],       pw1[2] = PKW(P0, 12), pw1); \
    VRD(7); SBAR(); GAPA3(C1 = mqk<VAR>(kf[7], qr[3], C1),   P1[7], P1[8], P1[9],       pw1[3] = PKW(P0, 14), pw1); \
                    GAPA3W2(C0 = mqk<VAR>(kf[8], qr[4], C0), P1[10], P1[11], P1[12],    pw2[0] = PKW(P1, 0),  pw2[1] = PKW(P1, 2),  pw2); \
                    GAPA3W2(C1 = mqk<VAR>(kf[9], qr[4], C1), P1[13], P1[14], P1[15],    pw2[2] = PKW(P1, 4),  pw2[3] = PKW(P1, 6),  pw2); \
                    GAPA0(C0 = mqk<VAR>(kf[10], qr[5], C0),  pw3[0] = PKW(P1, 8),  pw3[1] = PKW(P1, 10), pw3); \
                    GAPA0(C1 = mqk<VAR>(kf[11], qr[5], C1),  pw3[2] = PKW(P1, 12), pw3[3] = PKW(P1, 14), pw3); \
    l_reg += sacc + sacc2; \
    if (GK) DMA_K(KT, ks_cur); if (GV) DMA_V(VT, vs_next); PFX; \
    if (MASK) { const int jb_ = (t) - (NT - 4); if (jb_ >= 0) bmask(C0, C1, jb_, wid, qrel, hi); } \
    SBAR(); \
                GAPB(o[0] = mpv<VAR>(PAF(0), VFR(0), o[0]), C0, 0); \
    KRD(GL, 0); GAPB(o[1] = mpv<VAR>(PAF(0), VFR(4), o[1]), C0, 4); \
    KRD(GL, 1); GAPB(o[0] = mpv<VAR>(PAF(1), VFR(1), o[0]), C0, 8); \
    KRD(GL, 2); GAPB(o[1] = mpv<VAR>(PAF(1), VFR(5), o[1]), C0, 12); \
    KRD(GL, 3); GAPB(o[0] = mpv<VAR>(PAF(2), VFR(2), o[0]), C1, 0); \
    KRD(GL, 4); GAPB(o[1] = mpv<VAR>(PAF(2), VFR(6), o[1]), C1, 4); \
    KRD(GL, 5); GAPB(o[0] = mpv<VAR>(PAF(3), VFR(3), o[0]), C1, 8); \
                GAPB(o[1] = mpv<VAR>(PAF(3), VFR(7), o[1]), C1, 12); \
    } while (0)
    int t = 1;
    MSTAMP(31);
    for (; t + 5 < NT; t += 2) {
        STEP(pB0, pB1, pA0, pA1, t, false, true, true, true, (void)0);     if (VAR & 8) { asm volatile("s_waitcnt vmcnt(2) lgkmcnt(0)" ::: "memory"); } else { WAIT_BARH(3, 2); } ROT();
        STEP(pA0, pA1, pB0, pB1, t + 1, false, true, true, true, (void)0); if (VAR & 8) { asm volatile("s_waitcnt vmcnt(2) lgkmcnt(0)" ::: "memory"); } else { WAIT_BARH(3, 2); } ROT();
    }
    MSTAMP(32);
    if (NT > 4) {
        STEP(pB0, pB1, pA0, pA1, t, false, true, true, true, (void)0);     WAIT_BARH(3, 2); ROT();
        STEP(pA0, pA1, pB0, pB1, t + 1, true, true, true, true, (void)0);  WAIT_BARH(3, 2); ROT();
        t += 2;
    }
    STEPX(pB0, pB1, pA0, pA1, t, true, has_next, true, true, (void)0, 0, (t) + 1);        if (has_next) { WAIT_BARH(3, 2); } else { WAIT_BAR(1); } ROT();
    STEPX(pA0, pA1, pB0, pB1, t + 1, true, has_next, true, true, (void)0, 1, (t) + 2);    if (has_next) { WAIT_BARH(3, 2); } else { WAIT_BAR(1); } ROT();
#define PREFETCH_NEXT() do { if (has_next) { const int nq0_ = QB_OF(ui + 1) * QB; LOADQ(nq0_); } } while (0)
    MSTAMP(33);
    STEPX(pB0, pB1, pA0, pA1, NT - 1, true, has_next, has_next, false, PREFETCH_NEXT(), 2, 0);
    if (has_next) { WAIT_BARH(10, 9); } else { WAIT_BAR(0); }
    MSTAMP(34);
    u32x4 zz[4];
    { int lz = lane_id(); asm volatile("" : "+v"(lz)); const bf16* Zw = P.SZB + (rowbase + q0 + wid * QBLK) * 1024 + h * 64;
#pragma unroll
      for (int i = 0; i < 4; ++i) zz[i] = ld_hint<NT_ATTZ != 0>((const u32x4*)(Zw + (long)(i * 8 + (lz >> 3)) * 1024 + (lz & 7) * 8)); }
    { float sacc = pB0[0] + pB0[1];
#pragma unroll
      for (int r = 2; r < 16; ++r) sacc += pB0[r];
#pragma unroll
      for (int r = 0; r < 16; ++r) sacc += pB1[r];
      l_reg += sacc;
      pw0 = (u32x4){PKW(pB0, 0), PKW(pB0, 2), PKW(pB0, 4), PKW(pB0, 6)}; pw1 = (u32x4){PKW(pB0, 8), PKW(pB0, 10), PKW(pB0, 12), PKW(pB0, 14)};
      pw2 = (u32x4){PKW(pB1, 0), PKW(pB1, 2), PKW(pB1, 4), PKW(pB1, 6)}; pw3 = (u32x4){PKW(pB1, 8), PKW(pB1, 10), PKW(pB1, 12), PKW(pB1, 14)};
      const lds_cptr vp_ = vp0 + vs_cur; _Pragma("unroll") for (int i = 0; i < 8; ++i) VRD(i);
      o[0] = MFMA(PAF(0), VFR(0), o[0]); o[1] = MFMA(PAF(0), VFR(4), o[1]); o[0] = MFMA(PAF(1), VFR(1), o[0]); o[1] = MFMA(PAF(1), VFR(5), o[1]);
      o[0] = MFMA(PAF(2), VFR(2), o[0]); o[1] = MFMA(PAF(2), VFR(6), o[1]); o[0] = MFMA(PAF(3), VFR(3), o[0]); o[1] = MFMA(PAF(3), VFR(7), o[1]); }
    l_reg += __shfl_xor(l_reg, 32);
    int lane2 = lane_id(); asm volatile("" : "+v"(lane2));
    const int r32e = lane2 & 31, hie = lane2 >> 5;
    if (hie == 0) wsf[32 + r32e] = l_reg; asm volatile("s_waitcnt lgkmcnt(0)" ::: "memory");
    float rli[16];
#pragma unroll
    for (int r = 0; r < 16; ++r) rli[r] = __builtin_amdgcn_rcpf(wsf[32 + crow(r, hie)]);
    float* stg = (float*)(lds + LDS_OST) + wid * 2048;
#pragma unroll
    for (int r = 0; r < 16; ++r) { const int orow = crow(r, hie);
#pragma unroll
        for (int d0 = 0; d0 < 2; ++d0) stg[orow * 64 + d0 * 32 + r32e] = o[d0][r] * rli[r]; }
    asm volatile("s_waitcnt lgkmcnt(0)" ::: "memory");
    { const long row0 = rowbase + q0 + wid * QBLK; bf16* Ow = P.AB + row0 * 1024 + h * 64;
#pragma unroll
      for (int i = 0; i < 4; ++i) { const int row = i * 8 + (lane2 >> 3), ch = lane2 & 7;
          const f32x4 a0 = *(const f32x4*)(stg + row * 64 + ch * 8), a1 = *(const f32x4*)(stg + row * 64 + ch * 8 + 4); const u32x4 z = zz[i];
          u32x4 w; w.x = cvtpk(a0[0] * bflo(z.x), a0[1] * bfhi(z.x)); w.y = cvtpk(a0[2] * bflo(z.y), a0[3] * bfhi(z.y)); w.z = cvtpk(a1[0] * bflo(z.z), a1[1] * bfhi(z.z)); w.w = cvtpk(a1[2] * bflo(z.w), a1[3] * bfhi(z.w));
          st_hint<NT_ATTO != 0>(w, (u32x4*)(Ow + (long)row * 1024 + ch * 8)); } }
    asm volatile("s_waitcnt lgkmcnt(0)" ::: "memory");
    MSTAMP(35);
    ROT();
  }
    __builtin_amdgcn_s_setprio(0);
    asm volatile("s_waitcnt lgkmcnt(0)\n\ts_barrier" ::: "memory");
#undef QB_OF
#undef LOADQ
#undef PREFETCH_NEXT
#undef DMA_K
#undef DMA_V
#undef ROT
#undef EX
#undef PKW
#undef PAF
#undef VFR
#undef VRD
#undef KRD
#undef GAPA3
#undef GAPA3F
#undef GAPA0
#undef GAPA3W2
#undef GAPB
#undef STEP
}
#undef SBAR
#undef PIN
#undef MFMA
#undef WAIT_BAR
#undef WAIT_BARH
}

namespace swa {
using bf16x8 = __attribute__((ext_vector_type(8))) short;
using s16x4 = __attribute__((ext_vector_type(4))) short;
using f32x16 = __attribute__((ext_vector_type(16))) float;
typedef __attribute__((address_space(3))) const char* lds_cptr;
typedef short v4i16_t __attribute__((ext_vector_type(4)));
constexpr int L_K = 0, L_V = 32768, L_BT = 65536, L_WS = L_BT + 8192, L_OST = L_WS + 2048, L_TOTAL = L_OST + 8 * 8192;
static_assert(L_TOTAL <= LDS_BYTES, "SWA LDS map");
#define MFMA(a, b, c) __builtin_amdgcn_mfma_f32_32x32x16_bf16(a, b, c, 0, 0, 0)
__device__ __forceinline__ int crow(int r, int hi) { return (r & 3) + 8 * (r >> 2) + 4 * hi; }
__device__ __forceinline__ unsigned cvtpk(float lo, float hi) { unsigned r; asm("v_cvt_pk_bf16_f32 %0, %1, %2" : "=v"(r) : "v"(lo), "v"(hi)); return r; }
__device__ __forceinline__ s16x4 vtr(lds_cptr p) { return __builtin_bit_cast(s16x4, __builtin_amdgcn_ds_read_tr16_b64_v4i16((__attribute__((address_space(3))) v4i16_t*)p)); }

__device__ __forceinline__ void swa_unit(int b, int nblk, int g, const bf16* QA, const bf16* KVA, const bf16* SZA, bf16* AA, const float* BT, const float* sinks, LAS unsigned char* lds, const int wid) {
    const int lane = lane_id(), r32 = lane & 31, hi = lane >> 5, tid = wid * 64 + lane;
    const long rowbase = (long)b * SEQ;
    u32x4 bk[4], bv[4]; float tbv[4];
#pragma unroll
    for (int i = 0; i < 4; ++i) { const int e = tid + 512 * i, key = e >> 3, ch = e & 7; const int tok = (nblk - 1) * 128 + key;
        bk[i] = (u32x4){0u, 0u, 0u, 0u}; bv[i] = bk[i];
        if (tok >= 0) { const bf16* src = KVA + (rowbase + tok) * 256 + g * 64 + ch * 8; bk[i] = *(const u32x4*)src; bv[i] = *(const u32x4*)(src + 128); } }
#pragma unroll
    for (int i = 0; i < 4; ++i) { const int e = tid + 512 * i, dist = (e & 255) - 64; tbv[i] = (unsigned)dist < 128u ? BT[(g * 8 + (e >> 8)) * 128 + dist] : -INFINITY; }
    bf16x8 qn[4]; u32x4 zn[4];
    { const int task = wid * 4, hq = task >> 2, w4 = task & 3, head = g * 8 + hq; const long row0 = rowbase + nblk * 128 + 32 * w4;
#pragma unroll
      for (int d0 = 0; d0 < 4; ++d0) qn[d0] = *(const bf16x8*)(QA + (row0 + r32) * 1024 + head * 64 + d0 * 16 + hi * 8);
      const bf16* Zw = SZA + row0 * 1024 + head * 64;
#pragma unroll
      for (int i = 0; i < 4; ++i) zn[i] = ld_hint<NT_ATTZ != 0>((const u32x4*)(Zw + (long)(i * 8 + (lane >> 3)) * 1024 + (lane & 7) * 8)); }
    __syncthreads();
#pragma unroll
    for (int i = 0; i < 4; ++i) { const int e = tid + 512 * i, key = e >> 3, ch = e & 7;
        *(LAS u32x4*)(lds + L_K + ch * 4096 + key * 16) = bk[i];
        *(LAS u32x4*)(lds + L_V + (key >> 6) * 8192 + (ch >> 2) * 4096 + (key & 63) * 64 + (ch & 3) * 16) = bv[i];
        ((LAS float*)(lds + L_BT))[e] = tbv[i]; }
    __syncthreads();
    const lds_cptr kp0 = (lds_cptr)lds + L_K + hi * 4096 + r32 * 16;
    const lds_cptr vp0 = (lds_cptr)lds + L_V + ((lane >> 4) & 1) * 32 + (lane & 3) * 8 + (4 * hi + ((lane & 15) >> 2)) * 64;
    LAS float* wsf = (LAS float*)(lds + L_WS) + wid * 64; LAS float* stg = (LAS float*)(lds + L_OST) + wid * 2048;
    for (int tk = 0; tk < 4; ++tk) {
        const int task = wid * 4 + tk, hq = task >> 2, w4 = task & 3, head = g * 8 + hq, i0 = 32 * w4;
        const long row0 = rowbase + nblk * 128 + i0;
        bf16x8 qr[4];
#pragma unroll
        for (int d0 = 0; d0 < 4; ++d0) qr[d0] = qn[d0];
        u32x4 zz[4];
#pragma unroll
        for (int i = 0; i < 4; ++i) zz[i] = zn[i];
        if (tk < 3) { const int t2 = task + 1, hq2 = t2 >> 2, w42 = t2 & 3, head2 = g * 8 + hq2; const long r2 = rowbase + nblk * 128 + 32 * w42;
#pragma unroll
          for (int d0 = 0; d0 < 4; ++d0) qn[d0] = *(const bf16x8*)(QA + (r2 + r32) * 1024 + head2 * 64 + d0 * 16 + hi * 8);
          const bf16* Zw = SZA + r2 * 1024 + head2 * 64;
#pragma unroll
          for (int i = 0; i < 4; ++i) zn[i] = ld_hint<NT_ATTZ != 0>((const u32x4*)(Zw + (long)(i * 8 + (lane >> 3)) * 1024 + (lane & 7) * 8)); }
        f32x16 o[2]; o[0] = f32x16{}; o[1] = f32x16{};
        float l_reg = 0.f;
        const LAS float* tb = (const LAS float*)(lds + L_BT) + hq * 256 + 5 + i0 + 128 - 4 * hi + r32;
        const int jt0 = w4 >> 1; const bool first = nblk == 0;
#pragma unroll 1
        for (int jj = 0; jj < 3; ++jj) {
            const int jt = jt0 + jj;
            if (first && jt < 2) continue;
            f32x16 p0, p1;
            { const LAS float* tp = tb - 64 * jt;
#pragma unroll
              for (int r = 0; r < 16; ++r) { const int cr = (r & 3) + 8 * (r >> 2); p0[r] = tp[59 - cr]; p1[r] = tp[27 - cr]; } }
            { const lds_cptr kp = kp0 + jt * 1024;
              bf16x8 k0 = *(const __attribute__((address_space(3))) bf16x8*)(kp), k1 = *(const __attribute__((address_space(3))) bf16x8*)(kp + 512);
              p0 = MFMA(k0, qr[0], p0); p1 = MFMA(k1, qr[0], p1);
#pragma unroll
              for (int d0 = 1; d0 < 4; ++d0) { k0 = *(const __attribute__((address_space(3))) bf16x8*)(kp + d0 * 8192); k1 = *(const __attribute__((address_space(3))) bf16x8*)(kp + d0 * 8192 + 512);
                  p0 = MFMA(k0, qr[d0], p0); p1 = MFMA(k1, qr[d0], p1); } }
#pragma unroll
            for (int r = 0; r < 16; ++r) { p0[r] = __builtin_amdgcn_exp2f(p0[r]); p1[r] = __builtin_amdgcn_exp2f(p1[r]); }
            float sacc = 0.f;
#pragma unroll
            for (int r = 0; r < 16; ++r) sacc += p0[r] + p1[r];
            l_reg += sacc;
            u32x4 pw0 = (u32x4){cvtpk(p0[0], p0[1]), cvtpk(p0[2], p0[3]), cvtpk(p0[4], p0[5]), cvtpk(p0[6], p0[7])}, pw1 = (u32x4){cvtpk(p0[8], p0[9]), cvtpk(p0[10], p0[11]), cvtpk(p0[12], p0[13]), cvtpk(p0[14], p0[15])};
            u32x4 pw2 = (u32x4){cvtpk(p1[0], p1[1]), cvtpk(p1[2], p1[3]), cvtpk(p1[4], p1[5]), cvtpk(p1[6], p1[7])}, pw3 = (u32x4){cvtpk(p1[8], p1[9]), cvtpk(p1[10], p1[11]), cvtpk(p1[12], p1[13]), cvtpk(p1[14], p1[15])};
            const lds_cptr vp_ = vp0 + jt * 8192;
#define VF(i) ({ const s16x4 lo_ = vtr(vp_ + (((i) >> 2) * 4096 + ((i) & 3) * 1024)), hi_ = vtr(vp_ + (((i) >> 2) * 4096 + ((i) & 3) * 1024 + 512)); (bf16x8){lo_[0], lo_[1], lo_[2], lo_[3], hi_[0], hi_[1], hi_[2], hi_[3]}; })
            o[0] = MFMA(__builtin_bit_cast(bf16x8, pw0), VF(0), o[0]); o[1] = MFMA(__builtin_bit_cast(bf16x8, pw0), VF(4), o[1]);
            o[0] = MFMA(__builtin_bit_cast(bf16x8, pw1), VF(1), o[0]); o[1] = MFMA(__builtin_bit_cast(bf16x8, pw1), VF(5), o[1]);
            o[0] = MFMA(__builtin_bit_cast(bf16x8, pw2), VF(2), o[0]); o[1] = MFMA(__builtin_bit_cast(bf16x8, pw2), VF(6), o[1]);
            o[0] = MFMA(__builtin_bit_cast(bf16x8, pw3), VF(3), o[0]); o[1] = MFMA(__builtin_bit_cast(bf16x8, pw3), VF(7), o[1]);
#undef VF
        }
        l_reg += __shfl_xor(l_reg, 32);
        l_reg += __builtin_amdgcn_exp2f(sinks[head] * LOG2E);
        if (hi == 0) wsf[32 + r32] = l_reg;
        asm volatile("s_waitcnt lgkmcnt(0)" ::: "memory");
        float rli[16];
#pragma unroll
        for (int r = 0; r < 16; ++r) rli[r] = __builtin_amdgcn_rcpf(wsf[32 + crow(r, hi)]);
#pragma unroll
        for (int r = 0; r < 16; ++r) { const int orow = crow(r, hi);
#pragma unroll
            for (int d0 = 0; d0 < 2; ++d0) stg[orow * 64 + d0 * 32 + r32] = o[d0][r] * rli[r]; }
        asm volatile("s_waitcnt lgkmcnt(0)" ::: "memory");
        { bf16* Ow = AA + row0 * 1024 + head * 64;
#pragma unroll
          for (int i = 0; i < 4; ++i) { const int row = i * 8 + (lane >> 3), ch = lane & 7;
              const f32x4 a0 = *(const LAS f32x4*)(stg + row * 64 + ch * 8), a1 = *(const LAS f32x4*)(stg + row * 64 + ch * 8 + 4); const u32x4 z = zz[i];
              u32x4 w; w.x = cvtpk(a0[0] * bflo(z.x), a0[1] * bfhi(z.x)); w.y = cvtpk(a0[2] * bflo(z.y), a0[3] * bfhi(z.y)); w.z = cvtpk(a1[0] * bflo(z.z), a1[1] * bfhi(z.z)); w.w = cvtpk(a1[2] * bflo(z.w), a1[3] * bfhi(z.w));
              st_hint<NT_ATTO != 0>(w, (u32x4*)(Ow + (long)row * 1024 + ch * 8)); } }
        asm volatile("s_waitcnt lgkmcnt(0)" ::: "memory");
    }
}
#undef MFMA
}

struct Epi3c {
    static constexpr bool PERM = true, AFTER_DRAIN = false;
    bf16* __restrict__ MG; const bf16* __restrict__ SGA; const bf16* __restrict__ SGB;
    __device__ __forceinline__ void mid(pg8::f32x4 (&acc)[2][2][4][2], const pg8::Unit& u, int wr, int wc) const {
        int ln_ = lane_id(); asm volatile("" : "+v"(ln_)); const int fr = ln_ & 15, fq = ln_ >> 4;
        const int row0 = u.pm * 256 + wr * 64 + fr, lc0 = u.pn * 256 + 64 * wc + 8 * fq;
#pragma unroll
        for (int ai = 0; ai < 2; ++ai) {
            u32x4 ga[4][2];
#pragma unroll
            for (int m = 0; m < 4; ++m)
#pragma unroll
                for (int bj = 0; bj < 2; ++bj) ga[m][bj] = ld_hint<NT_SG != 0>((const u32x4*)(SGA + (size_t)(row0 + ai * 128 + m * 16) * 1024 + lc0 + 32 * bj));
#pragma unroll
            for (int m = 0; m < 4; ++m)
#pragma unroll
                for (int bj = 0; bj < 2; ++bj) {
                    const u32x4 A = ga[m][bj];
                    const float a_[8] = {bflo(A.x), bfhi(A.x), bflo(A.y), bfhi(A.y), bflo(A.z), bfhi(A.z), bflo(A.w), bfhi(A.w)};
#pragma unroll
                    for (int e = 0; e < 4; ++e) { acc[ai][bj][m][0][e] *= a_[e]; acc[ai][bj][m][1][e] *= a_[4 + e]; }
                }
            asm volatile("" ::: "memory");
        }
    }
    __device__ __forceinline__ void operator()(AccRef acc, const pg8::Unit& u, int wr, int wc, int, int) const {
        int ln_ = lane_id(); asm volatile("" : "+v"(ln_)); const int fr = ln_ & 15, fq = ln_ >> 4;
        const int row0 = u.pm * 256 + wr * 64 + fr, lc0 = u.pn * 256 + 64 * wc + 8 * fq;
#pragma unroll
        for (int ai = 0; ai < 2; ++ai) {
            u32x4 gb[4][2];
#pragma unroll
            for (int m = 0; m < 4; ++m)
#pragma unroll
                for (int bj = 0; bj < 2; ++bj) gb[m][bj] = ld_hint<NT_SG != 0>((const u32x4*)(SGB + (size_t)(row0 + ai * 128 + m * 16) * 1024 + lc0 + 32 * bj));
#pragma unroll
            for (int m = 0; m < 4; ++m)
#pragma unroll
                for (int bj = 0; bj < 2; ++bj) {
                    const u32x4 g = gb[m][bj];
                    f32x4 v0 = acc[ai][bj][m][0], v1 = acc[ai][bj][m][1];
                    v0[0] *= fmaxf(bflo(g.x), 1e-30f); v0[1] *= fmaxf(bfhi(g.x), 1e-30f); v0[2] *= fmaxf(bflo(g.y), 1e-30f); v0[3] *= fmaxf(bfhi(g.y), 1e-30f);
                    v1[0] *= fmaxf(bflo(g.z), 1e-30f); v1[1] *= fmaxf(bfhi(g.z), 1e-30f); v1[2] *= fmaxf(bflo(g.w), 1e-30f); v1[3] *= fmaxf(bfhi(g.w), 1e-30f);
                    st8(MG + (size_t)(row0 + ai * 128 + m * 16) * 1024 + lc0 + 32 * bj, v0, v1);
                }
            asm volatile("" ::: "memory");
        }
    }
};

struct Epi4 {
    static constexpr bool PERM = false, AFTER_DRAIN = false;
    const float* __restrict__ x; float* __restrict__ X1F; bf16* __restrict__ X1B; float* __restrict__ SSX1; int mode;
    __device__ __forceinline__ void operator()(AccRef acc, const pg8::Unit& u, int wr, int wc, int, int) const {
        int ln_ = lane_id(); asm volatile("" : "+v"(ln_)); const int fr = ln_ & 15, fq = ln_ >> 4;
        const int row0 = u.pm * 256 + wr * 64 + fr, c0 = u.pn * 256 + 32 * wc + 4 * fq;
#ifdef PROBE
        if (mode == 1) { pg8::f32x4 t = acc[0][0][0][0];
#pragma unroll
            for (int i_ = 1; i_ < 32; ++i_) t += acc[i_ >> 4][(i_ >> 3) & 1][(i_ >> 1) & 3][i_ & 1];
            asm volatile("" :: "v"(t)); return; }
        if (mode == 2) { pg8::f32x4 t = acc[0][0][0][0];
#pragma unroll
            for (int ai = 0; ai < 2; ++ai) { f32x4 xv[4][2][2];
#pragma unroll
                for (int m = 0; m < 4; ++m)
#pragma unroll
                    for (int bj = 0; bj < 2; ++bj)
#pragma unroll
                        for (int n = 0; n < 2; ++n) xv[m][bj][n] = *(const f32x4*)(x + (size_t)(row0 + ai * 128 + m * 16) * 1024 + c0 + 128 * bj + 16 * n);
#pragma unroll
                for (int m = 0; m < 4; ++m)
#pragma unroll
                    for (int bj = 0; bj < 2; ++bj)
#pragma unroll
                        for (int n = 0; n < 2; ++n) t += xv[m][bj][n] + acc[ai][bj][m][n];
                asm volatile("" ::: "memory"); }
            asm volatile("" :: "v"(t)); return; }
        if (mode == 4) {
#pragma unroll
            for (int ai = 0; ai < 2; ++ai)
#pragma unroll
                for (int m = 0; m < 4; ++m)
#pragma unroll
                    for (int bj = 0; bj < 2; ++bj)
#pragma unroll
                        for (int n = 0; n < 2; ++n) { const int row = u.pm * 256 + wr * 64 + ai * 128 + m * 16 + (fr & ~1) + n; const int col = u.pn * 256 + 128 * bj + 32 * wc + ((fr & 1) * 4 + fq) * 4;
                            const size_t off = (size_t)row * 1024 + col; const f32x4 v = acc[ai][bj][m][n];
                            *(f32x4*)(X1F + off) = v; u32x2 w; w.x = cvt_pk_bf16(v[0], v[1]); w.y = cvt_pk_bf16(v[2], v[3]); *(u32x2*)(X1B + off) = w; }
            return; }
        if (mode == 3) {
#pragma unroll
            for (int ai = 0; ai < 2; ++ai)
#pragma unroll
                for (int m = 0; m < 4; ++m)
#pragma unroll
                    for (int bj = 0; bj < 2; ++bj)
#pragma unroll
                        for (int n = 0; n < 2; ++n) { const size_t off = (size_t)(row0 + ai * 128 + m * 16) * 1024 + c0 + 128 * bj + 16 * n; const f32x4 v = acc[ai][bj][m][n];
                            *(f32x4*)(X1F + off) = v; u32x2 w; w.x = cvt_pk_bf16(v[0], v[1]); w.y = cvt_pk_bf16(v[2], v[3]); *(u32x2*)(X1B + off) = w; }
            return; }
#endif
#pragma unroll
        for (int ai = 0; ai < 2; ++ai) {
            f32x4 xv[4][2][2];
#pragma unroll
            for (int m = 0; m < 4; ++m)
#pragma unroll
                for (int bj = 0; bj < 2; ++bj)
#pragma unroll
                    for (int n = 0; n < 2; ++n) xv[m][bj][n] = __builtin_nontemporal_load((const f32x4*)(x + (size_t)(row0 + ai * 128 + m * 16) * 1024 + c0 + 128 * bj + 16 * n));
#pragma unroll
            for (int m = 0; m < 4; ++m) {
                const int row = row0 + ai * 128 + m * 16; float ss = 0.f;
#pragma unroll
                for (int bj = 0; bj < 2; ++bj)
#pragma unroll
                    for (int n = 0; n < 2; ++n) {
                        const size_t off = (size_t)row * 1024 + c0 + 128 * bj + 16 * n;
                        const f32x4 v = xv[m][bj][n] + acc[ai][bj][m][n];
                        ss += sumsq4(v);
                        u32x2 w; w.x = cvt_pk_bf16(v[0], v[1]); w.y = cvt_pk_bf16(v[2], v[3]); st_hint<NT_X1B != 0>(w, (u32x2*)(X1B + off));
                    }
                ss = red_fq(ss);
                if (fq == 0) SSX1[(size_t)row * 16 + u.pn * 4 + wc] = ss;
            }
            asm volatile("" ::: "memory");
        }
    }
};

struct EpiE {
    static constexpr bool PERM = true, AFTER_DRAIN = false;
    bf16* ER; float* SSE;
    __device__ __forceinline__ void operator()(AccRef acc, const pg8::Unit& u, int wr, int wc, int, int) const {
        int ln_ = lane_id(); asm volatile("" : "+v"(ln_)); const int fr = ln_ & 15, fq = ln_ >> 4;
        const int row0 = u.pm * 256 + wr * 64 + fr, lc0 = u.pn * 256 + 64 * wc + 8 * fq;
#pragma unroll
        for (int ai = 0; ai < 2; ++ai)
#pragma unroll
            for (int m = 0; m < 4; ++m) {
                const int row = row0 + ai * 128 + m * 16;
                float ss = (sumsq4(acc[ai][0][m][0]) + sumsq4(acc[ai][0][m][1])) + (sumsq4(acc[ai][1][m][0]) + sumsq4(acc[ai][1][m][1]));
                ss = red_fq(ss);
                if (fq == 0) SSE[(size_t)row * 16 + u.pn * 4 + wc] = ss;
                bf16* dst = ER + (size_t)row * 1024 + lc0;
#pragma unroll
                for (int bj = 0; bj < 2; ++bj) st8(dst + 32 * bj, acc[ai][bj][m][0], acc[ai][bj][m][1]);
            }
    }
};

struct Epi5 {
    static constexpr bool PERM = false, AFTER_DRAIN = false;
    float* __restrict__ out; const bf16* __restrict__ X1B; const bf16* __restrict__ ER; const float* __restrict__ SSX1; const float* __restrict__ SSE; const float* __restrict__ gpost;
    __device__ __forceinline__ void operator()(AccRef acc, const pg8::Unit& u, int wr, int wc, int, int) const {
        int ln_ = lane_id(); asm volatile("" : "+v"(ln_)); const int fr = ln_ & 15, fq = ln_ >> 4;
        const int row0 = u.pm * 256 + wr * 64 + fr, c0 = u.pn * 256 + 32 * wc + 4 * fq;
        f32x4 gp[2][2];
#pragma unroll
        for (int bj = 0; bj < 2; ++bj)
#pragma unroll
            for (int n = 0; n < 2; ++n) gp[bj][n] = *(const f32x4*)(gpost + c0 + 128 * bj + 16 * n);
#pragma unroll
        for (int ai = 0; ai < 2; ++ai)
#pragma unroll
            for (int mp = 0; mp < 2; ++mp) {
                f32x4 sa[2], sb[2]; u32x2 xv[2][2][2], ev[2][2][2];
#pragma unroll
                for (int mm = 0; mm < 2; ++mm) { const int row = row0 + ai * 128 + (2 * mp + mm) * 16;
                    sa[mm] = *(const f32x4*)(SSX1 + (size_t)row * 16 + 4 * fq); sb[mm] = *(const f32x4*)(SSE + (size_t)row * 16 + 4 * fq);
#pragma unroll
                    for (int bj = 0; bj < 2; ++bj)
#pragma unroll
                        for (int n = 0; n < 2; ++n) { const size_t off = (size_t)row * 1024 + c0 + 128 * bj + 16 * n; xv[mm][bj][n] = ld_hint<NT_X1ER != 0>((const u32x2*)(X1B + off)); ev[mm][bj][n] = ld_hint<NT_X1ER != 0>((const u32x2*)(ER + off)); } }
#pragma unroll
                for (int mm = 0; mm < 2; ++mm) { const int m = 2 * mp + mm, row = row0 + ai * 128 + m * 16;
                    const float s1 = red_fq((sa[mm][0] + sa[mm][1]) + (sa[mm][2] + sa[mm][3])), se = red_fq((sb[mm][0] + sb[mm][1]) + (sb[mm][2] + sb[mm][3]));
                    const float r1 = rsqrtf(s1 * (1.0f / 1024.0f) + EPS), re = rsqrtf(se * (1.0f / 1024.0f) + EPS);
#pragma unroll
                    for (int bj = 0; bj < 2; ++bj)
#pragma unroll
                        for (int n = 0; n < 2; ++n) {
                            const size_t off = (size_t)row * 1024 + c0 + 128 * bj + 16 * n;
                            const u32x2 xw = xv[mm][bj][n]; const f32x4 x1 = (f32x4){bflo(xw.x), bfhi(xw.x), bflo(xw.y), bfhi(xw.y)}; const u32x2 e = ev[mm][bj][n];
                            const f32x4 a = acc[ai][bj][m][n] * r1; f32x4 em = (f32x4){bflo(e.x), bfhi(e.x), bflo(e.y), bfhi(e.y)}; em = em * gp[bj][n] * re;
                            f32x4 o;
#pragma unroll
                            for (int q = 0; q < 4; ++q) o[q] = x1[q] + sigmoidf_(a[q]) * em[q];
                            __builtin_nontemporal_store(o, (f32x4*)(out + off));
                        } }
                asm volatile("" ::: "memory");
            }
    }
};

__device__ __forceinline__ float wave_sum(float v) {
#pragma unroll
    for (int o = 1; o < 64; o <<= 1) v += __shfl_xor(v, o);
    return v;
}
struct TrDesc { const float* W; const float* kg; bf16* WT; int ldw, srcc0, krows, K, drow0, k0; };
__device__ __forceinline__ void tr_load(const TrDesc& d, f32x4 (&v)[8], int lane) {
#pragma unroll
    for (int i = 0; i < 8; ++i) { const int kk = 8 * i + (lane >> 3), k = d.k0 + kk; v[i] = (f32x4){0.f, 0.f, 0.f, 0.f};
        if (d.srcc0 >= 0 && k < d.krows) { v[i] = ld_hint<NT_WLD != 0>((const f32x4*)(d.W + (size_t)k * d.ldw + d.srcc0 + 4 * (lane & 7))); if (d.kg) v[i] = v[i] * d.kg[k]; } }
}
__device__ __forceinline__ void tr_store(const TrDesc& d, const f32x4 (&v)[8], LAS float* scr, int lane) {
#pragma unroll
    for (int i = 0; i < 8; ++i) { LAS float* p_ = scr + (8 * i + (lane >> 3)) * 33 + 4 * (lane & 7); p_[0] = v[i][0]; p_[1] = v[i][1]; p_[2] = v[i][2]; p_[3] = v[i][3]; }
    LDS_WAIT(); asm volatile("" ::: "memory");
    const int c = lane & 7;
#pragma unroll
    for (int j = 0; j < 4; ++j) { const int n = (lane >> 3) + 8 * j; const LAS float* s = scr + (8 * c) * 33 + n;
        u32x4 o; o.x = pk2(s[0 * 33], s[1 * 33]); o.y = pk2(s[2 * 33], s[3 * 33]); o.z = pk2(s[4 * 33], s[5 * 33]); o.w = pk2(s[6 * 33], s[7 * 33]);
        *(u32x4*)(d.WT + (size_t)(d.drow0 + n) * d.K + d.k0 + 8 * c) = o; }
    LDS_WAIT(); asm volatile("" ::: "memory");
}
__device__ __forceinline__ void sincos_red(double a, double& s, double& c) {
    const double k = rint(a * 0.63661977236758134308); const double r = fma(-k, 6.123233995736766e-17, fma(-k, 1.5707963267948966, a)); const double r2 = r * r;
    double sp = -1.0 / 1307674368000.0; sp = fma(sp, r2, 1.0 / 6227020800.0); sp = fma(sp, r2, -1.0 / 39916800.0); sp = fma(sp, r2, 1.0 / 362880.0); sp = fma(sp, r2, -1.0 / 5040.0); sp = fma(sp, r2, 1.0 / 120.0); sp = fma(sp, r2, -1.0 / 6.0); sp = fma(sp * r2, r, r);
    double cp = 1.0 / 20922789888000.0; cp = fma(cp, r2, -1.0 / 87178291200.0); cp = fma(cp, r2, 1.0 / 479001600.0); cp = fma(cp, r2, -1.0 / 3628800.0); cp = fma(cp, r2, 1.0 / 40320.0); cp = fma(cp, r2, -1.0 / 720.0); cp = fma(cp, r2, 1.0 / 24.0); cp = fma(cp, r2, -0.5); cp = fma(cp, r2, 1.0);
    const int q = (int)k & 3;
    s = (q == 0) ? sp : (q == 1) ? cp : (q == 2) ? -sp : -cp; c = (q == 0) ? cp : (q == 1) ? -sp : (q == 2) ? -cp : sp;
}
__device__ __forceinline__ int hp_row(int L0) { const int lc = L0 & 255; return (L0 & ~255) + 128 * ((lc >> 5) & 1) + 32 * (lc >> 6); }

constexpr int TR_I1 = (N1 / 32) * 16, TR_I2 = 32 * 16, TR_I5 = 48 * 4, TR_I6 = 32 * 2, TR_I7 = 32 * 4;
constexpr int TR_EARLY = TR_I1 + TR_I5 + 2 * TR_I6, TR_ALL = TR_EARLY + 4 * TR_I2 + TR_I7;
__device__ __forceinline__ TrDesc tr_decode(const Args& a, int it) {
    unsigned char* ws = a.ws;
    constexpr int I1 = TR_I1, I2 = TR_I2, I5 = TR_I5, I6 = TR_I6;
    {
        int r = it;
        if (r < I1) { const int nb = r / 16, kb = r % 16, L0 = nb * 32; int src = L0 < 2720 ? L0 : (L0 < 2816 ? -1 : L0 - 96);
            if (L0 >= 3840) { const int j = (L0 - 3840) >> 8, lc = L0 & 255, wc_ = lc >> 6, bj_ = (lc >> 5) & 1; src = (bj_ ? 4768 : 3744) + 128 * j + 32 * wc_; }
            return TrDesc{a.in[4], nullptr, (bf16*)(ws + WS_BT1), DIN, src, 1024, 1024, hp_row(L0), kb * 64}; } r -= I1;
        if (r < I5) { const int nb = r / 4, kb = r % 4, L0 = nb * 32; const int src = L0 < 1024 ? (L0 >> 6) * 96 + (L0 & 63) : ((L0 - 1024) >> 5) * 96 + 64;
            return TrDesc{a.in[11], a.in[10], (bf16*)(ws + WS_BT2), 1536, src, 256, 256, hp_row(L0), kb * 64}; } r -= I5;
        if (r < I6) { const int nb = r / 2, kb = r % 2; return TrDesc{a.in[13], a.in[12], (bf16*)(ws + WS_BT2) + (size_t)1536 * 256, 1024, nb * 32, 128, 128, hp_row(nb * 32), kb * 64}; } r -= I6;
        if (r < I6) { const int nb = r / 2, kb = r % 2; return TrDesc{a.in[14], a.in[12], (bf16*)(ws + WS_BT2) + (size_t)1536 * 256 + (size_t)1024 * 128, 1024, nb * 32, 128, 128, hp_row(nb * 32), kb * 64}; } r -= I6;
        if (r < I2) { const int nb = r / 16, kb = r % 16; return TrDesc{a.in[9], nullptr, (bf16*)(ws + WS_BT3), 1024, nb * 32, 1024, 2048, hp_row(nb * 32), kb * 64}; } r -= I2;
        if (r < I2) { const int nb = r / 16, kb = r % 16; return TrDesc{a.in[18], nullptr, (bf16*)(ws + WS_BT3) + 1024, 1024, nb * 32, 1024, 2048, hp_row(nb * 32), kb * 64}; } r -= I2;
        if (r < I2) { const int nb = r / 16, kb = r % 16; return TrDesc{a.in[19], nullptr, (bf16*)(ws + WS_WOUT), 1024, nb * 32, 1024, 1024, nb * 32, kb * 64}; } r -= I2;
        if (r < I2) { const int nb = r / 16, kb = r % 16; return TrDesc{a.in[21], a.in[20], (bf16*)(ws + WS_WG), 1024, nb * 32, 1024, 1024, nb * 32, kb * 64}; } r -= I2;
        { const int nb = r / 4, kb = r % 4; return TrDesc{a.in[22], nullptr, (bf16*)(ws + WS_WPP), 1024, nb * 32, 256, 256, hp_row(nb * 32), kb * 64}; }
    }
}

__device__ __forceinline__ void tr_items(Frame& F, const Args& a, int it0, int it1, int worker, int nworkers) {
    LAS float* scr = (LAS float*)(F.lds + F.wave * 16384);
    const int lane = F.lane;
    for (int it = it0 + worker; it < it1; it += 2 * nworkers) {
        const bool two = it + nworkers < it1;
        const TrDesc d0 = tr_decode(a, it), d1 = tr_decode(a, two ? it + nworkers : it);
        f32x4 v0[8], v1[8];
        tr_load(d0, v0, lane); if (two) tr_load(d1, v1, lane);
        tr_store(d0, v0, scr, lane); if (two) tr_store(d1, v1, scr, lane);
    }
}

__device__ __forceinline__ void p0_prologue(Frame& F, const Args& a) {
    unsigned char* ws = a.ws;
    const int gw = F.vcu * NWAVES + F.wave, NGW = F.G * NWAVES, lane = F.lane;
    tr_items(F, a, 0, TR_EARLY, gw, NGW);
    FSTAMP(F, 10);
    {
        const float* x = a.in[0]; const float* g = a.in[3]; bf16* XN = (bf16*)(ws + WS_XN);
        f32x4 gv[4];
#pragma unroll
        for (int j = 0; j < 4; ++j) gv[j] = *(const f32x4*)(g + 4 * lane + 256 * j);
        for (int m = gw; m < T; m += 4 * NGW) {
            f32x4 v[4][4]; float ssq[4];
#pragma unroll
            for (int r = 0; r < 4; ++r) { const int mr = m + r * NGW < T ? m + r * NGW : m; const f32x4* xr = (const f32x4*)(x + (size_t)mr * DM) + lane;
#pragma unroll
                for (int j = 0; j < 4; ++j) v[r][j] = __builtin_nontemporal_load(xr + 64 * j); }
#pragma unroll
            for (int r = 0; r < 4; ++r) { float s_ = 0.f;
#pragma unroll
                for (int j = 0; j < 4; ++j) s_ += sumsq4(v[r][j]);
                ssq[r] = s_; }
#pragma unroll
            for (int o = 1; o < 64; o <<= 1) {
#pragma unroll
                for (int r = 0; r < 4; ++r) ssq[r] += __shfl_xor(ssq[r], o); }
#pragma unroll
            for (int r = 0; r < 4; ++r) { const int mr = m + r * NGW; if (mr < T) { const float rr = rsqrtf(ssq[r] * (1.0f / DM) + EPS);
                unsigned long long* o8 = (unsigned long long*)(XN + (size_t)mr * DM) + lane;
#pragma unroll
                for (int j = 0; j < 4; ++j) { const f32x4 w = v[r][j] * gv[j] * rr; o8[64 * j] = (unsigned long long)cvt_pk_bf16(w[0], w[1]) | ((unsigned long long)cvt_pk_bf16(w[2], w[3]) << 32); } } }
        }
    }
    FSTAMP(F, 11);
    {
        const int gt = F.vcu * NTHR + F.tid, NGT = F.G * NTHR; const int* pos = (const int*)a.in[2]; float* rope = (float*)(ws + WS_ROPE);
        float invf_c = (float)exp2(-(double)(gt & 15) * (13.287712379549449 / 16.0));
        for (int e = gt; e < T * 16; e += NGT) { const int row = e >> 4, i = e & 15;
            const float invf = (NGT & 15) == 0 ? invf_c : (float)exp2(-(double)i * (13.287712379549449 / 16.0)); const float ang = (float)pos[row] * invf;
            double sv, cv; sincos_red((double)ang, sv, cv); rope[(size_t)row * 32 + i] = (float)cv; rope[(size_t)row * 32 + 16 + i] = (float)sv; }
        float* bt = (float*)(ws + WS_BT); const float* rb = a.in[8];
        for (int e = gt; e < 16 * 128; e += NGT) { const int h = e >> 7, d = e & 127;
            int b = d; if (d >= 16) { b = 16 + (int)(logf((float)d * (1.0f / 16.0f)) / logf(8.0f) * 16.0f); b = b < 31 ? b : 31; }
            bt[e] = rb[b * 16 + h] * LOG2E; }
    }
    FSTAMP(F, 12);
}
__device__ __forceinline__ void p_to_bf16(Frame& F, const Args& a, int worker, int nworkers) {
    const int gt = worker * NTHR + F.tid, NGT = nworkers * NTHR; const f32x4* p = (const f32x4*)a.in[1]; u32x2* o = (u32x2*)(a.ws + WS_PB);
    for (int e = gt; e < T * 256 / 4; e += NGT) { const f32x4 v = ld_hint<NT_PLD != 0>(p + e); u32x2 w; w.x = cvt_pk_bf16(v[0], v[1]); w.y = cvt_pk_bf16(v[2], v[3]); st_hint<NT_PST != 0>(w, o + e); }
}

__device__ __forceinline__ void cvt8(u32x4 w, LAS float* d) {
    *(LAS f32x4*)d = (f32x4){bflo(w.x), bfhi(w.x), bflo(w.y), bfhi(w.y)}; *(LAS f32x4*)(d + 4) = (f32x4){bflo(w.z), bfhi(w.z), bflo(w.w), bfhi(w.w)};
}
__device__ __forceinline__ void mla_simple(Frame& F, const Args& a) {
    unsigned char* ws = a.ws;
    const bf16 *QBN = (const bf16*)(ws + WS_QBN), *QBR = (const bf16*)(ws + WS_QBR), *KN = (const bf16*)(ws + WS_KN), *KR = (const bf16*)(ws + WS_KR), *VB = (const bf16*)(ws + WS_VB);
    const bf16* SZB = (const bf16*)a.out + (size_t)T * 1024; bf16* AB = (bf16*)(ws + WS_QBN);
    const float *SSCQ = (const float*)(ws + WS_SSCQ), *rope = (const float*)(ws + WS_ROPE), *gq = a.in[15];
    LAS float* Kf = (LAS float*)F.lds; LAS float* Vf = Kf + 64 * 96;
    const int tid = F.tid;
    for (int ui = F.vcu; ui < 1024; ui += F.G) {
        const int bh = ui & 63, s = ui >> 6; const int qb = ((s >> 2) & 1) ? 4 * (s >> 2) + 3 - (s & 3) : 4 * (s >> 2) + (s & 3);
        const int b = bh >> 4, h = bh & 15; const int qpos = qb * 512 + tid; const size_t row = (size_t)b * SEQ + qpos;
        f32x4 q[24];
        {
            const u32x4* qn = (const u32x4*)(QBN + row * 1024 + h * 64); const u32x4* qr = (const u32x4*)(QBR + row * 512 + h * 32);
#pragma unroll
            for (int c = 0; c < 12; ++c) { const u32x4 w = c < 8 ? qn[c] : qr[c - 8];
                q[2 * c] = (f32x4){bflo(w.x), bfhi(w.x), bflo(w.y), bfhi(w.y)}; q[2 * c + 1] = (f32x4){bflo(w.z), bfhi(w.z), bflo(w.w), bfhi(w.w)}; }
            const float* SSQ = (const float*)(ws + WS_SSQ); const float ss = SSQ[row * 32 + h] + SSQ[row * 32 + 16 + h];
            const f32x4 sc = *(const f32x4*)(SSCQ + row * 4);
            const float msl = ((sc[0] + sc[1]) + (sc[2] + sc[3])) * (1.0f / 256.0f) + EPS;
            const float r = rsqrtf(ss * (1.0f / 96.0f) + EPS * msl);
#pragma unroll
            for (int c = 0; c < 24; ++c) q[c] = q[c] * r;
#pragma unroll
            for (int c = 0; c < 24; ++c) q[c] = q[c] * QB_SCALE;
        }
        f32x4 o[16];
#pragma unroll
        for (int c = 0; c < 16; ++c) o[c] = (f32x4){0.f, 0.f, 0.f, 0.f};
        float mrun = -INFINITY, l = 0.f;
        const int nkt = (qb + 1) * 8;
        for (int kt = 0; kt < nkt; ++kt) {
            __syncthreads();
            { const int key = tid >> 3, ch = tid & 7; const size_t kr = (size_t)b * SEQ + kt * 64 + key;
              cvt8(*(const u32x4*)(KN + kr * 1024 + h * 64 + ch * 8), Kf + key * 96 + ch * 8);
              cvt8(*(const u32x4*)(VB + kr * 1024 + h * 64 + ch * 8), Vf + key * 64 + ch * 8);
              if (tid < 256) { const int k2 = tid >> 2, c2 = tid & 3; cvt8(*(const u32x4*)(KR + ((size_t)b * SEQ + kt * 64 + k2) * 32 + c2 * 8), Kf + k2 * 96 + 64 + c2 * 8); } }
            __syncthreads();
            for (int c8 = 0; c8 < 8; ++c8) {
                float sv[8]; float cm = -INFINITY;
#pragma unroll
                for (int j = 0; j < 8; ++j) { const LAS f32x4* kp = (const LAS f32x4*)(Kf + (c8 * 8 + j) * 96); f32x4 acc = q[0] * kp[0];
#pragma unroll
                    for (int c = 1; c < 24; ++c) acc += q[c] * kp[c];
                    float sj = (acc[0] + acc[1]) + (acc[2] + acc[3]);
                    if (kt * 64 + c8 * 8 + j > qpos) sj = -INFINITY;
                    sv[j] = sj; cm = fmaxf(cm, sj); }
                const float mn = fmaxf(mrun, cm), f = __builtin_amdgcn_exp2f(mrun - mn); mrun = mn; l *= f;
#pragma unroll
                for (int c = 0; c < 16; ++c) o[c] = o[c] * f;
#pragma unroll
                for (int j = 0; j < 8; ++j) { const float p = __builtin_amdgcn_exp2f(sv[j] - mn); l += p; const LAS f32x4* vp = (const LAS f32x4*)(Vf + (c8 * 8 + j) * 64);
#pragma unroll
                    for (int c = 0; c < 16; ++c) o[c] += vp[c] * p; }
            }
        }
        const float rl = 1.0f / l;
        const u32x4* sz = (const u32x4*)(SZB + row * 1024 + h * 64); u32x4* dst = (u32x4*)(AB + row * 1024 + h * 64);
#pragma unroll
        for (int c = 0; c < 8; ++c) { const u32x4 g = sz[c]; f32x4 v0 = o[2 * c] * rl, v1 = o[2 * c + 1] * rl;
            v0[0] *= bflo(g.x); v0[1] *= bfhi(g.x); v0[2] *= bflo(g.y); v0[3] *= bfhi(g.y); v1[0] *= bflo(g.z); v1[1] *= bfhi(g.z); v1[2] *= bflo(g.w); v1[3] *= bfhi(g.w);
            u32x4 w; w.x = cvt_pk_bf16(v0[0], v0[1]); w.y = cvt_pk_bf16(v0[2], v0[3]); w.z = cvt_pk_bf16(v1[0], v1[1]); w.w = cvt_pk_bf16(v1[2], v1[3]); dst[c] = w; }
    }
    __syncthreads();
}
__device__ __forceinline__ void swa_simple(Frame& F, const Args& a) {
    unsigned char* ws = a.ws;
    const bf16 *QA = (const bf16*)(ws + WS_QA), *KVA = (const bf16*)(ws + WS_KVA); const bf16* SZA = (const bf16*)a.out; bf16* AA = (bf16*)(ws + WS_QA);
    const float *bt = (const float*)(ws + WS_BT), *sinks = a.in[7];
    LAS float* Kf = (LAS float*)F.lds; LAS float* Vf = Kf + 256 * 64;
    const int tid = F.tid;
    for (int ui = F.vcu; ui < 256; ui += F.G) {
        const int b = ui >> 6, nblk = ui & 63;
        for (int g = 0; g < 2; ++g) {
            __syncthreads();
            for (int e = tid; e < 256 * 8; e += NTHR) { const int c = e >> 3, ch = e & 7; const int tok = (nblk - 1) * 128 + c;
                if (tok >= 0) { const size_t kr = (size_t)b * SEQ + tok;
                    cvt8(*(const u32x4*)(KVA + kr * 256 + g * 64 + ch * 8), Kf + c * 64 + ch * 8);
                    cvt8(*(const u32x4*)(KVA + kr * 256 + 128 + g * 64 + ch * 8), Vf + c * 64 + ch * 8); }
                else { const u32x4 z = (u32x4){0u, 0u, 0u, 0u}; cvt8(z, Kf + c * 64 + ch * 8); cvt8(z, Vf + c * 64 + ch * 8); } }
            __syncthreads();
            for (int itr = 0; itr < 2; ++itr) {
                const int p = tid + NTHR * itr, ql = p & 127, head = g * 8 + (p >> 7); const int ql0 = ql & ~63;
                const size_t row = (size_t)b * SEQ + nblk * 128 + ql;
                f32x4 q[16];
                { const u32x4* qp = (const u32x4*)(QA + row * 1024 + head * 64);
#pragma unroll
                  for (int c = 0; c < 8; ++c) { const u32x4 w = qp[c]; q[2 * c] = (f32x4){bflo(w.x), bfhi(w.x), bflo(w.y), bfhi(w.y)}; q[2 * c + 1] = (f32x4){bflo(w.z), bfhi(w.z), bflo(w.w), bfhi(w.w)}; } }
                f32x4 o[16];
#pragma unroll
                for (int c = 0; c < 16; ++c) o[c] = (f32x4){0.f, 0.f, 0.f, 0.f};
                float mrun = sinks[head] * LOG2E, l = 1.0f;
                const float* bth = bt + head * 128;
                for (int c0 = ql0 + 1; c0 < ql0 + 192; c0 += 8) {
                    float sv[8]; float cm = -INFINITY;
#pragma unroll
                    for (int j = 0; j < 8; ++j) { const int c = c0 + j; const int cc = c < 256 ? c : 255; const LAS f32x4* kp = (const LAS f32x4*)(Kf + cc * 64); f32x4 acc = q[0] * kp[0];
#pragma unroll
                        for (int d = 1; d < 16; ++d) acc += q[d] * kp[d];
                        const int dist = ql + 128 - c; const bool valid = dist >= 0 && dist < 128 && c < 256 && !(nblk == 0 && c < 128);
                        float sj = (acc[0] + acc[1]) + (acc[2] + acc[3]) + bth[dist & 127];
                        sj = valid ? sj : -INFINITY; sv[j] = sj; cm = fmaxf(cm, sj); }
                    const float mn = fmaxf(mrun, cm), f = __builtin_amdgcn_exp2f(mrun - mn); mrun = mn; l *= f;
#pragma unroll
                    for (int d = 0; d < 16; ++d) o[d] = o[d] * f;
#pragma unroll
                    for (int j = 0; j < 8; ++j) { const int c = c0 + j; const int cc = c < 256 ? c : 255; const float pj = __builtin_amdgcn_exp2f(sv[j] - mn); l += pj; const LAS f32x4* vp = (const LAS f32x4*)(Vf + cc * 64);
#pragma unroll
                        for (int d = 0; d < 16; ++d) o[d] += vp[d] * pj; }
                }
                const float rl = 1.0f / l;
                const u32x4* sz = (const u32x4*)(SZA + row * 1024 + head * 64); u32x4* dst = (u32x4*)(AA + row * 1024 + head * 64);
#pragma unroll
                for (int c = 0; c < 8; ++c) { const u32x4 gz = sz[c]; f32x4 v0 = o[2 * c] * rl, v1 = o[2 * c + 1] * rl;
                    v0[0] *= bflo(gz.x); v0[1] *= bfhi(gz.x); v0[2] *= bflo(gz.y); v0[3] *= bfhi(gz.y); v1[0] *= bflo(gz.z); v1[1] *= bfhi(gz.z); v1[2] *= bflo(gz.w); v1[3] *= bfhi(gz.w);
                    u32x4 w; w.x = cvt_pk_bf16(v0[0], v0[1]); w.y = cvt_pk_bf16(v0[2], v0[3]); w.z = cvt_pk_bf16(v1[0], v1[1]); w.w = cvt_pk_bf16(v1[2], v1[3]); dst[c] = w; }
            }
        }
    }
    __syncthreads();
}

__device__ __forceinline__ void swa_phase(Frame& F, const Args& a) {
    unsigned char* ws = a.ws;
    unsigned* qctr = (unsigned*)(ws + WS_CTL + 8192); volatile LAS unsigned* qw = (volatile LAS unsigned*)(F.lds + LDS_BYTES - 128);
    const bool asker = F.wave == 0 && lane_id() == 0;
    unsigned got = 0u; if (asker) got = __hip_atomic_fetch_add(qctr, 1u, __ATOMIC_RELAXED, __HIP_MEMORY_SCOPE_AGENT);
    float gqm, gkm, rbm, skm;
    { const int l = F.lane; float v = fabsf(a.in[5][l]), w = fabsf(a.in[6][l]), z = 0.f, y = fabsf(a.in[7][l & 15]);
#pragma unroll
      for (int j = 0; j < 8; ++j) z = fmaxf(z, fabsf(a.in[8][l + 64 * j]));
#pragma unroll
      for (int o = 1; o < 64; o <<= 1) { v = fmaxf(v, __shfl_xor(v, o)); w = fmaxf(w, __shfl_xor(w, o)); z = fmaxf(z, __shfl_xor(z, o)); y = fmaxf(y, __shfl_xor(y, o)); }
      gqm = v; gkm = w; rbm = z; skm = y; }
    const float Mb = fmaxf(1.01f * QA_SCALE * 64.0f * gqm * gkm + rbm * LOG2E, skm * LOG2E);
    bool general = !(__builtin_amdgcn_readfirstlane(__float_as_int(Mb)) < __float_as_int(64.0f));
#ifdef FORCE_SIMPLE
    general = true;
#endif
    if (general) { swa_simple(F, a); return; }
#define SWA_UNIT(u) swa::swa_unit((u) >> 7, ((u) >> 1) & 63, (u) & 1, (const bf16*)(ws + WS_QA), (const bf16*)(ws + WS_KVA), (const bf16*)a.out, (bf16*)(ws + WS_QA), (const float*)(ws + WS_BT), a.in[7], F.lds, F.wave)
    for (;;) {
        if (asker) qw[0] = got;
        __syncthreads();
        const unsigned u = qw[0];
        if (u >= 512u) break;
        if (asker) got = __hip_atomic_fetch_add(qctr, 1u, __ATOMIC_RELAXED, __HIP_MEMORY_SCOPE_AGENT);
        SWA_UNIT((int)u);
    }
#undef SWA_UNIT
    __syncthreads();
}

#if defined(PROBE) && defined(PROBE_MLAV)
__device__ __forceinline__ void mla_probe_pass(Frame& F, const Args& a, char* lds) {
    unsigned char* ws = a.ws;
    const mla::Ptrs P{(const bf16*)(ws + WS_QBN), (const bf16*)(ws + WS_QBR), (const bf16*)(ws + WS_KN), (const bf16*)(ws + WS_KR), (const bf16*)(ws + WS_VB), (const bf16*)a.out + (size_t)T * 1024,
                      (bf16*)a.out, (const float*)(ws + WS_SSCQ), (const float*)(ws + WS_ROPE), a.in[15], (const float*)(ws + WS_SSQ), (float*)(ws + WS_RS), (unsigned long long*)(ws + WS_CTL + 4096)};
    for (int vv = F.vcu; vv < 256; vv += F.G) {
        const int bh = vv >> 2, s = vv & 3;
#ifndef PROBE_ULO
#define PROBE_ULO 0
#define PROBE_UHI 8
#endif
        mla::mla_cu<PROBE_MLAV>(bh, s, PROBE_ULO, PROBE_UHI, P, lds, F.wave);
    }
}
#endif
__device__ __forceinline__ void mla_phase(Frame& F, const Args& a, char* lds) {
    unsigned char* ws = a.ws;
    const mla::Ptrs P{(const bf16*)(ws + WS_QBN), (const bf16*)(ws + WS_QBR), (const bf16*)(ws + WS_KN), (const bf16*)(ws + WS_KR), (const bf16*)(ws + WS_VB), (const bf16*)a.out + (size_t)T * 1024,
                      (bf16*)(ws + WS_QBN), (const float*)(ws + WS_SSCQ), (const float*)(ws + WS_ROPE), a.in[15], (const float*)(ws + WS_SSQ), (float*)(ws + WS_RS), (unsigned long long*)(ws + WS_CTL + 4096)};
    float gqm, gknm, gkrm;
    { const int l = F.lane; float v = fmaxf(fabsf(a.in[15][l]), fabsf(a.in[15][64 + (l & 31)])), w = fabsf(a.in[16][l]), z = fabsf(a.in[17][l & 31]);
#pragma unroll
      for (int o = 1; o < 64; o <<= 1) { v = fmaxf(v, __shfl_xor(v, o)); w = fmaxf(w, __shfl_xor(w, o)); z = fmaxf(z, __shfl_xor(z, o)); }
      gqm = v; gknm = w; gkrm = z; }
    const float Mb = 1.01f * QB_SCALE * sqrtf(96.0f) * gqm * sqrtf(64.0f * gknm * gknm + 32.0f * gkrm * gkrm);
#ifdef FORCE_SIMPLE
    { mla_simple(F, a); return; }
#endif
    if (!(__builtin_amdgcn_readfirstlane(__float_as_int(Mb)) < __float_as_int(64.0f))) { mla_simple(F, a); return; }
    unsigned* qctr = (unsigned*)(ws + WS_CTL + 8192 + 256); volatile LAS unsigned* qw = (volatile LAS unsigned*)(F.lds + LDS_BYTES - 128);
    const bool asker = F.wave == 0 && lane_id() == 0, dyn = F.G == 256;
    int vv = F.vcu, bh = vv >> 2, s = vv & 3, ulo = dyn ? 1 : 0, uhi = 8;
    if (vv >= 256) return;
    mla::q_prep_units(bh, s, ulo, uhi, P, F.wave);
    for (;;) {
        mla::mla_cu<0>(bh, s, ulo, uhi, P, lds, F.wave);
        if (dyn) {
            if (asker) qw[0] = __hip_atomic_fetch_add(qctr, 1u, __ATOMIC_RELAXED, __HIP_MEMORY_SCOPE_AGENT);
            __syncthreads();
            const unsigned idx = qw[0];
            __syncthreads();
            if (idx >= 256u) break;
            bh = (int)(idx & 63u); s = 3 - (int)(idx >> 6); ulo = 0; uhi = 1;
            mla::q_prep_units(bh, s, 0, 1, P, F.wave);
        } else {
            vv += F.G; if (vv >= 256) break;
            bh = vv >> 2; s = vv & 3;
            mla::q_prep_units(bh, s, 0, 8, P, F.wave);
        }
    }
}

#define RLX_AGENT __ATOMIC_RELAXED, __HIP_MEMORY_SCOPE_AGENT
#define XB_TMO      128
#define XB_XCNT(j)  (256  + 64 * (j))
#define XB_XSUB(j)  (1280 + 64 * (j))
#define XB_XGEN(j)  (2304 + 64 * (j))
#define XB_TOP      3328
#define XB_TOPGEN   3392
#define XCD_BAR_WORDS 3456
#define XB_SPIN_CAP (1u << 18)

__device__ __forceinline__ unsigned xb_ld(unsigned* p)              { return __hip_atomic_load(p, __ATOMIC_RELAXED, __HIP_MEMORY_SCOPE_AGENT); }
__device__ __forceinline__ unsigned xb_add(unsigned* p, unsigned v) { return __hip_atomic_fetch_add(p, v, __ATOMIC_RELAXED, __HIP_MEMORY_SCOPE_AGENT); }
__device__ __forceinline__ unsigned xb_xcc_id() { return (unsigned)__builtin_amdgcn_s_getreg((3 << 11) | 20) & 0xFu; }
#define XB_SPIN(cond, bar) do { unsigned _sp = 0; while (cond) { __builtin_amdgcn_s_sleep(1); \
    if ((++_sp & 255u) == 0u) { if (xb_ld(&(bar)[XB_TMO])) break; if (_sp > XB_SPIN_CAP) { atomicAdd(&(bar)[XB_TMO], 1u); break; } } } } while (0)

struct XcdBarrier {
    unsigned* bar; unsigned x; bool leader;
    volatile LAS unsigned* st;
};

__device__ __forceinline__ XcdBarrier xcd_barrier_post(unsigned* bar, volatile LAS unsigned* st, bool leader) {
    XcdBarrier b; b.bar = bar; b.x = xb_xcc_id(); b.st = st; b.leader = leader;
    if (b.leader) (void)xb_add(&bar[XB_XCNT(b.x)], 1u);
    return b;
}
__device__ __forceinline__ void xcd_barrier_complete(unsigned* bar, unsigned x, unsigned& nloc, unsigned& nx) {
    const unsigned G = gridDim.x * gridDim.y * gridDim.z;
    unsigned sum, cnt, mine, sp = 0u;
    for (;;) {
        sum = 0u; cnt = 0u; mine = 0u;
#pragma unroll
        for (unsigned j = 0; j < 16; ++j) { const unsigned c = xb_ld(&bar[XB_XCNT(j)]); sum += c; cnt += (c > 0u) ? 1u : 0u; mine = (j == x) ? c : mine; }
        if (sum == G) break;
        __builtin_amdgcn_s_sleep(1);
        if ((++sp & 255u) == 0u) { if (xb_ld(&bar[XB_TMO])) break; if (sp > XB_SPIN_CAP) { atomicAdd(&bar[XB_TMO], 1u); break; } }
    }
    nloc = mine > 0u ? mine : 1u; nx = cnt > 0u ? cnt : 1u;
}

__device__ __forceinline__ void xcd_barrier(const XcdBarrier& b, bool leader) {
    asm volatile("s_waitcnt vmcnt(0)" ::: "memory");
    __syncthreads();
    if (leader) {
        unsigned* bar = b.bar;
        __builtin_amdgcn_s_waitcnt(0);
        unsigned nloc = b.st[0], nx = b.st[1];
        if (nloc == 0u) { xcd_barrier_complete(bar, b.x, nloc, nx); b.st[0] = nloc; b.st[1] = nx; }
        const unsigned old = xb_add(&bar[XB_XSUB(b.x)], 1u);
        const unsigned gen = old / nloc;
        if (old + 1u == (gen + 1u) * nloc) {
            __builtin_amdgcn_fence(__ATOMIC_RELEASE, "agent");
            asm volatile("s_waitcnt vmcnt(0)" ::: "memory");
            const unsigned og = xb_add(&bar[XB_TOP], 1u);
            const unsigned tg = og / nx;
            if (og + 1u == (tg + 1u) * nx) xb_add(&bar[XB_TOPGEN], 1u);
            else XB_SPIN(xb_ld(&bar[XB_TOPGEN]) == tg, bar);
            __builtin_amdgcn_fence(__ATOMIC_ACQUIRE, "agent");
            xb_add(&bar[XB_XGEN(b.x)], 1u);
            asm volatile("s_waitcnt vmcnt(0)" ::: "memory");
        } else {
            XB_SPIN(xb_ld(&bar[XB_XGEN(b.x)]) == gen, bar);
            __builtin_amdgcn_fence(__ATOMIC_ACQUIRE, "agent");
            asm volatile("s_waitcnt vmcnt(0)" ::: "memory");
        }
    }
    __syncthreads();
}

__device__ __forceinline__ void grid_barrier(unsigned* ctr, unsigned target, int wave) {
    asm volatile("s_waitcnt vmcnt(0) lgkmcnt(0)" ::: "memory");
    __syncthreads();
    if (wave == 0 && lane_id() == 0) {
        __builtin_amdgcn_fence(__ATOMIC_RELEASE, "agent");
        asm volatile("s_waitcnt vmcnt(0)" ::: "memory");
        __hip_atomic_fetch_add(ctr, 1u, __ATOMIC_RELAXED, __HIP_MEMORY_SCOPE_AGENT);
        const unsigned long long t0 = __builtin_amdgcn_s_memrealtime();
        while (__hip_atomic_load(ctr, __ATOMIC_RELAXED, __HIP_MEMORY_SCOPE_AGENT) < target) {
            __builtin_amdgcn_s_sleep(2);
            if (__builtin_amdgcn_s_memrealtime() - t0 > 200000000ull) break;
        }
        __builtin_amdgcn_fence(__ATOMIC_ACQUIRE, "agent");
        asm volatile("s_waitcnt vmcnt(0)" ::: "memory");
    }
    __syncthreads();
}

constexpr int NPHASE = 7;
__global__ void __launch_bounds__(NTHR, 2) mk_fwd(Args a) {
    extern __shared__ __attribute__((aligned(16))) unsigned char lds[];
    cg::grid_group grid = cg::this_grid();
    Frame F; F.lds = (LAS unsigned char*)lds; F.wave = __builtin_amdgcn_readfirstlane((int)threadIdx.x >> 6); F.lane = lane_id(); F.tid = F.wave * 64 + F.lane;
    F.G = gridDim.x; { const int bx = blockIdx.x; F.vcu = (F.G % 8 == 0) ? (bx % 8) * (F.G / 8) + bx / 8 : bx; }
    unsigned char* ws = a.ws;
    const int lo = a.ph_lo, hi = a.ph_hi;
#define IN(k) (lo <= (k) && (k) < hi)
#define RELANE() do { F.lane = lane_id(); F.tid = F.wave * 64 + F.lane; } while (0)
    volatile LAS unsigned* xst = (volatile LAS unsigned*)(F.lds + LDS_BYTES - 256);
    if (F.wave == 0 && lane_id() < 2) xst[lane_id() & 1] = 0u;
    __syncthreads();
    const XcdBarrier xbar = xcd_barrier_post((unsigned*)(ws + WS_CTL + 16384), xst, F.wave == 0 && lane_id() == 0);
#ifdef PROBE_BAR
    for (int i_ = 0; i_ < 8; ++i_) xcd_barrier(xbar, F.wave == 0 && lane_id() == 0);
#endif
#if defined(PROBE) && defined(PROBE_IMBP)
#define IMBREC(k) do { if ((k) == PROBE_IMBP && F.wave == 0 && lane_id() == 0) { const unsigned long long t_ = __builtin_amdgcn_s_memrealtime(); atomicMin(&pts[20], t_); atomicMax(&pts[21], t_); } } while (0)
#else
#define IMBREC(k) do { } while (0)
#endif
#define SEAM(k) do { IMBREC(k); if (IN(k) && IN((k) + 1)) xcd_barrier(xbar, F.wave == 0 && lane_id() == 0); STAMP((k) + 1); } while (0)
#ifdef PROBE
    unsigned long long* pts = (unsigned long long*)(ws + WS_CTL + 4096); F.pts = pts;
#define STAMP(k) do { if (blockIdx.x == 0 && F.wave == 0 && lane_id() == 0) pts[k] = __builtin_amdgcn_s_memrealtime(); } while (0)
#else
#define STAMP(k) do { } while (0)
#endif
    STAMP(0);
#if defined(PROBE) && (defined(PROBE_IMB) || defined(PROBE_IMBP))
    if (blockIdx.x == 0 && F.wave == 0 && lane_id() == 0) pts[20] = ~0ull;
#endif
    if (lo > hi) grid.sync();
    bf16* SZA = (bf16*)a.out; bf16* SZB = SZA + (size_t)T * 1024;

#ifndef SKIP_P0
    if (IN(0)) { RELANE(); p0_prologue(F, a); }
#endif
    SEAM(0);

    int K1024 = 1024, K256 = 256; asm volatile("" : "+s"(K1024), "+s"(K256));
    if (IN(1)) {
        pg8::Gemm g{(const bf16*)(ws + WS_XN), (const bf16*)(ws + WS_BT1), T, N1, K1024}; pg8::StaticOrder S; S.init(T, N1, F.G, (int)blockIdx.x);
#if defined(PROBE) && defined(PROBE_MODE1)
        { Epi1 E0{a.out, ws, a.in[5], a.in[6], a.in[17], PROBE_MODE1};
          pg8::gemm_phase<Epi1, pg8::StaticOrder, true, true>(F.lds, g, S, E0, F.wave * 64 + lane_id());
          xcd_barrier(xbar, F.wave == 0 && lane_id() == 0); STAMP(2); }
#define PROBE_SKIP_STAMP2 1
#endif
        Epi1 E{a.out, ws, a.in[5], a.in[6], a.in[17], 0};
#ifndef SKIP_G1
        pg8::gemm_phase<Epi1, pg8::StaticOrder, true, true>(F.lds, g, S, E, F.wave * 64 + lane_id());
#endif
        { const int nwg = (T / 256) * (N1 / 256), rounds = (nwg + F.G - 1) / F.G, first_short = nwg - (rounds - 1) * F.G;
          int nshort = F.G - first_short, w = (int)blockIdx.x - first_short;
          if (nshort == 0) { nshort = F.G; w = (int)blockIdx.x; }
          if (w >= 0) { RELANE(); p_to_bf16(F, a, w, nshort); tr_items(F, a, TR_EARLY, TR_ALL, w * NWAVES + F.wave, nshort * NWAVES); } }
    }
#if defined(PROBE) && defined(PROBE_MODE1)
    if (IN(1) && IN(2)) xcd_barrier(xbar, F.wave == 0 && lane_id() == 0);
#else
    SEAM(1);
#endif

    if (IN(2)) {
        int K128 = 128; asm volatile("" : "+s"(K128));
        { pg8::Gemm g{(const bf16*)(ws + WS_CQKV), (const bf16*)(ws + WS_BT2), T, 1536, K256}; pg8::StaticOrder S; S.init(T, 1536, F.G, (int)blockIdx.x);
          Epi2 E{ws, a.in[16], a.in[15], 0};
#ifndef SKIP_G2
          pg8::gemm_phase<Epi2, pg8::StaticOrder, true, true>(F.lds, g, S, E, F.wave * 64 + lane_id());
#endif
        }
        { pg8::Gemm g{(const bf16*)(ws + WS_CQKV) + (size_t)T * 256, (const bf16*)(ws + WS_BT2) + (size_t)1536 * 256, T, 2048, K128}; pg8::StaticOrder S; S.init(T, 2048, F.G, (int)blockIdx.x);
          Epi2 E{ws, a.in[16], a.in[15], 6};
#ifndef SKIP_G2
          pg8::gemm_phase<Epi2, pg8::StaticOrder, true, true>(F.lds, g, S, E, F.wave * 64 + lane_id());
#endif
        }
    } SEAM(2);

    if (IN(3)) {
#if !defined(SKIP_SWA) && (defined(PROBE_MLAV) || defined(PROBE_SWA))
        RELANE(); swa_phase(F, a);
#ifdef PROBE_SWA
        STAMP(8);
#endif
#endif
#ifndef SKIP_MLA
#ifdef MLA_SIMPLE
        RELANE(); mla_simple(F, a);
#else
#if defined(PROBE) && defined(PROBE_MLAV)
        __syncthreads(); STAMP(3);
        RELANE(); mla_probe_pass(F, a, (char*)lds);
        xcd_barrier(xbar, F.wave == 0 && lane_id() == 0); STAMP(4);
#endif
        RELANE(); mla_phase(F, a, (char*)lds);
#if !defined(SKIP_SWA) && !(defined(PROBE_MLAV) || defined(PROBE_SWA))
        RELANE(); swa_phase(F, a);
#endif
#if defined(PROBE) && defined(PROBE_IMB)
        if (F.wave == 0 && lane_id() == 0) { const unsigned long long t_ = __builtin_amdgcn_s_memrealtime(); atomicMin(&pts[20], t_); atomicMax(&pts[21], t_); }
#endif
#endif
#endif
    }
#if defined(PROBE) && defined(PROBE_MLAV)
    if (IN(3) && IN(4)) xcd_barrier(xbar, F.wave == 0 && lane_id() == 0);
#else
    SEAM(3);
#endif

    if (IN(4)) {
        int K2048 = 2048; asm volatile("" : "+s"(K2048));
        pg8::Gemm g{(const bf16*)(ws + WS_QA), (const bf16*)(ws + WS_BT3), T, 1024, K2048}; pg8::StaticOrder S; S.init(T, 1024, F.G, (int)blockIdx.x);
        Epi3c E{(bf16*)(ws + WS_MG), (const bf16*)(ws + WS_SGA), (const bf16*)(ws + WS_SGB)};
#ifndef SKIP_G3
        pg8::gemm_phase_cat<Epi3c, pg8::StaticOrder, true, true>(F.lds, g, S, E, F.wave * 64 + lane_id(), 1024, 16, (long)(WS_QBN - WS_QA));
#endif
    } SEAM(4);

    int p5mode = 0;
#if defined(PROBE) && defined(PROBE_MODE5)
    if (IN(5)) {
        p5mode = PROBE_MODE5;
        { pg8::Gemm g{(const bf16*)(ws + WS_MG), (const bf16*)(ws + WS_WOUT), T, 1024, K1024}; pg8::StaticOrder S; S.init(T, 1024, F.G, (int)blockIdx.x);
          Epi4 E{a.in[0], (float*)(ws + WS_X1F), (bf16*)(ws + WS_X1B), (float*)(ws + WS_SSX1), p5mode};
#ifdef PROBE_HALF
          if ((F.vcu & 1) == 0)
#endif
          pg8::gemm_phase<Epi4, pg8::StaticOrder, true, true>(F.lds, g, S, E, F.wave * 64 + lane_id()); }
        xcd_barrier(xbar, F.wave == 0 && lane_id() == 0); STAMP(6);
        p5mode = 0; asm volatile("" : "+s"(p5mode));
    }
#endif
    if (IN(5)) {
        for (int st = 0; st < 2; ++st) {
            if (((st ^ F.vcu) & 1) == 0) {
                pg8::Gemm g{(const bf16*)(ws + WS_MG), (const bf16*)(ws + WS_WOUT), T, 1024, K1024}; pg8::StaticOrder S; S.init(T, 1024, F.G, (int)blockIdx.x);
                Epi4 E{a.in[0], (float*)(ws + WS_X1F), (bf16*)(ws + WS_X1B), (float*)(ws + WS_SSX1), p5mode};
#ifndef SKIP_G4
                pg8::gemm_phase<Epi4, pg8::StaticOrder, true, true>(F.lds, g, S, E, F.wave * 64 + lane_id());
#endif
            } else {
                pg8::Gemm g{(const bf16*)(ws + WS_PB), (const bf16*)(ws + WS_WPP), T, 1024, K256}; pg8::StaticOrder S; S.init(T, 1024, F.G, (int)blockIdx.x);
                EpiE E{(bf16*)(ws + WS_ER), (float*)(ws + WS_SSE)};
#ifndef SKIP_GE
                pg8::gemm_phase<EpiE, pg8::StaticOrder, true, true>(F.lds, g, S, E, F.wave * 64 + lane_id());
#endif
            }
        }
    }
#if defined(PROBE) && defined(PROBE_MODE5)
    if (IN(5) && IN(6)) xcd_barrier(xbar, F.wave == 0 && lane_id() == 0);
#else
    SEAM(5);
#endif

    if (IN(6)) {
        pg8::Gemm g{(const bf16*)(ws + WS_X1B), (const bf16*)(ws + WS_WG), T, 1024, K1024}; pg8::StaticOrder S; S.init(T, 1024, F.G, (int)blockIdx.x);
        Epi5 E{a.out, (const bf16*)(ws + WS_X1B), (const bf16*)(ws + WS_ER), (const float*)(ws + WS_SSX1), (const float*)(ws + WS_SSE), a.in[23]};
#ifndef SKIP_G5
        pg8::gemm_phase<Epi5, pg8::StaticOrder, true, true>(F.lds, g, S, E, F.wave * 64 + lane_id());
#endif
    }
#ifdef PROBE
    xcd_barrier(xbar, F.wave == 0 && lane_id() == 0); STAMP(7);
    if (blockIdx.x == 0) {
        __syncthreads();
        volatile unsigned long long* vts = pts;
#ifdef PROBE_SWA
#ifdef PROBE_SWAONLY
        const float sw = (float)(vts[8] - vts[3]) * 0.01f;
#else
        const float sw = ((float)(vts[4] - vts[8]) * 0.01f - 600.0f) * 0.25f;
#endif
        if (F.wave == 0 && lane_id() == 0) a.out[0] += sw * PROBE_SCALE;
        if (0)
#endif
        {}
#if PROBE_A >= 10
        const float sa = (PROBE_A >= 31 && PROBE_A <= 35) ? (float)(vts[PROBE_A] - vts[PROBE_A - 1]) * 0.01f : (PROBE_A == 21) ? (float)(vts[21] - vts[20]) * 0.01f : (PROBE_A == 14) ? (float)(vts[14] - vts[4]) * 0.01f : (PROBE_A == 10) ? (float)(vts[10] - vts[0]) * 0.01f : (PROBE_A == 13) ? (float)(vts[1] - vts[12]) * 0.01f : (float)(vts[PROBE_A] - vts[PROBE_A - 1]) * 0.01f;
        const float sb = 0.f;
#else
        const float sa = (PROBE_A == 7) ? (float)(vts[7] - vts[0]) * 0.01f : (float)(vts[PROBE_A + 1] - vts[PROBE_A]) * 0.01f;
        const float sb = (PROBE_B == 7) ? (float)(vts[7] - vts[0]) * 0.01f : (float)(vts[PROBE_B + 1] - vts[PROBE_B]) * 0.01f;
#endif
        RELANE();
        (void)sb;
#ifndef PROBE_OFFSET
#define PROBE_OFFSET 0.0f
#endif
#ifndef PROBE_SWA
        if (F.tid == 0) a.out[0] += (sa - PROBE_OFFSET) * PROBE_SCALE;
#endif
    }
#endif
#undef IN
#undef SEAM
}

#ifndef MK_N_LAUNCHES
#define MK_N_LAUNCHES 1
#endif
extern "C" void kernel_launch(void* const* d_in, const int* in_sizes, int n_in, void* d_out, int out_size, void* d_ws, size_t ws_size, hipStream_t stream) {
    static int grid = 0;
    if (grid == 0) {
        if (n_in != 24 || in_sizes[0] != T * DM || out_size != T * DM || ws_size < WS_END) { fprintf(stderr, "kernel_launch: unexpected shapes / workspace (n_in %d, ws %zu)\n", n_in, ws_size); grid = -1; return; }
        int dev = 0, cus = 0, per_cu = 0;
        if (hipGetDevice(&dev) != hipSuccess || hipDeviceGetAttribute(&cus, hipDeviceAttributeMultiprocessorCount, dev) != hipSuccess) { grid = -1; return; }
        if (hipFuncSetAttribute((const void*)mk_fwd, hipFuncAttributeMaxDynamicSharedMemorySize, LDS_BYTES) != hipSuccess) { fprintf(stderr, "kernel_launch: hipFuncSetAttribute failed\n"); grid = -1; return; }
        if (hipOccupancyMaxActiveBlocksPerMultiprocessor(&per_cu, (const void*)mk_fwd, NTHR, LDS_BYTES) != hipSuccess || per_cu < 1) { fprintf(stderr, "kernel_launch: occupancy query says %d\n", per_cu); per_cu = 1; }
        (void)hipGetLastError();
        grid = cus;
    }
    if (grid < 0) return;
    Args a{};
    for (int i = 0; i < 24; ++i) a.in[i] = (const float*)d_in[i];
    a.out = (float*)d_out; a.ws = (unsigned char*)d_ws;
    if (hipMemsetAsync((char*)d_ws + WS_CTL, 0, 32768, stream) != hipSuccess) { fprintf(stderr, "kernel_launch: hipMemsetAsync failed\n"); return; }
#if MK_N_LAUNCHES == 1
    a.ph_lo = 0; a.ph_hi = NPHASE;
    void* args[] = {&a};
    hipError_t e = hipLaunchCooperativeKernel((const void*)mk_fwd, dim3(grid), dim3(NTHR), args, LDS_BYTES, stream);
    if (e != hipSuccess) fprintf(stderr, "kernel_launch: cooperative launch failed: %s (grid %d)\n", hipGetErrorString(e), grid);
#else
    for (int ph = 0; ph < NPHASE; ++ph) { a.ph_lo = ph; a.ph_hi = ph + 1; hipLaunchKernelGGL(mk_fwd, dim3(grid), dim3(NTHR), LDS_BYTES, stream, a); }
#endif
}
```

```cpp
#include <hip/hip_runtime.h>
#include <hip/hip_cooperative_groups.h>
#include <cstdio>
#include <cstdint>
namespace cg = cooperative_groups;
namespace pg8 {
#define PG8_LAS __attribute__((address_space(3)))
typedef unsigned short bf16_t;
typedef short bf16x8 __attribute__((ext_vector_type(8)));
typedef float f32x4 __attribute__((ext_vector_type(4)));
typedef unsigned u32x4 __attribute__((ext_vector_type(4)));
constexpr int BM = 256, BK = 64, HALF = 128, HTB = HALF * BK * 2  , STAGE_BYTES = 8 * HTB, NXCD = 8, WGM = 8;

__host__ __device__ __forceinline__ int lds_byte(int r, int c) { const int st = (r >> 4) * 2 + (c >> 5), rr = r & 15, cc = c & 31, ob = rr * 64 + cc * 2; return st * 1024 + (ob ^ (((ob >> 9) & 1) << 5)); }
__host__ __device__ __forceinline__ void stage_rc(int b, int& R, int& C) { const int st = b / 1024, sb = b % 1024, swz = sb ^ (((sb >> 9) & 1) << 5); R = (st >> 1) * 16 + swz / 64; C = (st & 1) * 32 + (swz % 64) / 2; }
__host__ __device__ __forceinline__ int perm32(int rho) { const int n = rho >> 4, i = rho & 15; return 8 * (i >> 2) + 4 * n + (i & 3); }

struct Unit { int pm, pn; };
struct Gemm { const bf16_t* A; const bf16_t* Bt; int M, N, K; };

struct StaticOrder {
    int nM, nN, nwg, G, c;
    __host__ __device__ void init(int M, int N, int G_, int c_) { nM = M / BM; nN = N / BM; nwg = nM * nN; G = G_; c = c_; }
    __host__ __device__ bool next(int i, Unit& u) const {
        const long L = (long)i * G + c; if (L >= nwg) return false;
        int wgid = (int)L; { const int q = nwg / NXCD, r = nwg % NXCD, xcd = wgid % NXCD, off = wgid / NXCD; wgid = (xcd < r ? xcd * (q + 1) : r * (q + 1) + (xcd - r) * q) + off; }
        const int nig = WGM * nN, gid = wgid / nig, fm = gid * WGM, gsz = (nM - fm) < WGM ? (nM - fm) : WGM;
        u.pm = fm + ((wgid % nig) % gsz); u.pn = (wgid % nig) / gsz; return true;
    }
    __device__ __forceinline__ void a_ready(const Unit&) const {}
    __device__ __forceinline__ void done(const Unit&) const {}
};

__device__ __forceinline__ unsigned cvt_pk_bf16(float lo, float hi) { unsigned r; asm volatile("v_cvt_pk_bf16_f32 %0, %1, %2" : "=v"(r) : "v"(lo), "v"(hi)); return r; }
typedef float f32x2 __attribute__((ext_vector_type(2)));
template <class Epi, class Sched, bool ALIGN_EPI = false, bool SP2 = false>
__device__ __forceinline__ void gemm_phase(PG8_LAS unsigned char* lds, const Gemm g, const Sched& S, const Epi& E, const int tid_in) {
    const int tid = tid_in, wid = __builtin_amdgcn_readfirstlane(tid >> 6), lane = tid & 63, wr = wid >> 2, wc = wid & 3, fr = lane & 15, fq = lane >> 4;
    const int K = g.K, nt = K / BK;
    unsigned voffA[2], voffB[2];
#pragma unroll
    for (int i = 0; i < 2; ++i) { int R, C; stage_rc(tid * 16 + i * 8192, R, C); const int Rb = Epi::PERM ? ((R & ~31) + perm32(R & 31)) : R;
        voffA[i] = (unsigned)(R * K + C) * 2u; voffB[i] = (unsigned)(Rb * K + C) * 2u; }
    const size_t kstep = (size_t)(BK * 2);
    const size_t hstep = (size_t)HALF * K * 2;
    const size_t tstep = 2 * hstep;
    const unsigned ldsw = (unsigned)wid * 1024u;
    const int aoff = lds_byte(wr * 64 + fr, fq * 8), boff = lds_byte(wc * 32 + fr, fq * 8);
#define PG8_SA(b, h) (((b) * 2 + (h)) * HTB)
#define PG8_SB(b, h) ((4 + (b) * 2 + (h)) * HTB)
#define PG8_STAGE(bufoff, gbase, voff) do { _Pragma("unroll") for (int _i = 0; _i < 2; ++_i) \
        __builtin_amdgcn_global_load_lds((const unsigned*)((const char*)(gbase) + (voff)[_i]), (PG8_LAS unsigned*)(lds + (bufoff) + ldsw + _i * 8192), 16, 0, 0); } while (0)
#define PG8_LDA(dst, b, h) do { _Pragma("unroll") for (int m = 0; m < 4; ++m) _Pragma("unroll") for (int k = 0; k < 2; ++k) dst[m][k] = *(const PG8_LAS bf16x8*)(lds + PG8_SA(b, h) + aoff + m * 2048 + k * 1024); } while (0)
#define PG8_LDB(dst, b, h) do { _Pragma("unroll") for (int n = 0; n < 2; ++n) _Pragma("unroll") for (int k = 0; k < 2; ++k) dst[n][k] = *(const PG8_LAS bf16x8*)(lds + PG8_SB(b, h) + boff + n * 2048 + k * 1024); } while (0)
#define PG8_MMA(ai, bj, At, Bt) do { __builtin_amdgcn_s_setprio(1); _Pragma("unroll") for (int m = 0; m < 4; ++m) _Pragma("unroll") for (int n = 0; n < 2; ++n) _Pragma("unroll") for (int k = 0; k < 2; ++k) \
        acc[ai][bj][m][n] = __builtin_amdgcn_mfma_f32_16x16x32_bf16(Bt[n][k], At[m][k], acc[ai][bj][m][n], 0, 0, 0); __builtin_amdgcn_s_setprio(0); } while (0)
#define PG8_WAIT_V(n) asm volatile("s_waitcnt vmcnt(" #n ")" ::: "memory")
#define PG8_WAIT_L(n) asm volatile("s_waitcnt lgkmcnt(" #n ")" ::: "memory")
#define PG8_BAR __builtin_amdgcn_s_barrier()
#define PG8_SCHED __builtin_amdgcn_sched_barrier(0)
    Unit cur, nxt; int ui = 0;
    if (!S.next(0, cur)) return;
    f32x4 acc[2][2][4][2];
#pragma unroll
    for (int a = 0; a < 2; ++a)
#pragma unroll
        for (int b = 0; b < 2; ++b)
#pragma unroll
            for (int m = 0; m < 4; ++m)
#pragma unroll
                for (int n = 0; n < 2; ++n) acc[a][b][m][n] = (f32x4){0.f, 0.f, 0.f, 0.f};
    bf16x8 At[4][2], B0[2][2], B1[2][2];
    const char* cA = (const char*)g.A + (size_t)cur.pm * tstep; const char* cB = (const char*)g.Bt + (size_t)cur.pn * tstep;
    S.a_ready(cur);
    if constexpr (SP2) {
        PG8_STAGE(PG8_SB(0, 0), cB, voffB); PG8_STAGE(PG8_SB(0, 1), cB + hstep, voffB); PG8_STAGE(PG8_SA(0, 0), cA, voffA); PG8_STAGE(PG8_SA(0, 1), cA + hstep, voffA);
        if (wr == 1) PG8_BAR;
        PG8_WAIT_V(2); PG8_BAR;
        PG8_STAGE(PG8_SB(1, 0), cB + kstep, voffB); PG8_STAGE(PG8_SA(1, 0), cA + kstep, voffA); PG8_STAGE(PG8_SB(1, 1), cB + hstep + kstep, voffB);
        PG8_WAIT_V(6); PG8_BAR;
    } else {
        PG8_STAGE(PG8_SB(0, 0), cB, voffB); PG8_STAGE(PG8_SA(0, 0), cA, voffA); PG8_STAGE(PG8_SB(0, 1), cB + hstep, voffB); PG8_STAGE(PG8_SA(0, 1), cA + hstep, voffA);
        if (wr == 1) PG8_BAR;
        PG8_WAIT_V(4); PG8_BAR;
        PG8_STAGE(PG8_SB(1, 0), cB + kstep, voffB); PG8_STAGE(PG8_SA(1, 0), cA + kstep, voffA); PG8_STAGE(PG8_SB(1, 1), cB + hstep + kstep, voffB);
        PG8_WAIT_V(6); PG8_BAR;
    }
    for (;;) {
        const bool has_next = S.next(ui + 1, nxt);
        const char* nA = has_next ? (const char*)g.A + (size_t)nxt.pm * tstep : cA; const char* nB = has_next ? (const char*)g.Bt + (size_t)nxt.pn * tstep : cB;
        for (int t = 0; t < nt; t += 2) {
            const bool last = (t == nt - 2);
            const char* a1 = cA + (size_t)(t + 1) * kstep;
            const char* a2 = last ? nA : cA + (size_t)(t + 2) * kstep; const char* b2 = last ? nB : cB + (size_t)(t + 2) * kstep;
            const char* a3 = a2 + kstep; const char* b3 = b2 + kstep;
            if (last && has_next) S.a_ready(nxt);
            if constexpr (SP2) {
            PG8_LDB(B0, 0, 0); PG8_LDB(B1, 0, 1); PG8_SCHED; PG8_LDA(At, 0, 0); PG8_STAGE(PG8_SA(1, 1), a1 + hstep, voffA);
            PG8_WAIT_V(8); PG8_WAIT_L(0); PG8_BAR; PG8_MMA(0, 0, At, B0); PG8_MMA(0, 1, At, B1); PG8_BAR; PG8_SCHED;
            PG8_LDA(At, 0, 1); PG8_STAGE(PG8_SB(0, 0), b2, voffB); PG8_STAGE(PG8_SB(0, 1), b2 + hstep, voffB); PG8_STAGE(PG8_SA(0, 0), a2, voffA);
            PG8_WAIT_V(8); PG8_WAIT_L(0); PG8_BAR; PG8_MMA(1, 0, At, B0); PG8_MMA(1, 1, At, B1); PG8_BAR; PG8_SCHED;
            PG8_LDB(B0, 1, 0); PG8_LDB(B1, 1, 1); PG8_SCHED; PG8_LDA(At, 1, 0); PG8_STAGE(PG8_SA(0, 1), a2 + hstep, voffA);
            PG8_WAIT_V(8); PG8_WAIT_L(0); PG8_BAR; PG8_MMA(0, 0, At, B0); PG8_MMA(0, 1, At, B1); PG8_BAR; PG8_SCHED;
            PG8_LDA(At, 1, 1); PG8_STAGE(PG8_SB(1, 0), b3, voffB); PG8_STAGE(PG8_SB(1, 1), b3 + hstep, voffB); PG8_STAGE(PG8_SA(1, 0), a3, voffA);
            PG8_WAIT_V(8); PG8_WAIT_L(0); PG8_BAR; PG8_MMA(1, 0, At, B0); PG8_MMA(1, 1, At, B1); PG8_BAR; PG8_SCHED;
            } else {
            PG8_LDB(B0, 0, 0); PG8_SCHED; PG8_LDA(At, 0, 0); PG8_STAGE(PG8_SA(1, 1), a1 + hstep, voffA);
            PG8_WAIT_L(8); PG8_BAR; PG8_WAIT_L(0); PG8_MMA(0, 0, At, B0); PG8_BAR; PG8_SCHED;
            PG8_LDB(B1, 0, 1); PG8_STAGE(PG8_SB(0, 0), b2, voffB);
            PG8_BAR; PG8_WAIT_L(0); PG8_MMA(0, 1, At, B1); PG8_BAR;
            PG8_LDA(At, 0, 1); PG8_STAGE(PG8_SA(0, 0), a2, voffA);
            PG8_BAR; PG8_WAIT_L(0); PG8_MMA(1, 0, At, B0); PG8_BAR; PG8_SCHED;
            PG8_STAGE(PG8_SB(0, 1), b2 + hstep, voffB);
            PG8_WAIT_V(6); PG8_BAR; PG8_MMA(1, 1, At, B1); PG8_BAR;
            PG8_LDB(B0, 1, 0); PG8_SCHED; PG8_LDA(At, 1, 0); PG8_STAGE(PG8_SA(0, 1), a2 + hstep, voffA);
            PG8_WAIT_L(8); PG8_BAR; PG8_WAIT_L(0); PG8_MMA(0, 0, At, B0); PG8_BAR; PG8_SCHED;
            PG8_LDB(B1, 1, 1); PG8_STAGE(PG8_SB(1, 0), b3, voffB);
            PG8_BAR; PG8_WAIT_L(0); PG8_MMA(0, 1, At, B1); PG8_BAR;
            PG8_LDA(At, 1, 1); PG8_STAGE(PG8_SA(1, 0), a3, voffA);
            PG8_BAR; PG8_WAIT_L(0); PG8_MMA(1, 0, At, B0); PG8_BAR; PG8_SCHED;
            PG8_STAGE(PG8_SB(1, 1), b3 + hstep, voffB);
            PG8_WAIT_V(6); PG8_BAR; PG8_MMA(1, 1, At, B1); PG8_BAR;
            }
        }
        if constexpr (ALIGN_EPI) { if (wr == 0) PG8_BAR; }
        if constexpr (!Epi::AFTER_DRAIN) { E(acc, cur, wr, wc, fr, fq); S.done(cur); }
        if (!has_next) break;
#pragma unroll
        for (int a = 0; a < 2; ++a)
#pragma unroll
            for (int b = 0; b < 2; ++b)
#pragma unroll
                for (int m = 0; m < 4; ++m)
#pragma unroll
                    for (int n = 0; n < 2; ++n) acc[a][b][m][n] = (f32x4){0.f, 0.f, 0.f, 0.f};
        cur = nxt; cA = nA; cB = nB; ++ui;
        if constexpr (ALIGN_EPI) { if (wr == 1) PG8_BAR; }
    }
    PG8_WAIT_V(0);
    if constexpr (!ALIGN_EPI) { if (wr == 0) PG8_BAR; }
    PG8_BAR;
    if constexpr (Epi::AFTER_DRAIN) { E.fused(acc, cur, wr, wc, fr, fq, lds, wid, lane); S.done(cur); }
#undef PG8_SA
#undef PG8_SB
#undef PG8_STAGE
#undef PG8_LDA
#undef PG8_LDB
#undef PG8_MMA
#undef PG8_WAIT_V
#undef PG8_WAIT_L
#undef PG8_BAR
#undef PG8_SCHED
}
}
namespace pg8 {
template <class Epi, class Sched, bool ALIGN_EPI = false, bool SP2 = false>
__device__ __forceinline__ void gemm_phase_cat(PG8_LAS unsigned char* lds, const Gemm g, const Sched& S, const Epi& E, const int tid_in, const int lda, const int KH, const long dA) {
    const int tid = tid_in, wid = __builtin_amdgcn_readfirstlane(tid >> 6), lane = tid & 63, wr = wid >> 2, wc = wid & 3, fr = lane & 15, fq = lane >> 4;
    const int K = g.K, nt = K / BK;
    unsigned voffA[2], voffB[2];
#pragma unroll
    for (int i = 0; i < 2; ++i) { int R, C; stage_rc(tid * 16 + i * 8192, R, C); const int Rb = Epi::PERM ? ((R & ~31) + perm32(R & 31)) : R;
        voffA[i] = (unsigned)(R * lda + C) * 2u; voffB[i] = (unsigned)(Rb * K + C) * 2u; }
    const size_t kstep = (size_t)(BK * 2);
    const size_t hstep = (size_t)HALF * K * 2, tstep = 2 * hstep;
    const size_t hstepA = (size_t)HALF * lda * 2, tstepA = 2 * hstepA;
    const size_t dsplit = (size_t)dA - (size_t)KH * kstep;
#define PG8_APT(base, kt) ((base) + (size_t)(kt) * kstep + ((kt) >= KH ? dsplit : (size_t)0))
    const unsigned ldsw = (unsigned)wid * 1024u;
    const int aoff = lds_byte(wr * 64 + fr, fq * 8), boff = lds_byte(wc * 32 + fr, fq * 8);
#define PG8_SA(b, h) (((b) * 2 + (h)) * HTB)
#define PG8_SB(b, h) ((4 + (b) * 2 + (h)) * HTB)
#define PG8_STAGE(bufoff, gbase, voff) do { _Pragma("unroll") for (int _i = 0; _i < 2; ++_i) \
        __builtin_amdgcn_global_load_lds((const unsigned*)((const char*)(gbase) + (voff)[_i]), (PG8_LAS unsigned*)(lds + (bufoff) + ldsw + _i * 8192), 16, 0, 0); } while (0)
#define PG8_LDA(dst, b, h) do { _Pragma("unroll") for (int m = 0; m < 4; ++m) _Pragma("unroll") for (int k = 0; k < 2; ++k) dst[m][k] = *(const PG8_LAS bf16x8*)(lds + PG8_SA(b, h) + aoff + m * 2048 + k * 1024); } while (0)
#define PG8_LDB(dst, b, h) do { _Pragma("unroll") for (int n = 0; n < 2; ++n) _Pragma("unroll") for (int k = 0; k < 2; ++k) dst[n][k] = *(const PG8_LAS bf16x8*)(lds + PG8_SB(b, h) + boff + n * 2048 + k * 1024); } while (0)
#define PG8_MMA(ai, bj, At, Bt) do { __builtin_amdgcn_s_setprio(1); _Pragma("unroll") for (int m = 0; m < 4; ++m) _Pragma("unroll") for (int n = 0; n < 2; ++n) _Pragma("unroll") for (int k = 0; k < 2; ++k) \
        acc[ai][bj][m][n] = __builtin_amdgcn_mfma_f32_16x16x32_bf16(Bt[n][k], At[m][k], acc[ai][bj][m][n], 0, 0, 0); __builtin_amdgcn_s_setprio(0); } while (0)
#define PG8_WAIT_V(n) asm volatile("s_waitcnt vmcnt(" #n ")" ::: "memory")
#define PG8_WAIT_L(n) asm volatile("s_waitcnt lgkmcnt(" #n ")" ::: "memory")
#define PG8_BAR __builtin_amdgcn_s_barrier()
#define PG8_SCHED __builtin_amdgcn_sched_barrier(0)
    Unit cur, nxt; int ui = 0;
    if (!S.next(0, cur)) return;
    f32x4 acc[2][2][4][2];
#pragma unroll
    for (int a = 0; a < 2; ++a)
#pragma unroll
        for (int b = 0; b < 2; ++b)
#pragma unroll
            for (int m = 0; m < 4; ++m)
#pragma unroll
                for (int n = 0; n < 2; ++n) acc[a][b][m][n] = (f32x4){0.f, 0.f, 0.f, 0.f};
    bf16x8 At[4][2], B0[2][2], B1[2][2];
    const char* cA = (const char*)g.A + (size_t)cur.pm * tstepA; const char* cB = (const char*)g.Bt + (size_t)cur.pn * tstep;
    S.a_ready(cur);
    if constexpr (SP2) {
        PG8_STAGE(PG8_SB(0, 0), cB, voffB); PG8_STAGE(PG8_SB(0, 1), cB + hstep, voffB); PG8_STAGE(PG8_SA(0, 0), cA, voffA); PG8_STAGE(PG8_SA(0, 1), cA + hstepA, voffA);
        if (wr == 1) PG8_BAR;
        PG8_WAIT_V(2); PG8_BAR;
        PG8_STAGE(PG8_SB(1, 0), cB + kstep, voffB); PG8_STAGE(PG8_SA(1, 0), cA + kstep, voffA); PG8_STAGE(PG8_SB(1, 1), cB + hstep + kstep, voffB);
        PG8_WAIT_V(6); PG8_BAR;
    } else {
        PG8_STAGE(PG8_SB(0, 0), cB, voffB); PG8_STAGE(PG8_SA(0, 0), cA, voffA); PG8_STAGE(PG8_SB(0, 1), cB + hstep, voffB); PG8_STAGE(PG8_SA(0, 1), cA + hstepA, voffA);
        if (wr == 1) PG8_BAR;
        PG8_WAIT_V(4); PG8_BAR;
        PG8_STAGE(PG8_SB(1, 0), cB + kstep, voffB); PG8_STAGE(PG8_SA(1, 0), cA + kstep, voffA); PG8_STAGE(PG8_SB(1, 1), cB + hstep + kstep, voffB);
        PG8_WAIT_V(6); PG8_BAR;
    }
    for (;;) {
        const bool has_next = S.next(ui + 1, nxt);
        const char* nA = has_next ? (const char*)g.A + (size_t)nxt.pm * tstepA : cA; const char* nB = has_next ? (const char*)g.Bt + (size_t)nxt.pn * tstep : cB;
        for (int t = 0; t < nt; t += 2) {
            const bool last = (t == nt - 2);
            if (t == KH) E.mid(acc, cur, wr, wc);
            const char* a1 = PG8_APT(cA, t + 1);
            const char* a2 = last ? nA : PG8_APT(cA, t + 2); const char* b2 = last ? nB : cB + (size_t)(t + 2) * kstep;
            const char* a3 = last ? nA + kstep : PG8_APT(cA, t + 3); const char* b3 = b2 + kstep;
            if (last && has_next) S.a_ready(nxt);
            if constexpr (SP2) {
            PG8_LDB(B0, 0, 0); PG8_LDB(B1, 0, 1); PG8_SCHED; PG8_LDA(At, 0, 0); PG8_STAGE(PG8_SA(1, 1), a1 + hstepA, voffA);
            PG8_WAIT_V(8); PG8_WAIT_L(0); PG8_BAR; PG8_MMA(0, 0, At, B0); PG8_MMA(0, 1, At, B1); PG8_BAR; PG8_SCHED;
            PG8_LDA(At, 0, 1); PG8_STAGE(PG8_SB(0, 0), b2, voffB); PG8_STAGE(PG8_SB(0, 1), b2 + hstep, voffB); PG8_STAGE(PG8_SA(0, 0), a2, voffA);
            PG8_WAIT_V(8); PG8_WAIT_L(0); PG8_BAR; PG8_MMA(1, 0, At, B0); PG8_MMA(1, 1, At, B1); PG8_BAR; PG8_SCHED;
            PG8_LDB(B0, 1, 0); PG8_LDB(B1, 1, 1); PG8_SCHED; PG8_LDA(At, 1, 0); PG8_STAGE(PG8_SA(0, 1), a2 + hstepA, voffA);
            PG8_WAIT_V(8); PG8_WAIT_L(0); PG8_BAR; PG8_MMA(0, 0, At, B0); PG8_MMA(0, 1, At, B1); PG8_BAR; PG8_SCHED;
            PG8_LDA(At, 1, 1); PG8_STAGE(PG8_SB(1, 0), b3, voffB); PG8_STAGE(PG8_SB(1, 1), b3 + hstep, voffB); PG8_STAGE(PG8_SA(1, 0), a3, voffA);
            PG8_WAIT_V(8); PG8_WAIT_L(0); PG8_BAR; PG8_MMA(1, 0, At, B0); PG8_MMA(1, 1, At, B1); PG8_BAR; PG8_SCHED;
            } else {
            PG8_LDB(B0, 0, 0); PG8_SCHED; PG8_LDA(At, 0, 0); PG8_STAGE(PG8_SA(1, 1), a1 + hstepA, voffA);
            PG8_WAIT_L(8); PG8_BAR; PG8_WAIT_L(0); PG8_MMA(0, 0, At, B0); PG8_BAR; PG8_SCHED;
            PG8_LDB(B1, 0, 1); PG8_STAGE(PG8_SB(0, 0), b2, voffB);
            PG8_BAR; PG8_WAIT_L(0); PG8_MMA(0, 1, At, B1); PG8_BAR;
            PG8_LDA(At, 0, 1); PG8_STAGE(PG8_SA(0, 0), a2, voffA);
            PG8_BAR; PG8_WAIT_L(0); PG8_MMA(1, 0, At, B0); PG8_BAR; PG8_SCHED;
            PG8_STAGE(PG8_SB(0, 1), b2 + hstep, voffB);
            PG8_WAIT_V(6); PG8_BAR; PG8_MMA(1, 1, At, B1); PG8_BAR;
            PG8_LDB(B0, 1, 0); PG8_SCHED; PG8_LDA(At, 1, 0); PG8_STAGE(PG8_SA(0, 1), a2 + hstepA, voffA);
            PG8_WAIT_L(8); PG8_BAR; PG8_WAIT_L(0); PG8_MMA(0, 0, At, B0); PG8_BAR; PG8_SCHED;
            PG8_LDB(B1, 1, 1); PG8_STAGE(PG8_SB(1, 0), b3, voffB);
            PG8_BAR; PG8_WAIT_L(0); PG8_MMA(0, 1, At, B1); PG8_BAR;
            PG8_LDA(At, 1, 1); PG8_STAGE(PG8_SA(1, 0), a3, voffA);
            PG8_BAR; PG8_WAIT_L(0); PG8_MMA(1, 0, At, B0); PG8_BAR; PG8_SCHED;
            PG8_STAGE(PG8_SB(1, 1), b3 + hstep, voffB);
            PG8_WAIT_V(6); PG8_BAR; PG8_MMA(1, 1, At, B1); PG8_BAR;
            }
        }
        if constexpr (ALIGN_EPI) { if (wr == 0) PG8_BAR; }
        if constexpr (!Epi::AFTER_DRAIN) { E(acc, cur, wr, wc, fr, fq); S.done(cur); }
        if (!has_next) break;
#pragma unroll
        for (int a = 0; a < 2; ++a)
#pragma unroll
            for (int b = 0; b < 2; ++b)
#pragma unroll
                for (int m = 0; m < 4; ++m)
#pragma unroll
                    for (int n = 0; n < 2; ++n) acc[a][b][m][n] = (f32x4){0.f, 0.f, 0.f, 0.f};
        cur = nxt; cA = nA; cB = nB; ++ui;
        if constexpr (ALIGN_EPI) { if (wr == 1) PG8_BAR; }
    }
    PG8_WAIT_V(0);
    if constexpr (!ALIGN_EPI) { if (wr == 0) PG8_BAR; }
    PG8_BAR;
    if constexpr (Epi::AFTER_DRAIN) { E.fused(acc, cur, wr, wc, fr, fq, lds, wid, lane); S.done(cur); }
#undef PG8_APT
#undef PG8_SA
#undef PG8_SB
#undef PG8_STAGE
#undef PG8_LDA
#undef PG8_LDB
#undef PG8_MMA
#undef PG8_WAIT_V
#undef PG8_WAIT_L
#undef PG8_BAR
#undef PG8_SCHED
}
}

#define GAS __attribute__((address_space(1)))
#define LAS __attribute__((address_space(3)))
typedef unsigned short bf16;
typedef unsigned u32x4 __attribute__((ext_vector_type(4)));
typedef unsigned u32x2 __attribute__((ext_vector_type(2)));
typedef float f32x4 __attribute__((ext_vector_type(4)));
typedef float f32x2 __attribute__((ext_vector_type(2)));
using pg8::cvt_pk_bf16;

constexpr int NWAVES = 8, NTHR = 512;
constexpr int T = 32768, SEQ = 8192, NB = 4, DM = 1024;
constexpr int DIN = 5792, N1 = 5888;
constexpr float EPS = 1e-6f, LOG2E = 1.4426950408889634f;
constexpr float QA_SCALE = 0.125f * LOG2E;
constexpr float QB_SCALE = 0.10206207261596575f * LOG2E;

constexpr size_t MiB = 1u << 20;
constexpr size_t WS_CTL = 0, WS_BT = 64 * 1024;
constexpr size_t WS_SSCQ = 1 * MiB, WS_SSCKV = 1 * MiB + 512 * 1024;
constexpr size_t WS_KR = 2 * MiB, WS_ROPE = 4 * MiB;
constexpr size_t WS_BT1 = 8 * MiB, WS_BT3 = 20 * MiB, WS_WOUT = 24 * MiB, WS_WG = 26 * MiB, WS_BT2 = 28 * MiB, WS_WPP = 30 * MiB;
constexpr size_t WS_XN = 32 * MiB;
constexpr size_t WS_QA = 96 * MiB;
constexpr size_t WS_KVA = 160 * MiB;
constexpr size_t WS_CQKV = 176 * MiB;
constexpr size_t WS_SGA = 208 * MiB, WS_SGB = 272 * MiB;
constexpr size_t WS_QBN = 336 * MiB;
constexpr size_t WS_QBR = 400 * MiB;
constexpr size_t WS_KN = 432 * MiB;
constexpr size_t WS_SSQ = 200 * MiB;
constexpr size_t WS_RS = 204 * MiB;
constexpr size_t WS_PBX = 496 * MiB;
constexpr size_t WS_END = 512 * MiB;
constexpr size_t WS_VB = WS_XN, WS_X1B = WS_XN, WS_ER = WS_QA, WS_PB = WS_PBX, WS_SSX1 = WS_CQKV, WS_SSE = WS_CQKV + 2 * MiB, WS_MG = WS_KN, WS_X1F = WS_SGA  ;

constexpr int RING_BYTES = 131072, LDS_BYTES = 147456;

#ifndef NT_ST8
#define NT_ST8 0
#endif
#ifndef NT_SG
#define NT_SG 0
#endif
#ifndef NT_X1ER
#define NT_X1ER 0
#endif
#ifndef NT_X1B
#define NT_X1B 0
#endif
#ifndef NT_PLD
#define NT_PLD 1
#endif
#ifndef NT_PST
#define NT_PST 0
#endif
#ifndef NT_ATTZ
#define NT_ATTZ 1
#endif
#ifndef NT_ATTO
#define NT_ATTO 1
#endif
#ifndef NT_WLD
#define NT_WLD 1
#endif
template <bool NT, class V> __device__ __forceinline__ V ld_hint(const V* p) { if constexpr (NT) return __builtin_nontemporal_load(p); else return *p; }
template <bool NT, class V> __device__ __forceinline__ void st_hint(V v, V* p) { if constexpr (NT) __builtin_nontemporal_store(v, p); else *p = v; }
#define LDS_WAIT() asm volatile("s_waitcnt lgkmcnt(0)" ::: "memory")
__device__ __forceinline__ unsigned f2bf(float f) { unsigned u = __builtin_bit_cast(unsigned, f); return (u + 0x7fffu + ((u >> 16) & 1u)) >> 16; }
__device__ __forceinline__ unsigned pk2(float lo, float hi) { return f2bf(lo) | (f2bf(hi) << 16); }
__device__ __forceinline__ float bf2f(unsigned short b) { return __builtin_bit_cast(float, (unsigned)b << 16); }
__device__ __forceinline__ float bflo(unsigned w) { return __builtin_bit_cast(float, w << 16); }
__device__ __forceinline__ float bfhi(unsigned w) { return __builtin_bit_cast(float, w & 0xffff0000u); }
__device__ __forceinline__ float sigmoidf_(float v) { return __builtin_amdgcn_rcpf(1.0f + __builtin_amdgcn_exp2f(-v * LOG2E)); }
__device__ __forceinline__ void st8(bf16* p, f32x4 a, f32x4 b) { u32x4 w; w.x = cvt_pk_bf16(a[0], a[1]); w.y = cvt_pk_bf16(a[2], a[3]); w.z = cvt_pk_bf16(b[0], b[1]); w.w = cvt_pk_bf16(b[2], b[3]);
#if defined(ST8_SC1) && ST8_SC1
    asm volatile("global_store_dwordx4 %0, %1, off sc1\n\ts_nop 1" :: "v"(p), "v"(w) : "memory");
#else
    st_hint<NT_ST8 != 0>(w, (u32x4*)p);
#endif
}
__device__ __forceinline__ float sumsq4(f32x4 a) { return (a[0] * a[0] + a[1] * a[1]) + (a[2] * a[2] + a[3] * a[3]); }
__device__ __forceinline__ float red_fq(float s) { s += __shfl_xor(s, 16); s += __shfl_xor(s, 32); return s; }

__device__ __forceinline__ int lane_id() { int l; asm volatile("v_mbcnt_lo_u32_b32 %0, -1, 0\n\tv_mbcnt_hi_u32_b32 %0, -1, %0" : "=v"(l)); return l; }

struct Args { const float* in[24]; float* out; unsigned char* ws; int ph_lo, ph_hi; };

struct Frame {
    LAS unsigned char* lds;
    int tid, lane, wave, vcu, G;
#ifdef PROBE
    unsigned long long* pts;
#endif
};
#ifdef PROBE
#define FSTAMP(F, k) do { if (blockIdx.x == 0 && (F).wave == 0 && lane_id() == 0) (F).pts[k] = __builtin_amdgcn_s_memrealtime(); } while (0)
#else
#define FSTAMP(F, k) do { } while (0)
#endif

struct Order2 {
    pg8::StaticOrder so;
    __device__ bool next(int i, pg8::Unit& u) const { if (!so.next(i, u)) return false; if (u.pn >= 6) u.pm += 128; return true; }
    __device__ __forceinline__ void a_ready(const pg8::Unit&) const {}
    __device__ __forceinline__ void done(const pg8::Unit&) const {}
};
typedef const pg8::f32x4 (&AccRef)[2][2][4][2];


__device__ __forceinline__ float acc_ss(AccRef acc, int ai, int m) { return (sumsq4(acc[ai][0][m][0]) + sumsq4(acc[ai][0][m][1])) + (sumsq4(acc[ai][1][m][0]) + sumsq4(acc[ai][1][m][1])); }
__device__ __forceinline__ void epi_raw(AccRef acc, bf16* base, int ld, int row0, int lc0) {
#pragma unroll
    for (int ai = 0; ai < 2; ++ai)
#pragma unroll
        for (int m = 0; m < 4; ++m) { bf16* dst = base + (size_t)(row0 + ai * 128 + m * 16) * ld + lc0;
#pragma unroll
            for (int bj = 0; bj < 2; ++bj) st8(dst + 32 * bj, acc[ai][bj][m][0], acc[ai][bj][m][1]); }
}
__device__ __forceinline__ void epi_raw_ss(AccRef acc, bf16* base, int ld, int row0, int lc0, float* ssp, int nss, int idx, int fq) {
#pragma unroll
    for (int ai = 0; ai < 2; ++ai)
#pragma unroll
        for (int m = 0; m < 4; ++m) { const int row = row0 + ai * 128 + m * 16; const float ss = red_fq(acc_ss(acc, ai, m));
            if (fq == 0) ssp[(size_t)row * nss + idx] = ss;
            bf16* dst = base + (size_t)row * ld + lc0;
#pragma unroll
            for (int bj = 0; bj < 2; ++bj) st8(dst + 32 * bj, acc[ai][bj][m][0], acc[ai][bj][m][1]); }
}
__device__ __forceinline__ void epi_headnorm(AccRef acc, bf16* base, int ld, int row0, int lc0, const float* g, float sc, int fq) {
    f32x4 gv[2][2];
#pragma unroll
    for (int bj = 0; bj < 2; ++bj)
#pragma unroll
        for (int n = 0; n < 2; ++n) gv[bj][n] = *(const f32x4*)(g + 32 * bj + 8 * fq + 4 * n) * sc;
#pragma unroll
    for (int ai = 0; ai < 2; ++ai)
#pragma unroll
        for (int m = 0; m < 4; ++m) { const int row = row0 + ai * 128 + m * 16; const float r = rsqrtf(red_fq(acc_ss(acc, ai, m)) * (1.0f / 64.0f) + EPS);
            bf16* dst = base + (size_t)row * ld + lc0;
#pragma unroll
            for (int bj = 0; bj < 2; ++bj) st8(dst + 32 * bj, acc[ai][bj][m][0] * gv[bj][0] * r, acc[ai][bj][m][1] * gv[bj][1] * r); }
}
template <bool SILU> __device__ __forceinline__ void epi_act(AccRef acc, bf16* base, int row0, int lc0) {
#pragma unroll
    for (int ai = 0; ai < 2; ++ai)
#pragma unroll
        for (int m = 0; m < 4; ++m) { bf16* dst = base + (size_t)(row0 + ai * 128 + m * 16) * 1024 + lc0;
#pragma unroll
            for (int bj = 0; bj < 2; ++bj) { f32x4 v0 = acc[ai][bj][m][0], v1 = acc[ai][bj][m][1], o0, o1;
#pragma unroll
                for (int e = 0; e < 4; ++e) { const float s0 = sigmoidf_(v0[e]), s1 = sigmoidf_(v1[e]); o0[e] = SILU ? v0[e] * s0 : s0; o1[e] = SILU ? v1[e] * s1 : s1; }
                st8(dst + 32 * bj, o0, o1); } }
}

struct Epi1 {
    static constexpr bool PERM = true, AFTER_DRAIN = false;
    float* out; unsigned char* ws; const float *gq, *gk, *gkr; int mode;
    __device__ __forceinline__ void operator()(AccRef acc, const pg8::Unit& u, int wr, int wc, int, int) const {
        int ln_ = lane_id(); asm volatile("" : "+v"(ln_)); const int fr = ln_ & 15, fq = ln_ >> 4;
        const int row0 = u.pm * 256 + wr * 64 + fr, pn = u.pn, lc0 = 64 * wc + 8 * fq;
#ifdef PROBE
        if (mode == 1) { pg8::f32x4 t = acc[0][0][0][0];
#pragma unroll
            for (int i_ = 1; i_ < 32; ++i_) t += acc[i_ >> 4][(i_ >> 3) & 1][(i_ >> 1) & 3][i_ & 1];
            asm volatile("" :: "v"(t)); return; }
        if (mode == 2) { epi_raw(acc, (bf16*)(ws + WS_SGA) + (pn & 3) * 256, 1024, row0, lc0); return; }
#endif
        if (pn < 4) {
            epi_headnorm(acc, (bf16*)(ws + WS_QA) + pn * 256, 1024, row0, lc0, gq, QA_SCALE, fq);
        } else if (pn == 4) {
            if (wc < 2) epi_headnorm(acc, (bf16*)(ws + WS_KVA), 256, row0, lc0, gk, 1.0f, fq);
            else epi_raw(acc, (bf16*)(ws + WS_KVA), 256, row0, lc0);
        } else if (pn <= 8) {
            epi_act<true>(acc, (bf16*)out + (pn - 5) * 256, row0, lc0);
        } else if (pn == 9) {
            epi_raw_ss(acc, (bf16*)(ws + WS_CQKV), 256, row0, lc0, (float*)(ws + WS_SSCQ), 4, wc, fq);
        } else if (pn == 10) {
            if (wc < 2) epi_raw_ss(acc, (bf16*)(ws + WS_CQKV) + (size_t)T * 256, 128, row0, lc0, (float*)(ws + WS_SSCKV), 2, wc, fq);
            else if (wc == 2) {
                f32x4 gv[2];
#pragma unroll
                for (int n = 0; n < 2; ++n) gv[n] = *(const f32x4*)(gkr + 8 * fq + 4 * n);
                const float* rope = (const float*)(ws + WS_ROPE); bf16* KR = (bf16*)(ws + WS_KR);
#pragma unroll
                for (int ai = 0; ai < 2; ++ai)
#pragma unroll
                    for (int m = 0; m < 4; ++m) {
                        const int row = row0 + ai * 128 + m * 16;
                        const float ss = red_fq(sumsq4(acc[ai][0][m][0]) + sumsq4(acc[ai][0][m][1]));
                        const float r = rsqrtf(ss * (1.0f / 32.0f) + EPS);
                        const f32x4 a0 = acc[ai][0][m][0] * gv[0] * r, a1 = acc[ai][0][m][1] * gv[1] * r;
                        f32x4 p0, p1;
#pragma unroll
                        for (int e = 0; e < 4; ++e) { p0[e] = __shfl_xor(a0[e], 32); p1[e] = __shfl_xor(a1[e], 32); }
                        const float* rp = rope + (size_t)row * 32 + 8 * (fq & 1);
                        const f32x4 c0 = *(const f32x4*)(rp), c1 = *(const f32x4*)(rp + 4), s0 = *(const f32x4*)(rp + 16), s1 = *(const f32x4*)(rp + 20);
                        const float sg = fq < 2 ? -1.0f : 1.0f;
                        st8(KR + (size_t)row * 32 + 8 * fq, a0 * c0 + p0 * s0 * sg, a1 * c1 + p1 * s1 * sg);
                        asm volatile("" ::: "memory");
                    }
            }
        } else if (pn <= 14) {
            epi_act<true>(acc, (bf16*)out + (size_t)T * 1024 + (pn - 11) * 256, row0, lc0);
        } else {
            bf16* RA = (bf16*)(ws + WS_SGA); bf16* SB = (bf16*)(ws + WS_SGB); const int c0 = 128 * (pn - 15) + 32 * wc + 8 * fq;
#pragma unroll
            for (int ai = 0; ai < 2; ++ai)
#pragma unroll
                for (int m = 0; m < 4; ++m) { const size_t off = (size_t)(row0 + ai * 128 + m * 16) * 1024 + c0;
                    f32x4 r0, r1, b0, b1;
#pragma unroll
                    for (int e = 0; e < 4; ++e) {
                        const float ea0 = __builtin_amdgcn_exp2f(-acc[ai][0][m][0][e] * LOG2E), ea1 = __builtin_amdgcn_exp2f(-acc[ai][0][m][1][e] * LOG2E);
                        const float eb0 = __builtin_amdgcn_exp2f(-acc[ai][1][m][0][e] * LOG2E), eb1 = __builtin_amdgcn_exp2f(-acc[ai][1][m][1][e] * LOG2E);
                        b0[e] = fmaxf(__builtin_amdgcn_rcpf(1.0f + eb0), 1e-30f); b1[e] = fmaxf(__builtin_amdgcn_rcpf(1.0f + eb1), 1e-30f);
                        r0[e] = __builtin_amdgcn_rcpf((1.0f + ea0) * b0[e]); r1[e] = __builtin_amdgcn_rcpf((1.0f + ea1) * b1[e]); }
                    st8(RA + off, r0, r1); st8(SB + off, b0, b1); }
        }
    }
};
static_assert(WS_SGB == WS_SGA + (size_t)T * 1024 * 2, "SGA and SGB adjacent");

struct Epi2 {
    static constexpr bool PERM = true, AFTER_DRAIN = false;
    unsigned char* ws; const float* gkn; const float* gqn; int pn_off;
    __device__ __forceinline__ void operator()(AccRef acc, const pg8::Unit& u, int wr, int wc, int, int) const {
        int ln_ = lane_id(); asm volatile("" : "+v"(ln_)); const int fr = ln_ & 15, fq = ln_ >> 4;
        const int row0 = u.pm * 256 + wr * 64 + fr, pn = u.pn + pn_off, lc0 = 64 * wc + 8 * fq;
        if (pn < 4) epi_raw_ss(acc, (bf16*)(ws + WS_QBN) + pn * 256, 1024, row0, lc0, (float*)(ws + WS_SSQ), 32, 4 * pn + wc, fq);
        else if (pn < 6) {
            bf16* base = (bf16*)(ws + WS_QBR) + (pn - 4) * 256; float* SSQ = (float*)(ws + WS_SSQ); const float* rope = (const float*)(ws + WS_ROPE);
            f32x4 gr[2];
#pragma unroll
            for (int n = 0; n < 2; ++n) gr[n] = *(const f32x4*)(gqn + 64 + 8 * fq + 4 * n);
#pragma unroll
            for (int ai = 0; ai < 2; ++ai)
#pragma unroll
                for (int m = 0; m < 4; ++m) { const int row = row0 + ai * 128 + m * 16;
                    const float s0 = red_fq(sumsq4(acc[ai][0][m][0]) + sumsq4(acc[ai][0][m][1])), s1 = red_fq(sumsq4(acc[ai][1][m][0]) + sumsq4(acc[ai][1][m][1]));
                    if (fq == 0) *(f32x2*)(SSQ + (size_t)row * 32 + 16 + 8 * (pn - 4) + 2 * wc) = (f32x2){s0, s1};
                    const float* rp = rope + (size_t)row * 32 + 8 * (fq & 1);
                    const f32x4 c0 = *(const f32x4*)(rp), c1 = *(const f32x4*)(rp + 4), sn0 = *(const f32x4*)(rp + 16), sn1 = *(const f32x4*)(rp + 20);
                    const float sg = fq < 2 ? -1.0f : 1.0f;
                    bf16* dst = base + (size_t)row * 512 + lc0;
#pragma unroll
                    for (int bj = 0; bj < 2; ++bj) { const f32x4 a0 = acc[ai][bj][m][0] * gr[0], a1 = acc[ai][bj][m][1] * gr[1]; f32x4 p0, p1;
#pragma unroll
                        for (int e = 0; e < 4; ++e) { p0[e] = __shfl_xor(a0[e], 32); p1[e] = __shfl_xor(a1[e], 32); }
                        st8(dst + 32 * bj, a0 * c0 + p0 * sn0 * sg, a1 * c1 + p1 * sn1 * sg); }
                    asm volatile("" ::: "memory"); }
        }
        else {
            const float* SSCKV = (const float*)(ws + WS_SSCKV);
            float msl8[2][4];
#pragma unroll
            for (int ai = 0; ai < 2; ++ai)
#pragma unroll
                for (int m = 0; m < 4; ++m) { const f32x2 t = *(const f32x2*)(SSCKV + (size_t)(row0 + ai * 128 + m * 16) * 2); msl8[ai][m] = (t[0] + t[1]) * (1.0f / 128.0f) + EPS; }
            if (pn < 10) {
                bf16* base = (bf16*)(ws + WS_KN) + (pn - 6) * 256;
                f32x4 gv[2][2];
#pragma unroll
                for (int bj = 0; bj < 2; ++bj)
#pragma unroll
                    for (int n = 0; n < 2; ++n) gv[bj][n] = *(const f32x4*)(gkn + 32 * bj + 8 * fq + 4 * n) * *(const f32x4*)(gqn + 32 * bj + 8 * fq + 4 * n);
#pragma unroll
                for (int ai = 0; ai < 2; ++ai)
#pragma unroll
                    for (int m = 0; m < 4; ++m) { const int row = row0 + ai * 128 + m * 16;
                        const float msl = msl8[ai][m];
                        const float r = rsqrtf(red_fq(acc_ss(acc, ai, m)) * (1.0f / 64.0f) + EPS * msl);
                        bf16* dst = base + (size_t)row * 1024 + lc0;
#pragma unroll
                        for (int bj = 0; bj < 2; ++bj) st8(dst + 32 * bj, acc[ai][bj][m][0] * gv[bj][0] * r, acc[ai][bj][m][1] * gv[bj][1] * r);
                        asm volatile("" ::: "memory"); }
            } else {
                bf16* base = (bf16*)(ws + WS_VB) + (pn - 10) * 256;
#pragma unroll
                for (int ai = 0; ai < 2; ++ai)
#pragma unroll
                    for (int m = 0; m < 4; ++m) { const int row = row0 + ai * 128 + m * 16;
                        const float r = rsqrtf(msl8[ai][m]);
                        bf16* dst = base + (size_t)row * 1024 + lc0;
#pragma unroll
                        for (int bj = 0; bj < 2; ++bj) st8(dst + 32 * bj, acc[ai][bj][m][0] * r, acc[ai][bj][m][1] * r);
                        asm volatile("" ::: "memory"); }
            }
        }
    }
};

namespace mla {
using bf16x8 = __attribute__((ext_vector_type(8))) short;
using s16x4 = __attribute__((ext_vector_type(4))) short;
using f32x16 = __attribute__((ext_vector_type(16))) float;
constexpr int NW = 8, QBLK = 32, QB = 256, KVBLK = 64;
constexpr int KSLOT = 12288, VSLOT = 8192;
constexpr int LDS_K = 0, LDS_V = 3 * KSLOT, LDS_WS = LDS_V + 3 * VSLOT, LDS_OST = LDS_WS + NW * 256, LDS_TOTAL = LDS_OST + NW * 8192;
static_assert(LDS_TOTAL <= RING_BYTES, "MLA LDS map");
#define SBAR() __builtin_amdgcn_sched_barrier(0)
#define PIN(x) asm volatile("" : "+v"(x))
#define MFMA(a, b, c) __builtin_amdgcn_mfma_f32_32x32x16_bf16(a, b, c, 0, 0, 0)
#define WAIT_BAR(N) asm volatile("s_waitcnt vmcnt(" #N ") lgkmcnt(0)\n\ts_barrier" ::: "memory")
#define WAIT_BARH(NLO, NHI) do { if (wid < 4) { WAIT_BAR(NLO); } else { WAIT_BAR(NHI); } } while (0)

__device__ __forceinline__ int crow(int r, int hi) { return (r & 3) + 8 * (r >> 2) + 4 * hi; }
typedef __bf16 bf16x2_n __attribute__((ext_vector_type(2)));
typedef float f32x2_n __attribute__((ext_vector_type(2)));
__device__ __forceinline__ unsigned cvtpk(float lo, float hi) { const f32x2_n v = {lo, hi}; return __builtin_bit_cast(unsigned, __builtin_convertvector(v, bf16x2_n)); }
__device__ __forceinline__ void glds16(const void* g, unsigned lds_base) {
    unsigned sv; asm volatile("s_mov_b32 %0, m0\n\ts_mov_b32 m0, %2\n\ts_nop 0\n\tglobal_load_lds_dwordx4 %1, off\n\ts_mov_b32 m0, %0" : "=&s"(sv) : "v"(g), "s"(lds_base) : "memory"); }
typedef __attribute__((address_space(3))) const char* lds_cptr;
typedef short v4i16_t __attribute__((ext_vector_type(4)));
__device__ __forceinline__ void kload2(bf16x8* kf, lds_cptr kp, int d0) { kf[2 * d0] = *(const __attribute__((address_space(3))) bf16x8*)(kp + d0 * 2048); kf[2 * d0 + 1] = *(const __attribute__((address_space(3))) bf16x8*)(kp + d0 * 2048 + 512); }
__device__ __forceinline__ s16x4 vtr(lds_cptr p) { return __builtin_bit_cast(s16x4, __builtin_amdgcn_ds_read_tr16_b64_v4i16((__attribute__((address_space(3))) v4i16_t*)p)); }
__device__ __forceinline__ void cmask(f32x16& p0, f32x16& p1, int jb, int qrel, int hi) {
    int d = qrel - (64 * jb + 4 * hi); asm volatile("" : "+v"(d));
#pragma unroll
    for (int r = 0; r < 16; ++r) { const int c = (r & 3) + 8 * (r >> 2); if (c > d) p0[r] = -INFINITY; if (c + 32 > d) p1[r] = -INFINITY; } }

__device__ __forceinline__ void bmask(f32x16& p0, f32x16& p1, int jb, int wid, int qrel, int hi) {
    const int part = wid >> 1;
    if (jb == part) cmask(p0, p1, jb, qrel, hi);
    else if (jb > part) {
#pragma unroll
        for (int r = 0; r < 16; ++r) { p0[r] = -INFINITY; p1[r] = -INFINITY; } }
}
template <int VAR> __device__ __forceinline__ f32x16 mqk(bf16x8 a, bf16x8 b, f32x16 c) { if constexpr ((VAR & 128) != 0) return c; else return MFMA(a, b, c); }
template <int VAR> __device__ __forceinline__ f32x16 mpv(bf16x8 a, bf16x8 b, f32x16 c) { if constexpr ((VAR & 64) != 0) return c; else return MFMA(a, b, c); }
struct Ptrs { const bf16 *QBN, *QBR, *KN, *KR, *VB, *SZB; bf16* AB; const float *SSCQ, *rope, *gq, *SSQ; float* RS; unsigned long long* pts; };
#ifdef PROBE_MLAT
#define MSTAMP(k) do { if (blockIdx.x == 0 && wid == 0 && ui == PROBE_MLAT && lane_id() == 0) P.pts[k] = __builtin_amdgcn_s_memrealtime(); } while (0)
#else
#define MSTAMP(k) do { } while (0)
#endif

__device__ __forceinline__ void q_prep_units(int bh, int s, int ulo, int uhi, const Ptrs& P, const int wid) {
    const int lane = lane_id(), r32 = lane & 31, hi = lane >> 5; const int b = bh >> 4, h = bh & 15;
    if (hi != 0) return;
    f32x4 sc[8]; float s0[8], s1[8];
#pragma unroll
    for (int i = 0; i < 8; ++i) if (i >= ulo && i < uhi) { const int qb = (i & 1) ? 8 * (i >> 1) + 7 - s : 8 * (i >> 1) + s; const long row = (long)b * SEQ + qb * QB + wid * QBLK + r32;
        sc[i] = *(const f32x4*)(P.SSCQ + row * 4); s0[i] = P.SSQ[row * 32 + h]; s1[i] = P.SSQ[row * 32 + 16 + h]; }
#pragma unroll
    for (int i = 0; i < 8; ++i) if (i >= ulo && i < uhi) { const int qb = (i & 1) ? 8 * (i >> 1) + 7 - s : 8 * (i >> 1) + s; const long row = (long)b * SEQ + qb * QB + wid * QBLK + r32;
        const float msl = ((sc[i][0] + sc[i][1]) + (sc[i][2] + sc[i][3])) * (1.0f / 256.0f) + EPS;
        P.RS[row * 16 + h] = rsqrtf((s0[i] + s1[i]) * (1.0f / 96.0f) + EPS * msl) * QB_SCALE; }
}

template <int VAR> __device__ __forceinline__ void mla_cu(int bh, int s, int ulo, int uhi, const Ptrs& P, char* lds, const int wid) {
    const int b = bh >> 4, h = bh & 15;
    const long rowbase = (long)b * SEQ;
    if (wid >= 4) __builtin_amdgcn_s_setprio(1);
    bf16x8 qr[6]; float qscale = 0.f;
    int ks_prev = 2 * KSLOT, ks_cur = 0, ks_next = KSLOT, vs_prev = 2 * VSLOT, vs_cur = 0, vs_next = VSLOT;
#define QB_OF(i) (((i) & 1) ? 8 * ((i) >> 1) + 7 - s : 8 * ((i) >> 1) + s)
  for (int ui = ulo; ui < uhi; ++ui) {
    const int qb = QB_OF(ui); const bool first = ui == ulo, has_next = ui + 1 < uhi;
    MSTAMP(30);
    int lane = lane_id(); asm volatile("" : "+v"(lane));
    const int r32 = lane & 31, hi = lane >> 5;
    const int q0 = qb * QB, NT = (q0 + QB) / KVBLK;
    const unsigned lds0 = (unsigned)(uintptr_t)lds; float* wsf = (float*)(lds + LDS_WS) + wid * 64;
    const bf16* ksrc = P.KN + (rowbase + lane) * 1024 + h * 64 + wid * 8;
    const bf16* rsrc = P.KR + (rowbase + lane) * 32 + (wid & 3) * 8;
    const bf16* vsrc = P.VB + (rowbase + 16 * (wid & 3) + (lane >> 2)) * 1024 + h * 64 + (wid >> 2) * 32 + (lane & 3) * 8;
    const unsigned kdst = lds0 + LDS_K + wid * 1024, rdst = lds0 + LDS_K + (8 + (wid & 3)) * 1024, vdst = lds0 + LDS_V + wid * 1024;
#define DMA_K(t, slot) do { if (VAR & 4) break; glds16(ksrc + (long)(t) * KVBLK * 1024, (unsigned)__builtin_amdgcn_readfirstlane(kdst + (slot))); if (wid < 4) glds16(rsrc + (long)(t) * KVBLK * 32, (unsigned)__builtin_amdgcn_readfirstlane(rdst + (slot))); } while (0)
#define DMA_V(t, slot) if (!(VAR & 4)) glds16(vsrc + (long)(t) * KVBLK * 1024, (unsigned)__builtin_amdgcn_readfirstlane(vdst + (slot)))
    const lds_cptr vp0 = (lds_cptr)lds + LDS_V + ((lane >> 4) & 1) * 32 + (lane & 3) * 8 + (4 * hi + ((lane & 15) >> 2)) * 64;
    const lds_cptr kp0 = (lds_cptr)lds + LDS_K + hi * 1024 + r32 * 16;
#define LOADQ(Q0_) do { const long row_ = rowbase + (Q0_) + wid * QBLK + r32; \
        _Pragma("unroll") for (int d0 = 0; d0 < 4; ++d0) qr[d0] = *(const bf16x8*)(P.QBN + row_ * 1024 + h * 64 + d0 * 16 + hi * 8); \
        _Pragma("unroll") for (int d0 = 4; d0 < 6; ++d0) qr[d0] = *(const bf16x8*)(P.QBR + row_ * 512 + h * 32 + (d0 - 4) * 16 + hi * 8); \
        qscale = P.RS[row_ * 16 + h]; } while (0)
    if (first) { DMA_K(0, ks_cur); DMA_V(0, vs_cur); DMA_K(1, ks_next); LOADQ(q0); }
    float l_reg = 0.f; f32x16 o[2]; o[0] = f32x16{}; o[1] = f32x16{};
    const int qrel = wid * QBLK + r32;
    f32x16 pA0, pA1, pB0, pB1; bf16x8 kf[12]; s16x4 vlo[8], vhi[8]; u32x4 pw0, pw1, pw2, pw3;
#define ROT() do { ks_prev = ks_cur; ks_cur = ks_next; ks_next = (ks_next == 2 * KSLOT) ? 0 : ks_next + KSLOT; vs_prev = vs_cur; vs_cur = vs_next; vs_next = (vs_next == 2 * VSLOT) ? 0 : vs_next + VSLOT; } while (0)
#define EX(v) ((VAR & 2) ? (v) : __builtin_amdgcn_exp2f(v))
    if (first) { DMA_K(2, ks_prev); WAIT_BARH(5, 3); }
    else { WAIT_BARH(20, 18); }
#pragma unroll
    for (int d0 = 0; d0 < 6; ++d0) { const u32x4 w = __builtin_bit_cast(u32x4, qr[d0]); u32x4 pk;
        pk.x = cvtpk(bflo(w.x) * qscale, bfhi(w.x) * qscale); pk.y = cvtpk(bflo(w.y) * qscale, bfhi(w.y) * qscale); pk.z = cvtpk(bflo(w.z) * qscale, bfhi(w.z) * qscale); pk.w = cvtpk(bflo(w.w) * qscale, bfhi(w.w) * qscale);
        qr[d0] = __builtin_bit_cast(bf16x8, pk); }
    _Pragma("unroll") for (int d0 = 0; d0 < 6; ++d0) kload2(kf, kp0 + ks_cur, d0);
    pA0 = MFMA(kf[0], qr[0], f32x16{}); pA1 = MFMA(kf[1], qr[0], f32x16{});
    _Pragma("unroll") for (int d0 = 1; d0 < 6; ++d0) { pA0 = MFMA(kf[2 * d0], qr[d0], pA0); pA1 = MFMA(kf[2 * d0 + 1], qr[d0], pA1); }
    if (NT == 4) bmask(pA0, pA1, 0, wid, qrel, hi);
#pragma unroll
    for (int r = 0; r < 16; ++r) { pA0[r] = EX(pA0[r]); pA1[r] = EX(pA1[r]); }
    WAIT_BAR(0);
    DMA_K(3, ks_cur); DMA_V(1, vs_next); ROT();
    _Pragma("unroll") for (int d0 = 0; d0 < 6; ++d0) kload2(kf, kp0 + ks_cur, d0);
    WAIT_BARH(3, 2);
#define PKW(Pv, i) cvtpk(Pv[i], Pv[i + 1])
#define PAF(k) __builtin_bit_cast(bf16x8, pw##k)
#define VFR(i) (bf16x8){vlo[i][0], vlo[i][1], vlo[i][2], vlo[i][3], vhi[i][0], vhi[i][1], vhi[i][2], vhi[i][3]}
#define VRD(i) do { if (VAR & 16) break; vlo[i] = vtr(vp_ + (((i) >> 2) * 4096 + ((i) & 3) * 1024)); vhi[i] = vtr(vp_ + (((i) >> 2) * 4096 + ((i) & 3) * 1024 + 512)); } while (0)
#define KRD(G, d0) do { if ((G) && !(VAR & 32)) { kload2(kf, kp0 + ks_next, d0); SBAR(); } } while (0)
#define GAPA3F(MF, a0, a1, a2, W0, PW) do { MF; if (!(VAR & 1)) { sacc += a0; sacc2 = a1 + a2; } W0; PIN(PW); PIN(sacc); PIN(sacc2); SBAR(); } while (0)
#define GAPA3(MF, a0, a1, a2, W0, PW) do { MF; if (!(VAR & 1)) { sacc += a0; sacc2 += a1; sacc += a2; } W0; PIN(PW); PIN(sacc); PIN(sacc2); SBAR(); } while (0)
#define GAPA0(MF, W0, W1, PW) do { MF; W0; W1; PIN(PW); SBAR(); } while (0)
#define GAPA3W2(MF, a0, a1, a2, W0, W1, PW) do { MF; if (!(VAR & 1)) { sacc += a0; sacc2 += a1; sacc += a2; } W0; W1; PIN(PW); PIN(sacc); PIN(sacc2); SBAR(); } while (0)
#define GAPB(MF, X, i) do { MF; X[i] = EX(X[i]); X[i + 1] = EX(X[i + 1]); X[i + 2] = EX(X[i + 2]); X[i + 3] = EX(X[i + 3]); PIN(X); SBAR(); } while (0)
#define STEP(C0, C1, P0, P1, t, MASK, GK, GV, GL, PFX) STEPX(C0, C1, P0, P1, t, MASK, GK, GV, GL, PFX, (t) + 3, (t) + 1)
#define STEPX(C0, C1, P0, P1, t, MASK, GK, GV, GL, PFX, KT, VT) do { SBAR(); \
    const lds_cptr vp_ = vp0 + vs_prev; \
    VRD(0); SBAR(); float sacc = P0[0] + P0[1], sacc2 = 0.f; \
                    GAPA3F(C0 = mqk<VAR>(kf[0], qr[0], f32x16{}), P0[2], P0[3], P0[4],      pw0[0] = PKW(P0, 0),  pw0); \
    VRD(4); SBAR(); GAPA3(C1 = mqk<VAR>(kf[1], qr[0], f32x16{}), P0[5], P0[6], P0[7],       pw0[1] = PKW(P0, 2),  pw0); \
    VRD(1); SBAR(); GAPA3(C0 = mqk<VAR>(kf[2], qr[1], C0),   P0[8], P0[9], P0[10],      pw0[2] = PKW(P0, 4),  pw0); \
    VRD(5); SBAR(); GAPA3(C1 = mqk<VAR>(kf[3], qr[1], C1),   P0[11], P0[12], P0[13],    pw0[3] = PKW(P0, 6),  pw0); \
    VRD(2); SBAR(); GAPA3(C0 = mqk<VAR>(kf[4], qr[2], C0),   P0[14], P0[15], P1[0],     pw1[0] = PKW(P0, 8),  pw1); \
    VRD(6); SBAR(); GAPA3(C1 = mqk<VAR>(kf[5], qr[2], C1),   P1[1], P1[2], P1[3],       pw1[1] = PKW(P0, 10), pw1); \
    VRD(3); SBAR(); GAPA3(C0 = mqk<VAR>(kf[6], qr[3], C0),   P1[4], P1[5], P1[6],       pw1[2] = PKW(P0, 12), pw1); \
    VRD(7); SBAR(); GAPA3(C1 = mqk<VAR>(kf[7], qr[3], C1),   P1[7], P1[8], P1[9],       pw1[3] = PKW(P0, 14), pw1); \
                    GAPA3W2(C0 = mqk<VAR>(kf[8], qr[4], C0), P1[10], P1[11], P1[12],    pw2[0] = PKW(P1, 0),  pw2[1] = PKW(P1, 2),  pw2); \
                    GAPA3W2(C1 = mqk<VAR>(kf[9], qr[4], C1), P1[13], P1[14], P1[15],    pw2[2] = PKW(P1, 4),  pw2[3] = PKW(P1, 6),  pw2); \
                    GAPA0(C0 = mqk<VAR>(kf[10], qr[5], C0),  pw3[0] = PKW(P1, 8),  pw3[1] = PKW(P1, 10), pw3); \
                    GAPA0(C1 = mqk<VAR>(kf[11], qr[5], C1),  pw3[2] = PKW(P1, 12), pw3[3] = PKW(P1, 14), pw3); \
    l_reg += sacc + sacc2; \
    if (GK) DMA_K(KT, ks_cur); if (GV) DMA_V(VT, vs_next); PFX; \
    if (MASK) { const int jb_ = (t) - (NT - 4); if (jb_ >= 0) bmask(C0, C1, jb_, wid, qrel, hi); } \
    SBAR(); \
                GAPB(o[0] = mpv<VAR>(PAF(0), VFR(0), o[0]), C0, 0); \
    KRD(GL, 0); GAPB(o[1] = mpv<VAR>(PAF(0), VFR(4), o[1]), C0, 4); \
    KRD(GL, 1); GAPB(o[0] = mpv<VAR>(PAF(1), VFR(1), o[0]), C0, 8); \
    KRD(GL, 2); GAPB(o[1] = mpv<VAR>(PAF(1), VFR(5), o[1]), C0, 12); \
    KRD(GL, 3); GAPB(o[0] = mpv<VAR>(PAF(2), VFR(2), o[0]), C1, 0); \
    KRD(GL, 4); GAPB(o[1] = mpv<VAR>(PAF(2), VFR(6), o[1]), C1, 4); \
    KRD(GL, 5); GAPB(o[0] = mpv<VAR>(PAF(3), VFR(3), o[0]), C1, 8); \
                GAPB(o[1] = mpv<VAR>(PAF(3), VFR(7), o[1]), C1, 12); \
    } while (0)
    int t = 1;
    MSTAMP(31);
    for (; t + 5 < NT; t += 2) {
        STEP(pB0, pB1, pA0, pA1, t, false, true, true, true, (void)0);     if (VAR & 8) { asm volatile("s_waitcnt vmcnt(2) lgkmcnt(0)" ::: "memory"); } else { WAIT_BARH(3, 2); } ROT();
        STEP(pA0, pA1, pB0, pB1, t + 1, false, true, true, true, (void)0); if (VAR & 8) { asm volatile("s_waitcnt vmcnt(2) lgkmcnt(0)" ::: "memory"); } else { WAIT_BARH(3, 2); } ROT();
    }
    MSTAMP(32);
    if (NT > 4) {
        STEP(pB0, pB1, pA0, pA1, t, false, true, true, true, (void)0);     WAIT_BARH(3, 2); ROT();
        STEP(pA0, pA1, pB0, pB1, t + 1, true, true, true, true, (void)0);  WAIT_BARH(3, 2); ROT();
        t += 2;
    }
    STEPX(pB0, pB1, pA0, pA1, t, true, has_next, true, true, (void)0, 0, (t) + 1);        if (has_next) { WAIT_BARH(3, 2); } else { WAIT_BAR(1); } ROT();
    STEPX(pA0, pA1, pB0, pB1, t + 1, true, has_next, true, true, (void)0, 1, (t) + 2);    if (has_next) { WAIT_BARH(3, 2); } else { WAIT_BAR(1); } ROT();
#define PREFETCH_NEXT() do { if (has_next) { const int nq0_ = QB_OF(ui + 1) * QB; LOADQ(nq0_); } } while (0)
    MSTAMP(33);
    const bool live3 = wid >= 4;
    if (live3) { STEPX(pB0, pB1, pA0, pA1, NT - 1, true, has_next, has_next, false, PREFETCH_NEXT(), 2, 0); }
    else { if (has_next) { DMA_K(2, ks_cur); DMA_V(0, vs_next); } PREFETCH_NEXT(); }
    if (has_next) { WAIT_BARH(10, 9); } else { WAIT_BAR(0); }
    MSTAMP(34);
    u32x4 zz[4];
    { int lz = lane_id(); asm volatile("" : "+v"(lz)); const bf16* Zw = P.SZB + (rowbase + q0 + wid * QBLK) * 1024 + h * 64;
#pragma unroll
      for (int i = 0; i < 4; ++i) zz[i] = ld_hint<NT_ATTZ != 0>((const u32x4*)(Zw + (long)(i * 8 + (lz >> 3)) * 1024 + (lz & 7) * 8)); }
    if (live3) { float sacc = pB0[0] + pB0[1];
#pragma unroll
      for (int r = 2; r < 16; ++r) sacc += pB0[r];
#pragma unroll
      for (int r = 0; r < 16; ++r) sacc += pB1[r];
      l_reg += sacc;
      pw0 = (u32x4){PKW(pB0, 0), PKW(pB0, 2), PKW(pB0, 4), PKW(pB0, 6)}; pw1 = (u32x4){PKW(pB0, 8), PKW(pB0, 10), PKW(pB0, 12), PKW(pB0, 14)};
      pw2 = (u32x4){PKW(pB1, 0), PKW(pB1, 2), PKW(pB1, 4), PKW(pB1, 6)}; pw3 = (u32x4){PKW(pB1, 8), PKW(pB1, 10), PKW(pB1, 12), PKW(pB1, 14)};
      const lds_cptr vp_ = vp0 + vs_cur; _Pragma("unroll") for (int i = 0; i < 8; ++i) VRD(i);
      o[0] = MFMA(PAF(0), VFR(0), o[0]); o[1] = MFMA(PAF(0), VFR(4), o[1]); o[0] = MFMA(PAF(1), VFR(1), o[0]); o[1] = MFMA(PAF(1), VFR(5), o[1]);
      o[0] = MFMA(PAF(2), VFR(2), o[0]); o[1] = MFMA(PAF(2), VFR(6), o[1]); o[0] = MFMA(PAF(3), VFR(3), o[0]); o[1] = MFMA(PAF(3), VFR(7), o[1]); }
    l_reg += __shfl_xor(l_reg, 32);
    int lane2 = lane_id(); asm volatile("" : "+v"(lane2));
    const int r32e = lane2 & 31, hie = lane2 >> 5;
    if (hie == 0) wsf[32 + r32e] = l_reg; asm volatile("s_waitcnt lgkmcnt(0)" ::: "memory");
    float rli[16];
#pragma unroll
    for (int r = 0; r < 16; ++r) rli[r] = __builtin_amdgcn_rcpf(wsf[32 + crow(r, hie)]);
    float* stg = (float*)(lds + LDS_OST) + wid * 2048;
#pragma unroll
    for (int r = 0; r < 16; ++r) { const int orow = crow(r, hie);
#pragma unroll
        for (int d0 = 0; d0 < 2; ++d0) stg[orow * 64 + d0 * 32 + r32e] = o[d0][r] * rli[r]; }
    asm volatile("s_waitcnt lgkmcnt(0)" ::: "memory");
    { const long row0 = rowbase + q0 + wid * QBLK; bf16* Ow = P.AB + row0 * 1024 + h * 64;
#pragma unroll
      for (int i = 0; i < 4; ++i) { const int row = i * 8 + (lane2 >> 3), ch = lane2 & 7;
          const f32x4 a0 = *(const f32x4*)(stg + row * 64 + ch * 8), a1 = *(const f32x4*)(stg + row * 64 + ch * 8 + 4); const u32x4 z = zz[i];
          u32x4 w; w.x = cvtpk(a0[0] * bflo(z.x), a0[1] * bfhi(z.x)); w.y = cvtpk(a0[2] * bflo(z.y), a0[3] * bfhi(z.y)); w.z = cvtpk(a1[0] * bflo(z.z), a1[1] * bfhi(z.z)); w.w = cvtpk(a1[2] * bflo(z.w), a1[3] * bfhi(z.w));
          st_hint<NT_ATTO != 0>(w, (u32x4*)(Ow + (long)row * 1024 + ch * 8)); } }
    asm volatile("s_waitcnt lgkmcnt(0)" ::: "memory");
    MSTAMP(35);
    ROT();
  }
    __builtin_amdgcn_s_setprio(0);
    asm volatile("s_waitcnt lgkmcnt(0)\n\ts_barrier" ::: "memory");
#undef QB_OF
#undef LOADQ
#undef PREFETCH_NEXT
#undef DMA_K
#undef DMA_V
#undef ROT
#undef EX
#undef PKW
#undef PAF
#undef VFR
#undef VRD
#undef KRD
#undef GAPA3
#undef GAPA3F
#undef GAPA0
#undef GAPA3W2
#undef GAPB
#undef STEP
}
#undef SBAR
#undef PIN
#undef MFMA
#undef WAIT_BAR
#undef WAIT_BARH
}

namespace swa {
using bf16x8 = __attribute__((ext_vector_type(8))) short;
using s16x4 = __attribute__((ext_vector_type(4))) short;
using f32x16 = __attribute__((ext_vector_type(16))) float;
typedef __attribute__((address_space(3))) const char* lds_cptr;
typedef short v4i16_t __attribute__((ext_vector_type(4)));
constexpr int L_K = 0, L_V = 32768, L_BT = 65536, L_WS = L_BT + 8192, L_OST = L_WS + 2048, L_TOTAL = L_OST + 8 * 8192;
static_assert(L_TOTAL <= LDS_BYTES, "SWA LDS map");
#define MFMA(a, b, c) __builtin_amdgcn_mfma_f32_32x32x16_bf16(a, b, c, 0, 0, 0)
__device__ __forceinline__ int crow(int r, int hi) { return (r & 3) + 8 * (r >> 2) + 4 * hi; }
__device__ __forceinline__ unsigned cvtpk(float lo, float hi) { unsigned r; asm("v_cvt_pk_bf16_f32 %0, %1, %2" : "=v"(r) : "v"(lo), "v"(hi)); return r; }
__device__ __forceinline__ s16x4 vtr(lds_cptr p) { return __builtin_bit_cast(s16x4, __builtin_amdgcn_ds_read_tr16_b64_v4i16((__attribute__((address_space(3))) v4i16_t*)p)); }

__device__ __forceinline__ void swa_unit(int b, int nblk, int g, const bf16* QA, const bf16* KVA, const bf16* SZA, bf16* AA, const float* BT, const float* sinks, LAS unsigned char* lds, const int wid) {
    const int lane = lane_id(), r32 = lane & 31, hi = lane >> 5, tid = wid * 64 + lane;
    const long rowbase = (long)b * SEQ;
    __syncthreads();
#pragma unroll
    for (int i = 0; i < 4; ++i) { const int e = tid + 512 * i, key = e >> 3, ch = e & 7; const int tok = (nblk - 1) * 128 + key;
        u32x4 kv = (u32x4){0u, 0u, 0u, 0u}, vv = kv;
        if (tok >= 0) { const bf16* src = KVA + (rowbase + tok) * 256 + g * 64 + ch * 8; kv = *(const u32x4*)src; vv = *(const u32x4*)(src + 128); }
        *(LAS u32x4*)(lds + L_K + ch * 4096 + key * 16) = kv;
        *(LAS u32x4*)(lds + L_V + (key >> 6) * 8192 + (ch >> 2) * 4096 + (key & 63) * 64 + (ch & 3) * 16) = vv; }
    for (int e = tid; e < 8 * 256; e += 512) { const int dist = (e & 255) - 64; ((LAS float*)(lds + L_BT))[e] = (unsigned)dist < 128u ? BT[(g * 8 + (e >> 8)) * 128 + dist] : -INFINITY; }
    __syncthreads();
    const lds_cptr kp0 = (lds_cptr)lds + L_K + hi * 4096 + r32 * 16;
    const lds_cptr vp0 = (lds_cptr)lds + L_V + ((lane >> 4) & 1) * 32 + (lane & 3) * 8 + (4 * hi + ((lane & 15) >> 2)) * 64;
    LAS float* wsf = (LAS float*)(lds + L_WS) + wid * 64; LAS float* stg = (LAS float*)(lds + L_OST) + wid * 2048;
    bf16x8 qn[4];
    { const int task = wid * 4, hq = task >> 2, w4 = task & 3, head = g * 8 + hq; const long row0 = rowbase + nblk * 128 + 32 * w4;
#pragma unroll
      for (int d0 = 0; d0 < 4; ++d0) qn[d0] = *(const bf16x8*)(QA + (row0 + r32) * 1024 + head * 64 + d0 * 16 + hi * 8); }
    for (int tk = 0; tk < 4; ++tk) {
        const int task = wid * 4 + tk, hq = task >> 2, w4 = task & 3, head = g * 8 + hq, i0 = 32 * w4;
        const long row0 = rowbase + nblk * 128 + i0;
        bf16x8 qr[4];
#pragma unroll
        for (int d0 = 0; d0 < 4; ++d0) qr[d0] = qn[d0];
        u32x4 zz[4];
        { const bf16* Zw = SZA + row0 * 1024 + head * 64;
#pragma unroll
          for (int i = 0; i < 4; ++i) zz[i] = ld_hint<NT_ATTZ != 0>((const u32x4*)(Zw + (long)(i * 8 + (lane >> 3)) * 1024 + (lane & 7) * 8)); }
        if (tk < 3) { const int t2 = task + 1, hq2 = t2 >> 2, w42 = t2 & 3, head2 = g * 8 + hq2; const long r2 = rowbase + nblk * 128 + 32 * w42;
#pragma unroll
          for (int d0 = 0; d0 < 4; ++d0) qn[d0] = *(const bf16x8*)(QA + (r2 + r32) * 1024 + head2 * 64 + d0 * 16 + hi * 8); }
        f32x16 o[2]; o[0] = f32x16{}; o[1] = f32x16{};
        float l_reg = 0.f;
        const LAS float* tb = (const LAS float*)(lds + L_BT) + hq * 256 + 5 + i0 + 128 - 4 * hi + r32;
        const int jt0 = w4 >> 1; const bool first = nblk == 0;
#pragma unroll 1
        for (int jj = 0; jj < 3; ++jj) {
            const int jt = jt0 + jj;
            if (first && jt < 2) continue;
            f32x16 p0, p1;
            { const LAS float* tp = tb - 64 * jt;
#pragma unroll
              for (int r = 0; r < 16; ++r) { const int cr = (r & 3) + 8 * (r >> 2); p0[r] = tp[59 - cr]; p1[r] = tp[27 - cr]; } }
            { const lds_cptr kp = kp0 + jt * 1024;
              bf16x8 k0 = *(const __attribute__((address_space(3))) bf16x8*)(kp), k1 = *(const __attribute__((address_space(3))) bf16x8*)(kp + 512);
              p0 = MFMA(k0, qr[0], p0); p1 = MFMA(k1, qr[0], p1);
#pragma unroll
              for (int d0 = 1; d0 < 4; ++d0) { k0 = *(const __attribute__((address_space(3))) bf16x8*)(kp + d0 * 8192); k1 = *(const __attribute__((address_space(3))) bf16x8*)(kp + d0 * 8192 + 512);
                  p0 = MFMA(k0, qr[d0], p0); p1 = MFMA(k1, qr[d0], p1); } }
#pragma unroll
            for (int r = 0; r < 16; ++r) { p0[r] = __builtin_amdgcn_exp2f(p0[r]); p1[r] = __builtin_amdgcn_exp2f(p1[r]); }
            float sacc = 0.f;
#pragma unroll
            for (int r = 0; r < 16; ++r) sacc += p0[r] + p1[r];
            l_reg += sacc;
            u32x4 pw0 = (u32x4){cvtpk(p0[0], p0[1]), cvtpk(p0[2], p0[3]), cvtpk(p0[4], p0[5]), cvtpk(p0[6], p0[7])}, pw1 = (u32x4){cvtpk(p0[8], p0[9]), cvtpk(p0[10], p0[11]), cvtpk(p0[12], p0[13]), cvtpk(p0[14], p0[15])};
            u32x4 pw2 = (u32x4){cvtpk(p1[0], p1[1]), cvtpk(p1[2], p1[3]), cvtpk(p1[4], p1[5]), cvtpk(p1[6], p1[7])}, pw3 = (u32x4){cvtpk(p1[8], p1[9]), cvtpk(p1[10], p1[11]), cvtpk(p1[12], p1[13]), cvtpk(p1[14], p1[15])};
            const lds_cptr vp_ = vp0 + jt * 8192;
#define VF(i) ({ const s16x4 lo_ = vtr(vp_ + (((i) >> 2) * 4096 + ((i) & 3) * 1024)), hi_ = vtr(vp_ + (((i) >> 2) * 4096 + ((i) & 3) * 1024 + 512)); (bf16x8){lo_[0], lo_[1], lo_[2], lo_[3], hi_[0], hi_[1], hi_[2], hi_[3]}; })
            o[0] = MFMA(__builtin_bit_cast(bf16x8, pw0), VF(0), o[0]); o[1] = MFMA(__builtin_bit_cast(bf16x8, pw0), VF(4), o[1]);
            o[0] = MFMA(__builtin_bit_cast(bf16x8, pw1), VF(1), o[0]); o[1] = MFMA(__builtin_bit_cast(bf16x8, pw1), VF(5), o[1]);
            o[0] = MFMA(__builtin_bit_cast(bf16x8, pw2), VF(2), o[0]); o[1] = MFMA(__builtin_bit_cast(bf16x8, pw2), VF(6), o[1]);
            o[0] = MFMA(__builtin_bit_cast(bf16x8, pw3), VF(3), o[0]); o[1] = MFMA(__builtin_bit_cast(bf16x8, pw3), VF(7), o[1]);
#undef VF
        }
        l_reg += __shfl_xor(l_reg, 32);
        l_reg += __builtin_amdgcn_exp2f(sinks[head] * LOG2E);
        if (hi == 0) wsf[32 + r32] = l_reg;
        asm volatile("s_waitcnt lgkmcnt(0)" ::: "memory");
        float rli[16];
#pragma unroll
        for (int r = 0; r < 16; ++r) rli[r] = __builtin_amdgcn_rcpf(wsf[32 + crow(r, hi)]);
#pragma unroll
        for (int r = 0; r < 16; ++r) { const int orow = crow(r, hi);
#pragma unroll
            for (int d0 = 0; d0 < 2; ++d0) stg[orow * 64 + d0 * 32 + r32] = o[d0][r] * rli[r]; }
        asm volatile("s_waitcnt lgkmcnt(0)" ::: "memory");
        { bf16* Ow = AA + row0 * 1024 + head * 64;
#pragma unroll
          for (int i = 0; i < 4; ++i) { const int row = i * 8 + (lane >> 3), ch = lane & 7;
              const f32x4 a0 = *(const LAS f32x4*)(stg + row * 64 + ch * 8), a1 = *(const LAS f32x4*)(stg + row * 64 + ch * 8 + 4); const u32x4 z = zz[i];
              u32x4 w; w.x = cvtpk(a0[0] * bflo(z.x), a0[1] * bfhi(z.x)); w.y = cvtpk(a0[2] * bflo(z.y), a0[3] * bfhi(z.y)); w.z = cvtpk(a1[0] * bflo(z.z), a1[1] * bfhi(z.z)); w.w = cvtpk(a1[2] * bflo(z.w), a1[3] * bfhi(z.w));
              st_hint<NT_ATTO != 0>(w, (u32x4*)(Ow + (long)row * 1024 + ch * 8)); } }
        asm volatile("s_waitcnt lgkmcnt(0)" ::: "memory");
    }
}
#undef MFMA
}

struct Epi3c {
    static constexpr bool PERM = true, AFTER_DRAIN = false;
    bf16* __restrict__ MG; const bf16* __restrict__ SGA; const bf16* __restrict__ SGB;
    __device__ __forceinline__ void mid(pg8::f32x4 (&acc)[2][2][4][2], const pg8::Unit& u, int wr, int wc) const {
        int ln_ = lane_id(); asm volatile("" : "+v"(ln_)); const int fr = ln_ & 15, fq = ln_ >> 4;
        const int row0 = u.pm * 256 + wr * 64 + fr, lc0 = u.pn * 256 + 64 * wc + 8 * fq;
#pragma unroll
        for (int ai = 0; ai < 2; ++ai) {
            u32x4 ga[4][2];
#pragma unroll
            for (int m = 0; m < 4; ++m)
#pragma unroll
                for (int bj = 0; bj < 2; ++bj) ga[m][bj] = ld_hint<NT_SG != 0>((const u32x4*)(SGA + (size_t)(row0 + ai * 128 + m * 16) * 1024 + lc0 + 32 * bj));
#pragma unroll
            for (int m = 0; m < 4; ++m)
#pragma unroll
                for (int bj = 0; bj < 2; ++bj) {
                    const u32x4 A = ga[m][bj];
                    const float a_[8] = {bflo(A.x), bfhi(A.x), bflo(A.y), bfhi(A.y), bflo(A.z), bfhi(A.z), bflo(A.w), bfhi(A.w)};
#pragma unroll
                    for (int e = 0; e < 4; ++e) { acc[ai][bj][m][0][e] *= a_[e]; acc[ai][bj][m][1][e] *= a_[4 + e]; }
                }
            asm volatile("" ::: "memory");
        }
    }
    __device__ __forceinline__ void operator()(AccRef acc, const pg8::Unit& u, int wr, int wc, int, int) const {
        int ln_ = lane_id(); asm volatile("" : "+v"(ln_)); const int fr = ln_ & 15, fq = ln_ >> 4;
        const int row0 = u.pm * 256 + wr * 64 + fr, lc0 = u.pn * 256 + 64 * wc + 8 * fq;
#pragma unroll
        for (int ai = 0; ai < 2; ++ai) {
            u32x4 gb[4][2];
#pragma unroll
            for (int m = 0; m < 4; ++m)
#pragma unroll
                for (int bj = 0; bj < 2; ++bj) gb[m][bj] = ld_hint<NT_SG != 0>((const u32x4*)(SGB + (size_t)(row0 + ai * 128 + m * 16) * 1024 + lc0 + 32 * bj));
#pragma unroll
            for (int m = 0; m < 4; ++m)
#pragma unroll
                for (int bj = 0; bj < 2; ++bj) {
                    const u32x4 g = gb[m][bj];
                    f32x4 v0 = acc[ai][bj][m][0], v1 = acc[ai][bj][m][1];
                    v0[0] *= fmaxf(bflo(g.x), 1e-30f); v0[1] *= fmaxf(bfhi(g.x), 1e-30f); v0[2] *= fmaxf(bflo(g.y), 1e-30f); v0[3] *= fmaxf(bfhi(g.y), 1e-30f);
                    v1[0] *= fmaxf(bflo(g.z), 1e-30f); v1[1] *= fmaxf(bfhi(g.z), 1e-30f); v1[2] *= fmaxf(bflo(g.w), 1e-30f); v1[3] *= fmaxf(bfhi(g.w), 1e-30f);
                    st8(MG + (size_t)(row0 + ai * 128 + m * 16) * 1024 + lc0 + 32 * bj, v0, v1);
                }
            asm volatile("" ::: "memory");
        }
    }
};

struct Epi4 {
    static constexpr bool PERM = false, AFTER_DRAIN = false;
    const float* __restrict__ x; float* __restrict__ X1F; bf16* __restrict__ X1B; float* __restrict__ SSX1; int mode;
    __device__ __forceinline__ void operator()(AccRef acc, const pg8::Unit& u, int wr, int wc, int, int) const {
        int ln_ = lane_id(); asm volatile("" : "+v"(ln_)); const int fr = ln_ & 15, fq = ln_ >> 4;
        const int row0 = u.pm * 256 + wr * 64 + fr, c0 = u.pn * 256 + 32 * wc + 4 * fq;
#ifdef PROBE
        if (mode == 1) { pg8::f32x4 t = acc[0][0][0][0];
#pragma unroll
            for (int i_ = 1; i_ < 32; ++i_) t += acc[i_ >> 4][(i_ >> 3) & 1][(i_ >> 1) & 3][i_ & 1];
            asm volatile("" :: "v"(t)); return; }
        if (mode == 2) { pg8::f32x4 t = acc[0][0][0][0];
#pragma unroll
            for (int ai = 0; ai < 2; ++ai) { f32x4 xv[4][2][2];
#pragma unroll
                for (int m = 0; m < 4; ++m)
#pragma unroll
                    for (int bj = 0; bj < 2; ++bj)
#pragma unroll
                        for (int n = 0; n < 2; ++n) xv[m][bj][n] = *(const f32x4*)(x + (size_t)(row0 + ai * 128 + m * 16) * 1024 + c0 + 128 * bj + 16 * n);
#pragma unroll
                for (int m = 0; m < 4; ++m)
#pragma unroll
                    for (int bj = 0; bj < 2; ++bj)
#pragma unroll
                        for (int n = 0; n < 2; ++n) t += xv[m][bj][n] + acc[ai][bj][m][n];
                asm volatile("" ::: "memory"); }
            asm volatile("" :: "v"(t)); return; }
        if (mode == 4) {
#pragma unroll
            for (int ai = 0; ai < 2; ++ai)
#pragma unroll
                for (int m = 0; m < 4; ++m)
#pragma unroll
                    for (int bj = 0; bj < 2; ++bj)
#pragma unroll
                        for (int n = 0; n < 2; ++n) { const int row = u.pm * 256 + wr * 64 + ai * 128 + m * 16 + (fr & ~1) + n; const int col = u.pn * 256 + 128 * bj + 32 * wc + ((fr & 1) * 4 + fq) * 4;
                            const size_t off = (size_t)row * 1024 + col; const f32x4 v = acc[ai][bj][m][n];
                            *(f32x4*)(X1F + off) = v; u32x2 w; w.x = cvt_pk_bf16(v[0], v[1]); w.y = cvt_pk_bf16(v[2], v[3]); *(u32x2*)(X1B + off) = w; }
            return; }
        if (mode == 3) {
#pragma unroll
            for (int ai = 0; ai < 2; ++ai)
#pragma unroll
                for (int m = 0; m < 4; ++m)
#pragma unroll
                    for (int bj = 0; bj < 2; ++bj)
#pragma unroll
                        for (int n = 0; n < 2; ++n) { const size_t off = (size_t)(row0 + ai * 128 + m * 16) * 1024 + c0 + 128 * bj + 16 * n; const f32x4 v = acc[ai][bj][m][n];
                            *(f32x4*)(X1F + off) = v; u32x2 w; w.x = cvt_pk_bf16(v[0], v[1]); w.y = cvt_pk_bf16(v[2], v[3]); *(u32x2*)(X1B + off) = w; }
            return; }
#endif
#pragma unroll
        for (int ai = 0; ai < 2; ++ai) {
            f32x4 xv[4][2][2];
#pragma unroll
            for (int m = 0; m < 4; ++m)
#pragma unroll
                for (int bj = 0; bj < 2; ++bj)
#pragma unroll
                    for (int n = 0; n < 2; ++n) xv[m][bj][n] = __builtin_nontemporal_load((const f32x4*)(x + (size_t)(row0 + ai * 128 + m * 16) * 1024 + c0 + 128 * bj + 16 * n));
#pragma unroll
            for (int m = 0; m < 4; ++m) {
                const int row = row0 + ai * 128 + m * 16; float ss = 0.f;
#pragma unroll
                for (int bj = 0; bj < 2; ++bj)
#pragma unroll
                    for (int n = 0; n < 2; ++n) {
                        const size_t off = (size_t)row * 1024 + c0 + 128 * bj + 16 * n;
                        const f32x4 v = xv[m][bj][n] + acc[ai][bj][m][n];
                        ss += sumsq4(v);
                        u32x2 w; w.x = cvt_pk_bf16(v[0], v[1]); w.y = cvt_pk_bf16(v[2], v[3]); st_hint<NT_X1B != 0>(w, (u32x2*)(X1B + off));
                    }
                ss = red_fq(ss);
                if (fq == 0) SSX1[(size_t)row * 16 + u.pn * 4 + wc] = ss;
            }
            asm volatile("" ::: "memory");
        }
    }
};

struct EpiE {
    static constexpr bool PERM = true, AFTER_DRAIN = false;
    bf16* ER; float* SSE;
    __device__ __forceinline__ void operator()(AccRef acc, const pg8::Unit& u, int wr, int wc, int, int) const {
        int ln_ = lane_id(); asm volatile("" : "+v"(ln_)); const int fr = ln_ & 15, fq = ln_ >> 4;
        const int row0 = u.pm * 256 + wr * 64 + fr, lc0 = u.pn * 256 + 64 * wc + 8 * fq;
#pragma unroll
        for (int ai = 0; ai < 2; ++ai)
#pragma unroll
            for (int m = 0; m < 4; ++m) {
                const int row = row0 + ai * 128 + m * 16;
                float ss = (sumsq4(acc[ai][0][m][0]) + sumsq4(acc[ai][0][m][1])) + (sumsq4(acc[ai][1][m][0]) + sumsq4(acc[ai][1][m][1]));
                ss = red_fq(ss);
                if (fq == 0) SSE[(size_t)row * 16 + u.pn * 4 + wc] = ss;
                bf16* dst = ER + (size_t)row * 1024 + lc0;
#pragma unroll
                for (int bj = 0; bj < 2; ++bj) st8(dst + 32 * bj, acc[ai][bj][m][0], acc[ai][bj][m][1]);
            }
    }
};

struct Epi5 {
    static constexpr bool PERM = false, AFTER_DRAIN = false;
    float* __restrict__ out; const bf16* __restrict__ X1B; const bf16* __restrict__ ER; const float* __restrict__ SSX1; const float* __restrict__ SSE; const float* __restrict__ gpost;
    __device__ __forceinline__ void operator()(AccRef acc, const pg8::Unit& u, int wr, int wc, int, int) const {
        int ln_ = lane_id(); asm volatile("" : "+v"(ln_)); const int fr = ln_ & 15, fq = ln_ >> 4;
        const int row0 = u.pm * 256 + wr * 64 + fr, c0 = u.pn * 256 + 32 * wc + 4 * fq;
        f32x4 gp[2][2];
#pragma unroll
        for (int bj = 0; bj < 2; ++bj)
#pragma unroll
            for (int n = 0; n < 2; ++n) gp[bj][n] = *(const f32x4*)(gpost + c0 + 128 * bj + 16 * n);
#pragma unroll
        for (int ai = 0; ai < 2; ++ai)
#pragma unroll
            for (int mp = 0; mp < 2; ++mp) {
                f32x4 sa[2], sb[2]; u32x2 xv[2][2][2], ev[2][2][2];
#pragma unroll
                for (int mm = 0; mm < 2; ++mm) { const int row = row0 + ai * 128 + (2 * mp + mm) * 16;
                    sa[mm] = *(const f32x4*)(SSX1 + (size_t)row * 16 + 4 * fq); sb[mm] = *(const f32x4*)(SSE + (size_t)row * 16 + 4 * fq);
#pragma unroll
                    for (int bj = 0; bj < 2; ++bj)
#pragma unroll
                        for (int n = 0; n < 2; ++n) { const size_t off = (size_t)row * 1024 + c0 + 128 * bj + 16 * n; xv[mm][bj][n] = ld_hint<NT_X1ER != 0>((const u32x2*)(X1B + off)); ev[mm][bj][n] = ld_hint<NT_X1ER != 0>((const u32x2*)(ER + off)); } }
#pragma unroll
                for (int mm = 0; mm < 2; ++mm) { const int m = 2 * mp + mm, row = row0 + ai * 128 + m * 16;
                    const float s1 = red_fq((sa[mm][0] + sa[mm][1]) + (sa[mm][2] + sa[mm][3])), se = red_fq((sb[mm][0] + sb[mm][1]) + (sb[mm][2] + sb[mm][3]));
                    const float r1 = rsqrtf(s1 * (1.0f / 1024.0f) + EPS), re = rsqrtf(se * (1.0f / 1024.0f) + EPS);
#pragma unroll
                    for (int bj = 0; bj < 2; ++bj)
#pragma unroll
                        for (int n = 0; n < 2; ++n) {
                            const size_t off = (size_t)row * 1024 + c0 + 128 * bj + 16 * n;
                            const u32x2 xw = xv[mm][bj][n]; const f32x4 x1 = (f32x4){bflo(xw.x), bfhi(xw.x), bflo(xw.y), bfhi(xw.y)}; const u32x2 e = ev[mm][bj][n];
                            const f32x4 a = acc[ai][bj][m][n] * r1; f32x4 em = (f32x4){bflo(e.x), bfhi(e.x), bflo(e.y), bfhi(e.y)}; em = em * gp[bj][n] * re;
                            f32x4 o;
#pragma unroll
                            for (int q = 0; q < 4; ++q) o[q] = x1[q] + sigmoidf_(a[q]) * em[q];
                            __builtin_nontemporal_store(o, (f32x4*)(out + off));
                        } }
                asm volatile("" ::: "memory");
            }
    }
};

__device__ __forceinline__ float wave_sum(float v) {
#pragma unroll
    for (int o = 1; o < 64; o <<= 1) v += __shfl_xor(v, o);
    return v;
}
struct TrDesc { const float* W; const float* kg; bf16* WT; int ldw, srcc0, krows, K, drow0, k0; };
__device__ __forceinline__ void tr_load(const TrDesc& d, f32x4 (&v)[8], int lane) {
#pragma unroll
    for (int i = 0; i < 8; ++i) { const int kk = 8 * i + (lane >> 3), k = d.k0 + kk; v[i] = (f32x4){0.f, 0.f, 0.f, 0.f};
        if (d.srcc0 >= 0 && k < d.krows) { v[i] = ld_hint<NT_WLD != 0>((const f32x4*)(d.W + (size_t)k * d.ldw + d.srcc0 + 4 * (lane & 7))); if (d.kg) v[i] = v[i] * d.kg[k]; } }
}
__device__ __forceinline__ void tr_store(const TrDesc& d, const f32x4 (&v)[8], LAS float* scr, int lane) {
#pragma unroll
    for (int i = 0; i < 8; ++i) { LAS float* p_ = scr + (8 * i + (lane >> 3)) * 33 + 4 * (lane & 7); p_[0] = v[i][0]; p_[1] = v[i][1]; p_[2] = v[i][2]; p_[3] = v[i][3]; }
    LDS_WAIT(); asm volatile("" ::: "memory");
    const int c = lane & 7;
#pragma unroll
    for (int j = 0; j < 4; ++j) { const int n = (lane >> 3) + 8 * j; const LAS float* s = scr + (8 * c) * 33 + n;
        u32x4 o; o.x = pk2(s[0 * 33], s[1 * 33]); o.y = pk2(s[2 * 33], s[3 * 33]); o.z = pk2(s[4 * 33], s[5 * 33]); o.w = pk2(s[6 * 33], s[7 * 33]);
        *(u32x4*)(d.WT + (size_t)(d.drow0 + n) * d.K + d.k0 + 8 * c) = o; }
    LDS_WAIT(); asm volatile("" ::: "memory");
}
__device__ __forceinline__ void sincos_red(double a, double& s, double& c) {
    const double k = rint(a * 0.63661977236758134308); const double r = fma(-k, 6.123233995736766e-17, fma(-k, 1.5707963267948966, a)); const double r2 = r * r;
    double sp = -1.0 / 1307674368000.0; sp = fma(sp, r2, 1.0 / 6227020800.0); sp = fma(sp, r2, -1.0 / 39916800.0); sp = fma(sp, r2, 1.0 / 362880.0); sp = fma(sp, r2, -1.0 / 5040.0); sp = fma(sp, r2, 1.0 / 120.0); sp = fma(sp, r2, -1.0 / 6.0); sp = fma(sp * r2, r, r);
    double cp = 1.0 / 20922789888000.0; cp = fma(cp, r2, -1.0 / 87178291200.0); cp = fma(cp, r2, 1.0 / 479001600.0); cp = fma(cp, r2, -1.0 / 3628800.0); cp = fma(cp, r2, 1.0 / 40320.0); cp = fma(cp, r2, -1.0 / 720.0); cp = fma(cp, r2, 1.0 / 24.0); cp = fma(cp, r2, -0.5); cp = fma(cp, r2, 1.0);
    const int q = (int)k & 3;
    s = (q == 0) ? sp : (q == 1) ? cp : (q == 2) ? -sp : -cp; c = (q == 0) ? cp : (q == 1) ? -sp : (q == 2) ? -cp : sp;
}
__device__ __forceinline__ int hp_row(int L0) { const int lc = L0 & 255; return (L0 & ~255) + 128 * ((lc >> 5) & 1) + 32 * (lc >> 6); }

constexpr int TR_I1 = (N1 / 32) * 16, TR_I2 = 32 * 16, TR_I5 = 48 * 4, TR_I6 = 32 * 2, TR_I7 = 32 * 4;
constexpr int TR_EARLY = TR_I1 + TR_I5 + 2 * TR_I6, TR_ALL = TR_EARLY + 4 * TR_I2 + TR_I7;
__device__ __forceinline__ TrDesc tr_decode(const Args& a, int it) {
    unsigned char* ws = a.ws;
    constexpr int I1 = TR_I1, I2 = TR_I2, I5 = TR_I5, I6 = TR_I6;
    {
        int r = it;
        if (r < I1) { const int nb = r / 16, kb = r % 16, L0 = nb * 32; int src = L0 < 2720 ? L0 : (L0 < 2816 ? -1 : L0 - 96);
            if (L0 >= 3840) { const int j = (L0 - 3840) >> 8, lc = L0 & 255, wc_ = lc >> 6, bj_ = (lc >> 5) & 1; src = (bj_ ? 4768 : 3744) + 128 * j + 32 * wc_; }
            return TrDesc{a.in[4], nullptr, (bf16*)(ws + WS_BT1), DIN, src, 1024, 1024, hp_row(L0), kb * 64}; } r -= I1;
        if (r < I5) { const int nb = r / 4, kb = r % 4, L0 = nb * 32; const int src = L0 < 1024 ? (L0 >> 6) * 96 + (L0 & 63) : ((L0 - 1024) >> 5) * 96 + 64;
            return TrDesc{a.in[11], a.in[10], (bf16*)(ws + WS_BT2), 1536, src, 256, 256, hp_row(L0), kb * 64}; } r -= I5;
        if (r < I6) { const int nb = r / 2, kb = r % 2; return TrDesc{a.in[13], a.in[12], (bf16*)(ws + WS_BT2) + (size_t)1536 * 256, 1024, nb * 32, 128, 128, hp_row(nb * 32), kb * 64}; } r -= I6;
        if (r < I6) { const int nb = r / 2, kb = r % 2; return TrDesc{a.in[14], a.in[12], (bf16*)(ws + WS_BT2) + (size_t)1536 * 256 + (size_t)1024 * 128, 1024, nb * 32, 128, 128, hp_row(nb * 32), kb * 64}; } r -= I6;
        if (r < I2) { const int nb = r / 16, kb = r % 16; return TrDesc{a.in[9], nullptr, (bf16*)(ws + WS_BT3), 1024, nb * 32, 1024, 2048, hp_row(nb * 32), kb * 64}; } r -= I2;
        if (r < I2) { const int nb = r / 16, kb = r % 16; return TrDesc{a.in[18], nullptr, (bf16*)(ws + WS_BT3) + 1024, 1024, nb * 32, 1024, 2048, hp_row(nb * 32), kb * 64}; } r -= I2;
        if (r < I2) { const int nb = r / 16, kb = r % 16; return TrDesc{a.in[19], nullptr, (bf16*)(ws + WS_WOUT), 1024, nb * 32, 1024, 1024, nb * 32, kb * 64}; } r -= I2;
        if (r < I2) { const int nb = r / 16, kb = r % 16; return TrDesc{a.in[21], a.in[20], (bf16*)(ws + WS_WG), 1024, nb * 32, 1024, 1024, nb * 32, kb * 64}; } r -= I2;
        { const int nb = r / 4, kb = r % 4; return TrDesc{a.in[22], nullptr, (bf16*)(ws + WS_WPP), 1024, nb * 32, 256, 256, hp_row(nb * 32), kb * 64}; }
    }
}

__device__ __forceinline__ void tr_items(Frame& F, const Args& a, int it0, int it1, int worker, int nworkers) {
    LAS float* scr = (LAS float*)(F.lds + F.wave * 16384);
    const int lane = F.lane;
    for (int it = it0 + worker; it < it1; it += 2 * nworkers) {
        const bool two = it + nworkers < it1;
        const TrDesc d0 = tr_decode(a, it), d1 = tr_decode(a, two ? it + nworkers : it);
        f32x4 v0[8], v1[8];
        tr_load(d0, v0, lane); if (two) tr_load(d1, v1, lane);
        tr_store(d0, v0, scr, lane); if (two) tr_store(d1, v1, scr, lane);
    }
}

__device__ __forceinline__ void p0_prologue(Frame& F, const Args& a) {
    unsigned char* ws = a.ws;
    const int gw = F.vcu * NWAVES + F.wave, NGW = F.G * NWAVES, lane = F.lane;
    tr_items(F, a, 0, TR_EARLY, gw, NGW);
    FSTAMP(F, 10);
    {
        const float* x = a.in[0]; const float* g = a.in[3]; bf16* XN = (bf16*)(ws + WS_XN);
        f32x4 gv[4];
#pragma unroll
        for (int j = 0; j < 4; ++j) gv[j] = *(const f32x4*)(g + 4 * lane + 256 * j);
        for (int m = gw; m < T; m += 4 * NGW) {
            f32x4 v[4][4]; float ssq[4];
#pragma unroll
            for (int r = 0; r < 4; ++r) { const int mr = m + r * NGW < T ? m + r * NGW : m; const f32x4* xr = (const f32x4*)(x + (size_t)mr * DM) + lane;
#pragma unroll
                for (int j = 0; j < 4; ++j) v[r][j] = __builtin_nontemporal_load(xr + 64 * j); }
#pragma unroll
            for (int r = 0; r < 4; ++r) { float s_ = 0.f;
#pragma unroll
                for (int j = 0; j < 4; ++j) s_ += sumsq4(v[r][j]);
                ssq[r] = s_; }
#pragma unroll
            for (int o = 1; o < 64; o <<= 1) {
#pragma unroll
                for (int r = 0; r < 4; ++r) ssq[r] += __shfl_xor(ssq[r], o); }
#pragma unroll
            for (int r = 0; r < 4; ++r) { const int mr = m + r * NGW; if (mr < T) { const float rr = rsqrtf(ssq[r] * (1.0f / DM) + EPS);
                unsigned long long* o8 = (unsigned long long*)(XN + (size_t)mr * DM) + lane;
#pragma unroll
                for (int j = 0; j < 4; ++j) { const f32x4 w = v[r][j] * gv[j] * rr; o8[64 * j] = (unsigned long long)cvt_pk_bf16(w[0], w[1]) | ((unsigned long long)cvt_pk_bf16(w[2], w[3]) << 32); } } }
        }
    }
    FSTAMP(F, 11);
    {
        const int gt = F.vcu * NTHR + F.tid, NGT = F.G * NTHR; const int* pos = (const int*)a.in[2]; float* rope = (float*)(ws + WS_ROPE);
        float invf_c = (float)exp2(-(double)(gt & 15) * (13.287712379549449 / 16.0));
        for (int e = gt; e < T * 16; e += NGT) { const int row = e >> 4, i = e & 15;
            const float invf = (NGT & 15) == 0 ? invf_c : (float)exp2(-(double)i * (13.287712379549449 / 16.0)); const float ang = (float)pos[row] * invf;
            double sv, cv; sincos_red((double)ang, sv, cv); rope[(size_t)row * 32 + i] = (float)cv; rope[(size_t)row * 32 + 16 + i] = (float)sv; }
        float* bt = (float*)(ws + WS_BT); const float* rb = a.in[8];
        for (int e = gt; e < 16 * 128; e += NGT) { const int h = e >> 7, d = e & 127;
            int b = d; if (d >= 16) { b = 16 + (int)(logf((float)d * (1.0f / 16.0f)) / logf(8.0f) * 16.0f); b = b < 31 ? b : 31; }
            bt[e] = rb[b * 16 + h] * LOG2E; }
    }
    FSTAMP(F, 12);
}
__device__ __forceinline__ void p_to_bf16(Frame& F, const Args& a, int worker, int nworkers) {
    const int gt = worker * NTHR + F.tid, NGT = nworkers * NTHR; const f32x4* p = (const f32x4*)a.in[1]; u32x2* o = (u32x2*)(a.ws + WS_PB);
    for (int e = gt; e < T * 256 / 4; e += NGT) { const f32x4 v = ld_hint<NT_PLD != 0>(p + e); u32x2 w; w.x = cvt_pk_bf16(v[0], v[1]); w.y = cvt_pk_bf16(v[2], v[3]); st_hint<NT_PST != 0>(w, o + e); }
}

__device__ __forceinline__ void cvt8(u32x4 w, LAS float* d) {
    *(LAS f32x4*)d = (f32x4){bflo(w.x), bfhi(w.x), bflo(w.y), bfhi(w.y)}; *(LAS f32x4*)(d + 4) = (f32x4){bflo(w.z), bfhi(w.z), bflo(w.w), bfhi(w.w)};
}
__device__ __forceinline__ void mla_simple(Frame& F, const Args& a) {
    unsigned char* ws = a.ws;
    const bf16 *QBN = (const bf16*)(ws + WS_QBN), *QBR = (const bf16*)(ws + WS_QBR), *KN = (const bf16*)(ws + WS_KN), *KR = (const bf16*)(ws + WS_KR), *VB = (const bf16*)(ws + WS_VB);
    const bf16* SZB = (const bf16*)a.out + (size_t)T * 1024; bf16* AB = (bf16*)(ws + WS_QBN);
    const float *SSCQ = (const float*)(ws + WS_SSCQ), *rope = (const float*)(ws + WS_ROPE), *gq = a.in[15];
    LAS float* Kf = (LAS float*)F.lds; LAS float* Vf = Kf + 64 * 96;
    const int tid = F.tid;
    for (int ui = F.vcu; ui < 1024; ui += F.G) {
        const int bh = ui & 63, s = ui >> 6; const int qb = ((s >> 2) & 1) ? 4 * (s >> 2) + 3 - (s & 3) : 4 * (s >> 2) + (s & 3);
        const int b = bh >> 4, h = bh & 15; const int qpos = qb * 512 + tid; const size_t row = (size_t)b * SEQ + qpos;
        f32x4 q[24];
        {
            const u32x4* qn = (const u32x4*)(QBN + row * 1024 + h * 64); const u32x4* qr = (const u32x4*)(QBR + row * 512 + h * 32);
#pragma unroll
            for (int c = 0; c < 12; ++c) { const u32x4 w = c < 8 ? qn[c] : qr[c - 8];
                q[2 * c] = (f32x4){bflo(w.x), bfhi(w.x), bflo(w.y), bfhi(w.y)}; q[2 * c + 1] = (f32x4){bflo(w.z), bfhi(w.z), bflo(w.w), bfhi(w.w)}; }
            const float* SSQ = (const float*)(ws + WS_SSQ); const float ss = SSQ[row * 32 + h] + SSQ[row * 32 + 16 + h];
            const f32x4 sc = *(const f32x4*)(SSCQ + row * 4);
            const float msl = ((sc[0] + sc[1]) + (sc[2] + sc[3])) * (1.0f / 256.0f) + EPS;
            const float r = rsqrtf(ss * (1.0f / 96.0f) + EPS * msl);
#pragma unroll
            for (int c = 0; c < 24; ++c) q[c] = q[c] * r;
#pragma unroll
            for (int c = 0; c < 24; ++c) q[c] = q[c] * QB_SCALE;
        }
        f32x4 o[16];
#pragma unroll
        for (int c = 0; c < 16; ++c) o[c] = (f32x4){0.f, 0.f, 0.f, 0.f};
        float mrun = -INFINITY, l = 0.f;
        const int nkt = (qb + 1) * 8;
        for (int kt = 0; kt < nkt; ++kt) {
            __syncthreads();
            { const int key = tid >> 3, ch = tid & 7; const size_t kr = (size_t)b * SEQ + kt * 64 + key;
              cvt8(*(const u32x4*)(KN + kr * 1024 + h * 64 + ch * 8), Kf + key * 96 + ch * 8);
              cvt8(*(const u32x4*)(VB + kr * 1024 + h * 64 + ch * 8), Vf + key * 64 + ch * 8);
              if (tid < 256) { const int k2 = tid >> 2, c2 = tid & 3; cvt8(*(const u32x4*)(KR + ((size_t)b * SEQ + kt * 64 + k2) * 32 + c2 * 8), Kf + k2 * 96 + 64 + c2 * 8); } }
            __syncthreads();
            for (int c8 = 0; c8 < 8; ++c8) {
                float sv[8]; float cm = -INFINITY;
#pragma unroll
                for (int j = 0; j < 8; ++j) { const LAS f32x4* kp = (const LAS f32x4*)(Kf + (c8 * 8 + j) * 96); f32x4 acc = q[0] * kp[0];
#pragma unroll
                    for (int c = 1; c < 24; ++c) acc += q[c] * kp[c];
                    float sj = (acc[0] + acc[1]) + (acc[2] + acc[3]);
                    if (kt * 64 + c8 * 8 + j > qpos) sj = -INFINITY;
                    sv[j] = sj; cm = fmaxf(cm, sj); }
                const float mn = fmaxf(mrun, cm), f = __builtin_amdgcn_exp2f(mrun - mn); mrun = mn; l *= f;
#pragma unroll
                for (int c = 0; c < 16; ++c) o[c] = o[c] * f;
#pragma unroll
                for (int j = 0; j < 8; ++j) { const float p = __builtin_amdgcn_exp2f(sv[j] - mn); l += p; const LAS f32x4* vp = (const LAS f32x4*)(Vf + (c8 * 8 + j) * 64);
#pragma unroll
                    for (int c = 0; c < 16; ++c) o[c] += vp[c] * p; }
            }
        }
        const float rl = 1.0f / l;
        const u32x4* sz = (const u32x4*)(SZB + row * 1024 + h * 64); u32x4* dst = (u32x4*)(AB + row * 1024 + h * 64);
#pragma unroll
        for (int c = 0; c < 8; ++c) { const u32x4 g = sz[c]; f32x4 v0 = o[2 * c] * rl, v1 = o[2 * c + 1] * rl;
            v0[0] *= bflo(g.x); v0[1] *= bfhi(g.x); v0[2] *= bflo(g.y); v0[3] *= bfhi(g.y); v1[0] *= bflo(g.z); v1[1] *= bfhi(g.z); v1[2] *= bflo(g.w); v1[3] *= bfhi(g.w);
            u32x4 w; w.x = cvt_pk_bf16(v0[0], v0[1]); w.y = cvt_pk_bf16(v0[2], v0[3]); w.z = cvt_pk_bf16(v1[0], v1[1]); w.w = cvt_pk_bf16(v1[2], v1[3]); dst[c] = w; }
    }
    __syncthreads();
}
__device__ __forceinline__ void swa_simple(Frame& F, const Args& a) {
    unsigned char* ws = a.ws;
    const bf16 *QA = (const bf16*)(ws + WS_QA), *KVA = (const bf16*)(ws + WS_KVA); const bf16* SZA = (const bf16*)a.out; bf16* AA = (bf16*)(ws + WS_QA);
    const float *bt = (const float*)(ws + WS_BT), *sinks = a.in[7];
    LAS float* Kf = (LAS float*)F.lds; LAS float* Vf = Kf + 256 * 64;
    const int tid = F.tid;
    for (int ui = F.vcu; ui < 256; ui += F.G) {
        const int b = ui >> 6, nblk = ui & 63;
        for (int g = 0; g < 2; ++g) {
            __syncthreads();
            for (int e = tid; e < 256 * 8; e += NTHR) { const int c = e >> 3, ch = e & 7; const int tok = (nblk - 1) * 128 + c;
                if (tok >= 0) { const size_t kr = (size_t)b * SEQ + tok;
                    cvt8(*(const u32x4*)(KVA + kr * 256 + g * 64 + ch * 8), Kf + c * 64 + ch * 8);
                    cvt8(*(const u32x4*)(KVA + kr * 256 + 128 + g * 64 + ch * 8), Vf + c * 64 + ch * 8); }
                else { const u32x4 z = (u32x4){0u, 0u, 0u, 0u}; cvt8(z, Kf + c * 64 + ch * 8); cvt8(z, Vf + c * 64 + ch * 8); } }
            __syncthreads();
            for (int itr = 0; itr < 2; ++itr) {
                const int p = tid + NTHR * itr, ql = p & 127, head = g * 8 + (p >> 7); const int ql0 = ql & ~63;
                const size_t row = (size_t)b * SEQ + nblk * 128 + ql;
                f32x4 q[16];
                { const u32x4* qp = (const u32x4*)(QA + row * 1024 + head * 64);
#pragma unroll
                  for (int c = 0; c < 8; ++c) { const u32x4 w = qp[c]; q[2 * c] = (f32x4){bflo(w.x), bfhi(w.x), bflo(w.y), bfhi(w.y)}; q[2 * c + 1] = (f32x4){bflo(w.z), bfhi(w.z), bflo(w.w), bfhi(w.w)}; } }
                f32x4 o[16];
#pragma unroll
                for (int c = 0; c < 16; ++c) o[c] = (f32x4){0.f, 0.f, 0.f, 0.f};
                float mrun = sinks[head] * LOG2E, l = 1.0f;
                const float* bth = bt + head * 128;
                for (int c0 = ql0 + 1; c0 < ql0 + 192; c0 += 8) {
                    float sv[8]; float cm = -INFINITY;
#pragma unroll
                    for (int j = 0; j < 8; ++j) { const int c = c0 + j; const int cc = c < 256 ? c : 255; const LAS f32x4* kp = (const LAS f32x4*)(Kf + cc * 64); f32x4 acc = q[0] * kp[0];
#pragma unroll
                        for (int d = 1; d < 16; ++d) acc += q[d] * kp[d];
                        const int dist = ql + 128 - c; const bool valid = dist >= 0 && dist < 128 && c < 256 && !(nblk == 0 && c < 128);
                        float sj = (acc[0] + acc[1]) + (acc[2] + acc[3]) + bth[dist & 127];
                        sj = valid ? sj : -INFINITY; sv[j] = sj; cm = fmaxf(cm, sj); }
                    const float mn = fmaxf(mrun, cm), f = __builtin_amdgcn_exp2f(mrun - mn); mrun = mn; l *= f;
#pragma unroll
                    for (int d = 0; d < 16; ++d) o[d] = o[d] * f;
#pragma unroll
                    for (int j = 0; j < 8; ++j) { const int c = c0 + j; const int cc = c < 256 ? c : 255; const float pj = __builtin_amdgcn_exp2f(sv[j] - mn); l += pj; const LAS f32x4* vp = (const LAS f32x4*)(Vf + cc * 64);
#pragma unroll
                        for (int d = 0; d < 16; ++d) o[d] += vp[d] * pj; }
                }
                const float rl = 1.0f / l;
                const u32x4* sz = (const u32x4*)(SZA + row * 1024 + head * 64); u32x4* dst = (u32x4*)(AA + row * 1024 + head * 64);
#pragma unroll
                for (int c = 0; c < 8; ++c) { const u32x4 gz = sz[c]; f32x4 v0 = o[2 * c] * rl, v1 = o[2 * c + 1] * rl;
                    v0[0] *= bflo(gz.x); v0[1] *= bfhi(gz.x); v0[2] *= bflo(gz.y); v0[3] *= bfhi(gz.y); v1[0] *= bflo(gz.z); v1[1] *= bfhi(gz.z); v1[2] *= bflo(gz.w); v1[3] *= bfhi(gz.w);
                    u32x4 w; w.x = cvt_pk_bf16(v0[0], v0[1]); w.y = cvt_pk_bf16(v0[2], v0[3]); w.z = cvt_pk_bf16(v1[0], v1[1]); w.w = cvt_pk_bf16(v1[2], v1[3]); dst[c] = w; }
            }
        }
    }
    __syncthreads();
}

__device__ __forceinline__ void swa_phase(Frame& F, const Args& a) {
    unsigned char* ws = a.ws;
    unsigned* qctr = (unsigned*)(ws + WS_CTL + 8192); volatile LAS unsigned* qw = (volatile LAS unsigned*)(F.lds + LDS_BYTES - 128);
    const bool asker = F.wave == 0 && lane_id() == 0;
    unsigned got = 0u; if (asker) got = __hip_atomic_fetch_add(qctr, 1u, __ATOMIC_RELAXED, __HIP_MEMORY_SCOPE_AGENT);
    float gqm, gkm, rbm, skm;
    { const int l = F.lane; float v = fabsf(a.in[5][l]), w = fabsf(a.in[6][l]), z = 0.f, y = fabsf(a.in[7][l & 15]);
#pragma unroll
      for (int j = 0; j < 8; ++j) z = fmaxf(z, fabsf(a.in[8][l + 64 * j]));
#pragma unroll
      for (int o = 1; o < 64; o <<= 1) { v = fmaxf(v, __shfl_xor(v, o)); w = fmaxf(w, __shfl_xor(w, o)); z = fmaxf(z, __shfl_xor(z, o)); y = fmaxf(y, __shfl_xor(y, o)); }
      gqm = v; gkm = w; rbm = z; skm = y; }
    const float Mb = fmaxf(1.01f * QA_SCALE * 64.0f * gqm * gkm + rbm * LOG2E, skm * LOG2E);
    bool general = !(__builtin_amdgcn_readfirstlane(__float_as_int(Mb)) < __float_as_int(64.0f));
#ifdef FORCE_SIMPLE
    general = true;
#endif
    if (general) { swa_simple(F, a); return; }
#define SWA_UNIT(u) swa::swa_unit((u) >> 7, ((u) >> 1) & 63, (u) & 1, (const bf16*)(ws + WS_QA), (const bf16*)(ws + WS_KVA), (const bf16*)a.out, (bf16*)(ws + WS_QA), (const float*)(ws + WS_BT), a.in[7], F.lds, F.wave)
    for (;;) {
        if (asker) qw[0] = got;
        __syncthreads();
        const unsigned u = qw[0];
        if (u >= 512u) break;
        if (asker) got = __hip_atomic_fetch_add(qctr, 1u, __ATOMIC_RELAXED, __HIP_MEMORY_SCOPE_AGENT);
        SWA_UNIT((int)u);
    }
#undef SWA_UNIT
    __syncthreads();
}

#if defined(PROBE) && defined(PROBE_MLAV)
__device__ __forceinline__ void mla_probe_pass(Frame& F, const Args& a, char* lds) {
    unsigned char* ws = a.ws;
    const mla::Ptrs P{(const bf16*)(ws + WS_QBN), (const bf16*)(ws + WS_QBR), (const bf16*)(ws + WS_KN), (const bf16*)(ws + WS_KR), (const bf16*)(ws + WS_VB), (const bf16*)a.out + (size_t)T * 1024,
                      (bf16*)a.out, (const float*)(ws + WS_SSCQ), (const float*)(ws + WS_ROPE), a.in[15], (const float*)(ws + WS_SSQ), (float*)(ws + WS_RS), (unsigned long long*)(ws + WS_CTL + 4096)};
    for (int vv = F.vcu; vv < 256; vv += F.G) {
        const int bh = vv >> 2, s = vv & 3;
#ifndef PROBE_ULO
#define PROBE_ULO 0
#define PROBE_UHI 8
#endif
        mla::mla_cu<PROBE_MLAV>(bh, s, PROBE_ULO, PROBE_UHI, P, lds, F.wave);
    }
}
#endif
__device__ __forceinline__ void mla_phase(Frame& F, const Args& a, char* lds) {
    unsigned char* ws = a.ws;
    const mla::Ptrs P{(const bf16*)(ws + WS_QBN), (const bf16*)(ws + WS_QBR), (const bf16*)(ws + WS_KN), (const bf16*)(ws + WS_KR), (const bf16*)(ws + WS_VB), (const bf16*)a.out + (size_t)T * 1024,
                      (bf16*)(ws + WS_QBN), (const float*)(ws + WS_SSCQ), (const float*)(ws + WS_ROPE), a.in[15], (const float*)(ws + WS_SSQ), (float*)(ws + WS_RS), (unsigned long long*)(ws + WS_CTL + 4096)};
    float gqm, gknm, gkrm;
    { const int l = F.lane; float v = fmaxf(fabsf(a.in[15][l]), fabsf(a.in[15][64 + (l & 31)])), w = fabsf(a.in[16][l]), z = fabsf(a.in[17][l & 31]);
#pragma unroll
      for (int o = 1; o < 64; o <<= 1) { v = fmaxf(v, __shfl_xor(v, o)); w = fmaxf(w, __shfl_xor(w, o)); z = fmaxf(z, __shfl_xor(z, o)); }
      gqm = v; gknm = w; gkrm = z; }
    const float Mb = 1.01f * QB_SCALE * sqrtf(96.0f) * gqm * sqrtf(64.0f * gknm * gknm + 32.0f * gkrm * gkrm);
#ifdef FORCE_SIMPLE
    { mla_simple(F, a); return; }
#endif
    if (!(__builtin_amdgcn_readfirstlane(__float_as_int(Mb)) < __float_as_int(64.0f))) { mla_simple(F, a); return; }
    unsigned* qctr = (unsigned*)(ws + WS_CTL + 8192 + 256); volatile LAS unsigned* qw = (volatile LAS unsigned*)(F.lds + LDS_BYTES - 128);
    const bool asker = F.wave == 0 && lane_id() == 0, dyn = F.G == 256;
    int vv = F.vcu, bh = vv >> 2, s = vv & 3, ulo = dyn ? 1 : 0, uhi = 8;
    if (vv >= 256) return;
    mla::q_prep_units(bh, s, ulo, uhi, P, F.wave);
    for (;;) {
        mla::mla_cu<0>(bh, s, ulo, uhi, P, lds, F.wave);
        if (dyn) {
            if (asker) qw[0] = __hip_atomic_fetch_add(qctr, 1u, __ATOMIC_RELAXED, __HIP_MEMORY_SCOPE_AGENT);
            __syncthreads();
            const unsigned idx = qw[0];
            __syncthreads();
            if (idx >= 256u) break;
            bh = (int)(idx & 63u); s = 3 - (int)(idx >> 6); ulo = 0; uhi = 1;
            mla::q_prep_units(bh, s, 0, 1, P, F.wave);
        } else {
            vv += F.G; if (vv >= 256) break;
            bh = vv >> 2; s = vv & 3;
            mla::q_prep_units(bh, s, 0, 8, P, F.wave);
        }
    }
}

#define RLX_AGENT __ATOMIC_RELAXED, __HIP_MEMORY_SCOPE_AGENT
#define XB_TMO      128
#define XB_XCNT(j)  (256  + 64 * (j))
#define XB_XSUB(j)  (1280 + 64 * (j))
#define XB_XGEN(j)  (2304 + 64 * (j))
#define XB_TOP      3328
#define XB_TOPGEN   3392
#define XCD_BAR_WORDS 3456
#define XB_SPIN_CAP (1u << 18)

__device__ __forceinline__ unsigned xb_ld(unsigned* p)              { return __hip_atomic_load(p, __ATOMIC_RELAXED, __HIP_MEMORY_SCOPE_AGENT); }
__device__ __forceinline__ unsigned xb_add(unsigned* p, unsigned v) { return __hip_atomic_fetch_add(p, v, __ATOMIC_RELAXED, __HIP_MEMORY_SCOPE_AGENT); }
__device__ __forceinline__ unsigned xb_xcc_id() { return (unsigned)__builtin_amdgcn_s_getreg((3 << 11) | 20) & 0xFu; }
#define XB_SPIN(cond, bar) do { unsigned _sp = 0; while (cond) { __builtin_amdgcn_s_sleep(1); \
    if ((++_sp & 255u) == 0u) { if (xb_ld(&(bar)[XB_TMO])) break; if (_sp > XB_SPIN_CAP) { atomicAdd(&(bar)[XB_TMO], 1u); break; } } } } while (0)

struct XcdBarrier {
    unsigned* bar; unsigned x; bool leader;
    volatile LAS unsigned* st;
};

__device__ __forceinline__ XcdBarrier xcd_barrier_post(unsigned* bar, volatile LAS unsigned* st, bool leader) {
    XcdBarrier b; b.bar = bar; b.x = xb_xcc_id(); b.st = st; b.leader = leader;
    if (b.leader) (void)xb_add(&bar[XB_XCNT(b.x)], 1u);
    return b;
}
__device__ __forceinline__ void xcd_barrier_complete(unsigned* bar, unsigned x, unsigned& nloc, unsigned& nx) {
    const unsigned G = gridDim.x * gridDim.y * gridDim.z;
    unsigned sum, cnt, mine, sp = 0u;
    for (;;) {
        sum = 0u; cnt = 0u; mine = 0u;
#pragma unroll
        for (unsigned j = 0; j < 16; ++j) { const unsigned c = xb_ld(&bar[XB_XCNT(j)]); sum += c; cnt += (c > 0u) ? 1u : 0u; mine = (j == x) ? c : mine; }
        if (sum == G) break;
        __builtin_amdgcn_s_sleep(1);
        if ((++sp & 255u) == 0u) { if (xb_ld(&bar[XB_TMO])) break; if (sp > XB_SPIN_CAP) { atomicAdd(&bar[XB_TMO], 1u); break; } }
    }
    nloc = mine > 0u ? mine : 1u; nx = cnt > 0u ? cnt : 1u;
}

__device__ __forceinline__ void xcd_barrier(const XcdBarrier& b, bool leader) {
    asm volatile("s_waitcnt vmcnt(0)" ::: "memory");
    __syncthreads();
    if (leader) {
        unsigned* bar = b.bar;
        __builtin_amdgcn_s_waitcnt(0);
        unsigned nloc = b.st[0], nx = b.st[1];
        if (nloc == 0u) { xcd_barrier_complete(bar, b.x, nloc, nx); b.st[0] = nloc; b.st[1] = nx; }
        const unsigned old = xb_add(&bar[XB_XSUB(b.x)], 1u);
        const unsigned gen = old / nloc;
        if (old + 1u == (gen + 1u) * nloc) {
            __builtin_amdgcn_fence(__ATOMIC_RELEASE, "agent");
            asm volatile("s_waitcnt vmcnt(0)" ::: "memory");
            const unsigned og = xb_add(&bar[XB_TOP], 1u);
            const unsigned tg = og / nx;
            if (og + 1u == (tg + 1u) * nx) xb_add(&bar[XB_TOPGEN], 1u);
            else XB_SPIN(xb_ld(&bar[XB_TOPGEN]) == tg, bar);
            __builtin_amdgcn_fence(__ATOMIC_ACQUIRE, "agent");
            xb_add(&bar[XB_XGEN(b.x)], 1u);
            asm volatile("s_waitcnt vmcnt(0)" ::: "memory");
        } else {
            XB_SPIN(xb_ld(&bar[XB_XGEN(b.x)]) == gen, bar);
            __builtin_amdgcn_fence(__ATOMIC_ACQUIRE, "agent");
            asm volatile("s_waitcnt vmcnt(0)" ::: "memory");
        }
    }
    __syncthreads();
}

__device__ __forceinline__ void grid_barrier(unsigned* ctr, unsigned target, int wave) {
    asm volatile("s_waitcnt vmcnt(0) lgkmcnt(0)" ::: "memory");
    __syncthreads();
    if (wave == 0 && lane_id() == 0) {
        __builtin_amdgcn_fence(__ATOMIC_RELEASE, "agent");
        asm volatile("s_waitcnt vmcnt(0)" ::: "memory");
        __hip_atomic_fetch_add(ctr, 1u, __ATOMIC_RELAXED, __HIP_MEMORY_SCOPE_AGENT);
        const unsigned long long t0 = __builtin_amdgcn_s_memrealtime();
        while (__hip_atomic_load(ctr, __ATOMIC_RELAXED, __HIP_MEMORY_SCOPE_AGENT) < target) {
            __builtin_amdgcn_s_sleep(2);
            if (__builtin_amdgcn_s_memrealtime() - t0 > 200000000ull) break;
        }
        __builtin_amdgcn_fence(__ATOMIC_ACQUIRE, "agent");
        asm volatile("s_waitcnt vmcnt(0)" ::: "memory");
    }
    __syncthreads();
}

constexpr int NPHASE = 7;
__global__ void __launch_bounds__(NTHR, 2) mk_fwd(Args a) {
    extern __shared__ __attribute__((aligned(16))) unsigned char lds[];
    cg::grid_group grid = cg::this_grid();
    Frame F; F.lds = (LAS unsigned char*)lds; F.wave = __builtin_amdgcn_readfirstlane((int)threadIdx.x >> 6); F.lane = lane_id(); F.tid = F.wave * 64 + F.lane;
    F.G = gridDim.x; { const int bx = blockIdx.x; F.vcu = (F.G % 8 == 0) ? (bx % 8) * (F.G / 8) + bx / 8 : bx; }
    unsigned char* ws = a.ws;
    const int lo = a.ph_lo, hi = a.ph_hi;
#define IN(k) (lo <= (k) && (k) < hi)
#define RELANE() do { F.lane = lane_id(); F.tid = F.wave * 64 + F.lane; } while (0)
    volatile LAS unsigned* xst = (volatile LAS unsigned*)(F.lds + LDS_BYTES - 256);
    if (F.wave == 0 && lane_id() < 2) xst[lane_id() & 1] = 0u;
    __syncthreads();
    const XcdBarrier xbar = xcd_barrier_post((unsigned*)(ws + WS_CTL + 16384), xst, F.wave == 0 && lane_id() == 0);
#ifdef PROBE_BAR
    for (int i_ = 0; i_ < 8; ++i_) xcd_barrier(xbar, F.wave == 0 && lane_id() == 0);
#endif
#if defined(PROBE) && defined(PROBE_IMBP)
#define IMBREC(k) do { if ((k) == PROBE_IMBP && F.wave == 0 && lane_id() == 0) { const unsigned long long t_ = __builtin_amdgcn_s_memrealtime(); atomicMin(&pts[20], t_); atomicMax(&pts[21], t_); } } while (0)
#else
#define IMBREC(k) do { } while (0)
#endif
#define SEAM(k) do { IMBREC(k); if (IN(k) && IN((k) + 1)) xcd_barrier(xbar, F.wave == 0 && lane_id() == 0); STAMP((k) + 1); } while (0)
#ifdef PROBE
    unsigned long long* pts = (unsigned long long*)(ws + WS_CTL + 4096); F.pts = pts;
#define STAMP(k) do { if (blockIdx.x == 0 && F.wave == 0 && lane_id() == 0) pts[k] = __builtin_amdgcn_s_memrealtime(); } while (0)
#else
#define STAMP(k) do { } while (0)
#endif
    STAMP(0);
#if defined(PROBE) && (defined(PROBE_IMB) || defined(PROBE_IMBP))
    if (blockIdx.x == 0 && F.wave == 0 && lane_id() == 0) pts[20] = ~0ull;
#endif
    if (lo > hi) grid.sync();
    bf16* SZA = (bf16*)a.out; bf16* SZB = SZA + (size_t)T * 1024;

#ifndef SKIP_P0
    if (IN(0)) { RELANE(); p0_prologue(F, a); }
#endif
    SEAM(0);

    int K1024 = 1024, K256 = 256; asm volatile("" : "+s"(K1024), "+s"(K256));
    if (IN(1)) {
        pg8::Gemm g{(const bf16*)(ws + WS_XN), (const bf16*)(ws + WS_BT1), T, N1, K1024}; pg8::StaticOrder S; S.init(T, N1, F.G, (int)blockIdx.x);
#if defined(PROBE) && defined(PROBE_MODE1)
        { Epi1 E0{a.out, ws, a.in[5], a.in[6], a.in[17], PROBE_MODE1};
          pg8::gemm_phase<Epi1, pg8::StaticOrder, true, true>(F.lds, g, S, E0, F.wave * 64 + lane_id());
          xcd_barrier(xbar, F.wave == 0 && lane_id() == 0); STAMP(2); }
#define PROBE_SKIP_STAMP2 1
#endif
        Epi1 E{a.out, ws, a.in[5], a.in[6], a.in[17], 0};
#ifndef SKIP_G1
        pg8::gemm_phase<Epi1, pg8::StaticOrder, true, true>(F.lds, g, S, E, F.wave * 64 + lane_id());
#endif
        { const int nwg = (T / 256) * (N1 / 256), rounds = (nwg + F.G - 1) / F.G, first_short = nwg - (rounds - 1) * F.G;
          int nshort = F.G - first_short, w = (int)blockIdx.x - first_short;
          if (nshort == 0) { nshort = F.G; w = (int)blockIdx.x; }
          if (w >= 0) { RELANE(); p_to_bf16(F, a, w, nshort); tr_items(F, a, TR_EARLY, TR_ALL, w * NWAVES + F.wave, nshort * NWAVES); } }
    }
#if defined(PROBE) && defined(PROBE_MODE1)
    if (IN(1) && IN(2)) xcd_barrier(xbar, F.wave == 0 && lane_id() == 0);
#else
    SEAM(1);
#endif

    if (IN(2)) {
        int K128 = 128; asm volatile("" : "+s"(K128));
        { pg8::Gemm g{(const bf16*)(ws + WS_CQKV), (const bf16*)(ws + WS_BT2), T, 1536, K256}; pg8::StaticOrder S; S.init(T, 1536, F.G, (int)blockIdx.x);
          Epi2 E{ws, a.in[16], a.in[15], 0};
#ifndef SKIP_G2
          pg8::gemm_phase<Epi2, pg8::StaticOrder, true, true>(F.lds, g, S, E, F.wave * 64 + lane_id());
#endif
        }
        { pg8::Gemm g{(const bf16*)(ws + WS_CQKV) + (size_t)T * 256, (const bf16*)(ws + WS_BT2) + (size_t)1536 * 256, T, 2048, K128}; pg8::StaticOrder S; S.init(T, 2048, F.G, (int)blockIdx.x);
          Epi2 E{ws, a.in[16], a.in[15], 6};
#ifndef SKIP_G2
          pg8::gemm_phase<Epi2, pg8::StaticOrder, true, true>(F.lds, g, S, E, F.wave * 64 + lane_id());
#endif
        }
    } SEAM(2);

    if (IN(3)) {
#if !defined(SKIP_SWA) && (defined(PROBE_MLAV) || defined(PROBE_SWA))
        RELANE(); swa_phase(F, a);
#ifdef PROBE_SWA
        STAMP(8);
#endif
#endif
#ifndef SKIP_MLA
#ifdef MLA_SIMPLE
        RELANE(); mla_simple(F, a);
#else
#if defined(PROBE) && defined(PROBE_MLAV)
        __syncthreads(); STAMP(3);
        RELANE(); mla_probe_pass(F, a, (char*)lds);
        xcd_barrier(xbar, F.wave == 0 && lane_id() == 0); STAMP(4);
#endif
        RELANE(); mla_phase(F, a, (char*)lds);
#if !defined(SKIP_SWA) && !(defined(PROBE_MLAV) || defined(PROBE_SWA))
        RELANE(); swa_phase(F, a);
#endif
#if defined(PROBE) && defined(PROBE_IMB)
        if (F.wave == 0 && lane_id() == 0) { const unsigned long long t_ = __builtin_amdgcn_s_memrealtime(); atomicMin(&pts[20], t_); atomicMax(&pts[21], t_); }
#endif
#endif
#endif
    }
#if defined(PROBE) && defined(PROBE_MLAV)
    if (IN(3) && IN(4)) xcd_barrier(xbar, F.wave == 0 && lane_id() == 0);
#else
    SEAM(3);
#endif

    if (IN(4)) {
        int K2048 = 2048; asm volatile("" : "+s"(K2048));
        pg8::Gemm g{(const bf16*)(ws + WS_QA), (const bf16*)(ws + WS_BT3), T, 1024, K2048}; pg8::StaticOrder S; S.init(T, 1024, F.G, (int)blockIdx.x);
        Epi3c E{(bf16*)(ws + WS_MG), (const bf16*)(ws + WS_SGA), (const bf16*)(ws + WS_SGB)};
#ifndef SKIP_G3
        pg8::gemm_phase_cat<Epi3c, pg8::StaticOrder, true, true>(F.lds, g, S, E, F.wave * 64 + lane_id(), 1024, 16, (long)(WS_QBN - WS_QA));
#endif
    } SEAM(4);

    int p5mode = 0;
#if defined(PROBE) && defined(PROBE_MODE5)
    if (IN(5)) {
        p5mode = PROBE_MODE5;
        { pg8::Gemm g{(const bf16*)(ws + WS_MG), (const bf16*)(ws + WS_WOUT), T, 1024, K1024}; pg8::StaticOrder S; S.init(T, 1024, F.G, (int)blockIdx.x);
          Epi4 E{a.in[0], (float*)(ws + WS_X1F), (bf16*)(ws + WS_X1B), (float*)(ws + WS_SSX1), p5mode};
#ifdef PROBE_HALF
          if ((F.vcu & 1) == 0)
#endif
          pg8::gemm_phase<Epi4, pg8::StaticOrder, true, true>(F.lds, g, S, E, F.wave * 64 + lane_id()); }
        xcd_barrier(xbar, F.wave == 0 && lane_id() == 0); STAMP(6);
        p5mode = 0; asm volatile("" : "+s"(p5mode));
    }
#endif
    if (IN(5)) {
        for (int st = 0; st < 2; ++st) {
            if (((st ^ F.vcu) & 1) == 0) {
                pg8::Gemm g{(const bf16*)(ws + WS_MG), (const bf16*)(ws + WS_WOUT), T, 1024, K1024}; pg8::StaticOrder S; S.init(T, 1024, F.G, (int)blockIdx.x);
                Epi4 E{a.in[0], (float*)(ws + WS_X1F), (bf16*)(ws + WS_X1B), (float*)(ws + WS_SSX1), p5mode};
#ifndef SKIP_G4
                pg8::gemm_phase<Epi4, pg8::StaticOrder, true, true>(F.lds, g, S, E, F.wave * 64 + lane_id());
#endif
            } else {
                pg8::Gemm g{(const bf16*)(ws + WS_PB), (const bf16*)(ws + WS_WPP), T, 1024, K256}; pg8::StaticOrder S; S.init(T, 1024, F.G, (int)blockIdx.x);
                EpiE E{(bf16*)(ws + WS_ER), (float*)(ws + WS_SSE)};
#ifndef SKIP_GE
                pg8::gemm_phase<EpiE, pg8::StaticOrder, true, true>(F.lds, g, S, E, F.wave * 64 + lane_id());
#endif
            }
        }
    }
#if defined(PROBE) && defined(PROBE_MODE5)
    if (IN(5) && IN(6)) xcd_barrier(xbar, F.wave == 0 && lane_id() == 0);
#else
    SEAM(5);
#endif

    if (IN(6)) {
        pg8::Gemm g{(const bf16*)(ws + WS_X1B), (const bf16*)(ws + WS_WG), T, 1024, K1024}; pg8::StaticOrder S; S.init(T, 1024, F.G, (int)blockIdx.x);
        Epi5 E{a.out, (const bf16*)(ws + WS_X1B), (const bf16*)(ws + WS_ER), (const float*)(ws + WS_SSX1), (const float*)(ws + WS_SSE), a.in[23]};
#ifndef SKIP_G5
        pg8::gemm_phase<Epi5, pg8::StaticOrder, true, true>(F.lds, g, S, E, F.wave * 64 + lane_id());
#endif
    }
#ifdef PROBE
    xcd_barrier(xbar, F.wave == 0 && lane_id() == 0); STAMP(7);
    if (blockIdx.x == 0) {
        __syncthreads();
        volatile unsigned long long* vts = pts;
#ifdef PROBE_SWA
#ifdef PROBE_SWAONLY
        const float sw = (float)(vts[8] - vts[3]) * 0.01f;
#else
        const float sw = ((float)(vts[4] - vts[8]) * 0.01f - 600.0f) * 0.25f;
#endif
        if (F.wave == 0 && lane_id() == 0) a.out[0] += sw * PROBE_SCALE;
        if (0)
#endif
        {}
#if PROBE_A >= 10
        const float sa = (PROBE_A >= 31 && PROBE_A <= 35) ? (float)(vts[PROBE_A] - vts[PROBE_A - 1]) * 0.01f : (PROBE_A == 21) ? (float)(vts[21] - vts[20]) * 0.01f : (PROBE_A == 14) ? (float)(vts[14] - vts[4]) * 0.01f : (PROBE_A == 10) ? (float)(vts[10] - vts[0]) * 0.01f : (PROBE_A == 13) ? (float)(vts[1] - vts[12]) * 0.01f : (float)(vts[PROBE_A] - vts[PROBE_A - 1]) * 0.01f;
        const float sb = 0.f;
#else
        const float sa = (PROBE_A == 7) ? (float)(vts[7] - vts[0]) * 0.01f : (float)(vts[PROBE_A + 1] - vts[PROBE_A]) * 0.01f;
        const float sb = (PROBE_B == 7) ? (float)(vts[7] - vts[0]) * 0.01f : (float)(vts[PROBE_B + 1] - vts[PROBE_B]) * 0.01f;
#endif
        RELANE();
        (void)sb;
#ifndef PROBE_OFFSET
#define PROBE_OFFSET 0.0f
#endif
#ifndef PROBE_SWA
        if (F.tid == 0) a.out[0] += (sa - PROBE_OFFSET) * PROBE_SCALE;
#endif
    }
#endif
#undef IN
#undef SEAM
}

#ifndef MK_N_LAUNCHES
#define MK_N_LAUNCHES 1
#endif
extern "C" void kernel_launch(void* const* d_in, const int* in_sizes, int n_in, void* d_out, int out_size, void* d_ws, size_t ws_size, hipStream_t stream) {
    static int grid = 0;
    if (grid == 0) {
        if (n_in != 24 || in_sizes[0] != T * DM || out_size != T * DM || ws_size < WS_END) { fprintf(stderr, "kernel_launch: unexpected shapes / workspace (n_in %d, ws %zu)\n", n_in, ws_size); grid = -1; return; }
        int dev = 0, cus = 0, per_cu = 0;
        if (hipGetDevice(&dev) != hipSuccess || hipDeviceGetAttribute(&cus, hipDeviceAttributeMultiprocessorCount, dev) != hipSuccess) { grid = -1; return; }
        if (hipFuncSetAttribute((const void*)mk_fwd, hipFuncAttributeMaxDynamicSharedMemorySize, LDS_BYTES) != hipSuccess) { fprintf(stderr, "kernel_launch: hipFuncSetAttribute failed\n"); grid = -1; return; }
        if (hipOccupancyMaxActiveBlocksPerMultiprocessor(&per_cu, (const void*)mk_fwd, NTHR, LDS_BYTES) != hipSuccess || per_cu < 1) { fprintf(stderr, "kernel_launch: occupancy query says %d\n", per_cu); per_cu = 1; }
        (void)hipGetLastError();
        grid = cus;
    }
    if (grid < 0) return;
    Args a{};
    for (int i = 0; i < 24; ++i) a.in[i] = (const float*)d_in[i];
    a.out = (float*)d_out; a.ws = (unsigned char*)d_ws;
    if (hipMemsetAsync((char*)d_ws + WS_CTL, 0, 32768, stream) != hipSuccess) { fprintf(stderr, "kernel_launch: hipMemsetAsync failed\n"); return; }
#if MK_N_LAUNCHES == 1
    a.ph_lo = 0; a.ph_hi = NPHASE;
    void* args[] = {&a};
    hipError_t e = hipLaunchCooperativeKernel((const void*)mk_fwd, dim3(grid), dim3(NTHR), args, LDS_BYTES, stream);
    if (e != hipSuccess) fprintf(stderr, "kernel_launch: cooperative launch failed: %s (grid %d)\n", hipGetErrorString(e), grid);
#else
    for (int ph = 0; ph < NPHASE; ++ph) { a.ph_lo = ph; a.ph_hi = ph + 1; hipLaunchKernelGGL(mk_fwd, dim3(grid), dim3(NTHR), LDS_BYTES, stream, a); }
#endif
}
```
